# Optimizing an MI355X kernel written in HIP

```python
import jax, jax.numpy as jnp
from jax import lax
import numpy as np

D_MODEL = 1024
BATCH = 16
SEQ = 256
DEPTH = 4
DEC_BATCH = 8
DEC_SEQ = 2048
PAST_LEN = 512

GRID_W = 64
FFT_GROUPS = 4
FFT_GC = 128
FFT_W = FFT_GROUPS * FFT_GC
SGU_GROUPS = 4
SGU_GC = 128
SGU_W = SGU_GROUPS * SGU_GC
SGU_CHUNK = 128
GLA_H = 4
GLA_DK = 128
GLA_DV = 256
GLA_LR = 16
GLA_GATE_NORM = 16.0
GLA_CHUNK = 64
D_FF = 2816
N_BRANCH = 3
N_ADA = 6
LN_EPS = 1e-5
SPLITS = [FFT_W, SGU_W, SGU_W, GLA_H * GLA_DK, GLA_H * GLA_DK, GLA_H * GLA_DV, GLA_H * GLA_DV, 2 * GLA_LR, N_BRANCH * D_MODEL]
D_IN = sum(SPLITS)

kernel_name = "hybrid_fourier_sgu_gla_diffusion_step"


def _norm32(x):
    x32 = x.astype(jnp.float32)
    mu = jnp.mean(x32, axis=-1, keepdims=True)
    var = jnp.mean(jnp.square(x32 - mu), axis=-1, keepdims=True)
    return (x32 - mu) * lax.rsqrt(var + LN_EPS)


def _layer_norm(x, g, b):
    return (_norm32(x) * g.astype(jnp.float32) + b.astype(jnp.float32)).astype(x.dtype)


def _gla_scan(q, k, v, logg, s0):
    B, T, H, K = q.shape
    V = v.shape[-1]
    L = GLA_CHUNK
    n = T // L
    def r(a):
        return a.reshape(B, n, L, H, a.shape[-1]).transpose(1, 0, 3, 2, 4)
    q, k, v, logg = r(q), r(k), r(v), r(logg)
    G = jnp.cumsum(logg, axis=3)
    G_last = G[:, :, :, -1:, :]
    qg = q * jnp.exp(G)
    kg = k * jnp.exp(-G)
    A = jnp.einsum('nbhlk,nbhmk->nbhlm', qg, kg)
    mask = jnp.tril(jnp.ones((L, L), dtype=bool))
    A = jnp.where(mask, A, 0.0)
    intra = jnp.einsum('nbhlm,nbhmv->nbhlv', A, v)
    dS = jnp.einsum('nbhlk,nbhlv->nbhkv', k * jnp.exp(G_last - G), v)
    decay = jnp.exp(G_last[:, :, :, 0, :])

    def step(S, inp):
        d, ds = inp
        return d[..., None] * S + ds, S

    S_fin, S_start = lax.scan(step, s0, (decay, dS))
    inter = jnp.einsum('nbhlk,nbhkv->nbhlv', qg, S_start)
    o = (intra + inter).transpose(1, 0, 3, 2, 4).reshape(B, T, H, V)
    return o, S_fin


def _mixer(h, s0_f, s0_b, w_in, b_merge, w_fft_out, sgu_g, sgu_ws, sgu_b, w_sgu_out,
           gla_w2, gla_b, gla_norm_g, w_gla_out, w_o):
    B, T, D = h.shape
    idx = np.cumsum(SPLITS)[:-1].tolist()
    z = h @ w_in
    a_f, u, v, q, k, vv, r, lr, gm = jnp.split(z, idx, axis=-1)
    af = a_f.astype(jnp.float32).reshape(B, T, FFT_GROUPS, FFT_GC)
    af = jnp.fft.fft2(af, axes=(1, 3), norm="ortho").real.astype(h.dtype).reshape(B, T, FFT_W)
    y_a = af @ w_fft_out
    u = jax.nn.gelu(u)
    v = jax.nn.gelu(v)
    v = (_norm32(v) * sgu_g.astype(jnp.float32)).astype(h.dtype)
    vc = v.reshape(B, T // SGU_CHUNK, SGU_CHUNK, SGU_GROUPS, SGU_GC)
    vm = jnp.einsum('gpq,bnqgc->bnpgc', sgu_ws, vc) + sgu_b.T[:, :, None]
    y_b = (u * vm.reshape(B, T, SGU_W)) @ w_sgu_out
    qh = q.astype(jnp.float32).reshape(B, T, GLA_H, GLA_DK) * (GLA_DK ** -0.5)
    kh = k.astype(jnp.float32).reshape(B, T, GLA_H, GLA_DK)
    vh = vv.astype(jnp.float32).reshape(B, T, GLA_H, GLA_DV)
    lr2 = lr.astype(jnp.float32).reshape(B, T, 2, GLA_LR)
    zg = jnp.einsum('btdr,drk->btdk', lr2, gla_w2.astype(jnp.float32)) + gla_b.astype(jnp.float32)
    logg = (jax.nn.log_sigmoid(zg) / GLA_GATE_NORM).reshape(B, T, 2, GLA_H, GLA_DK)
    o_f, s_f = _gla_scan(qh, kh, vh, logg[:, :, 0], s0_f)
    o_b, s_b = _gla_scan(qh[:, ::-1], kh[:, ::-1], vh[:, ::-1], logg[:, ::-1, 1], s0_b)
    o = o_f + o_b[:, ::-1]
    o = o * lax.rsqrt(jnp.mean(jnp.square(o), axis=-1, keepdims=True) + LN_EPS) * gla_norm_g.astype(jnp.float32)
    o = o.reshape(B, T, GLA_H * GLA_DV).astype(h.dtype) * jax.nn.silu(r)
    y_c = o @ w_gla_out
    g = jax.nn.sigmoid(gm.astype(jnp.float32).reshape(B, T, N_BRANCH, D) + b_merge.astype(jnp.float32)).astype(h.dtype)
    m = g[:, :, 0] * y_a + g[:, :, 1] * y_b + g[:, :, 2] * y_c
    return m @ w_o, s_f, s_b


def _conv_ffn(h, w_up, w_dw, b_dw, w_down, latent):
    B, T, _ = h.shape
    a, g = jnp.split(h @ w_up, 2, axis=-1)
    if latent:
        rows = T // GRID_W
        ag = a.reshape(B, rows, GRID_W, D_FF)
        conv = lax.conv_general_dilated(ag, w_dw[:, :, None, :].astype(a.dtype), (1, 1), 'SAME',
                                        dimension_numbers=('NHWC', 'HWIO', 'NHWC'),
                                        feature_group_count=D_FF).reshape(B, T, D_FF)
    else:
        w1 = w_dw[1].astype(a.dtype)
        ap = jnp.pad(a, ((0, 0), (1, 1), (0, 0)))
        conv = ap[:, :-2] * w1[0] + ap[:, 1:-1] * w1[1] + ap[:, 2:] * w1[2]
    conv = conv + b_dw
    return (jax.nn.gelu(conv) * g) @ w_down


def _layer(x, cond, latent, s0_f, s0_b, alpha, p):
    mod = (jax.nn.silu(cond.astype(jnp.float32)) @ p['w_ada'].astype(jnp.float32) + p['b_ada'].astype(jnp.float32))
    mod = mod.reshape(cond.shape[0], 1, N_ADA, D_MODEL).astype(x.dtype)
    sh1, sc1, g1, sh2, sc2, g2 = [mod[:, :, i] for i in range(N_ADA)]
    h = (_norm32(x).astype(x.dtype) * (1.0 + sc1) + sh1)
    mix, s_f, s_b = _mixer(h, s0_f, s0_b, p['w_in'], p['b_merge'], p['w_fft_out'], p['sgu_g'], p['sgu_ws'],
                           p['sgu_b'], p['w_sgu_out'], p['gla_w2'], p['gla_b'], p['gla_norm_g'],
                           p['w_gla_out'], p['w_o'])
    x = _layer_norm(alpha * x + g1 * mix.astype(x.dtype), p['ln1_g'], p['ln1_b'])
    h2 = (_norm32(x).astype(x.dtype) * (1.0 + sc2) + sh2)
    f = _conv_ffn(h2, p['w_up'], p['w_dw'], p['b_dw'], p['w_down'], latent)
    x = _layer_norm(alpha * x + g2 * f.astype(x.dtype), p['ln2_g'], p['ln2_b'])
    return x, s_f, s_b


def setup_inputs(seed: int = 0) -> dict:
    key = jax.random.key(seed)
    ks = jax.random.split(key, 32)
    beta = (8.0 * DEPTH) ** -0.25
    f32 = jnp.float32
    nrm = lambda k, shape, s: jax.random.normal(k, shape, f32) * s
    D = D_MODEL
    return {
        "x_prompt": nrm(ks[0], (BATCH, SEQ, D), 1.0),
        "x_sample": nrm(ks[1], (DEC_BATCH, DEC_SEQ, D), 1.0),
        "state_gla": nrm(ks[2], (DEC_BATCH, DEPTH, 2, GLA_H, GLA_DK, GLA_DV), 0.5),
        "c": nrm(ks[3], (DEC_BATCH, D), 1.0),
        "c_ctx": nrm(ks[4], (D,), 1.0),
        "w_in": nrm(ks[5], (DEPTH, D, D_IN), D ** -0.5),
        "b_merge": nrm(ks[6], (DEPTH, N_BRANCH, D), 0.02),
        "w_fft_out": nrm(ks[7], (DEPTH, FFT_W, D), FFT_W ** -0.5),
        "sgu_g": 1.0 + nrm(ks[8], (DEPTH, SGU_W), 0.02),
        "sgu_ws": nrm(ks[9], (DEPTH, SGU_GROUPS, SGU_CHUNK, SGU_CHUNK), SGU_CHUNK ** -0.5),
        "sgu_b": 1.0 + nrm(ks[10], (DEPTH, SGU_GROUPS, SGU_CHUNK), 0.02),
        "w_sgu_out": nrm(ks[11], (DEPTH, SGU_W, D), SGU_W ** -0.5),
        "gla_w2": nrm(ks[12], (DEPTH, 2, GLA_LR, GLA_H * GLA_DK), GLA_LR ** -0.5),
        "gla_b": nrm(ks[13], (DEPTH, 2, GLA_H * GLA_DK), 0.02),
        "gla_norm_g": 1.0 + nrm(ks[14], (DEPTH, GLA_DV), 0.02),
        "w_gla_out": nrm(ks[15], (DEPTH, GLA_H * GLA_DV, D), (GLA_H * GLA_DV) ** -0.5),
        "w_o": nrm(ks[16], (DEPTH, D, D), beta * D ** -0.5),
        "ln1_g": 1.0 + nrm(ks[17], (DEPTH, D), 0.02),
        "ln1_b": nrm(ks[18], (DEPTH, D), 0.02),
        "w_ada": nrm(ks[19], (DEPTH, D, N_ADA * D), 0.5 * D ** -0.5),
        "b_ada": nrm(ks[20], (DEPTH, N_ADA * D), 0.02),
        "w_up": nrm(ks[21], (DEPTH, D, 2 * D_FF), D ** -0.5),
        "w_dw": nrm(ks[22], (DEPTH, 3, 3, D_FF), 1.0 / 3.0),
        "b_dw": nrm(ks[23], (DEPTH, D_FF), 0.02),
        "w_down": nrm(ks[24], (DEPTH, D_FF, D), beta * D_FF ** -0.5),
        "ln2_g": 1.0 + nrm(ks[25], (DEPTH, D), 0.02),
        "ln2_b": nrm(ks[26], (DEPTH, D), 0.02),
    }


def reference(x_prompt, x_sample, state_gla, c, c_ctx, w_in, b_merge, w_fft_out, sgu_g, sgu_ws, sgu_b,
              w_sgu_out, gla_w2, gla_b, gla_norm_g, w_gla_out, w_o, ln1_g, ln1_b, w_ada, b_ada,
              w_up, w_dw, b_dw, w_down, ln2_g, ln2_b):
    alpha = (2.0 * DEPTH) ** 0.25
    xp = x_prompt
    xs = x_sample
    zeros = jnp.zeros((x_prompt.shape[0], GLA_H, GLA_DK, GLA_DV), jnp.float32)
    cond_ctx = c_ctx[None, :]
    new_states = []
    for l in range(DEPTH):
        p = {'w_in': w_in[l], 'b_merge': b_merge[l], 'w_fft_out': w_fft_out[l], 'sgu_g': sgu_g[l],
             'sgu_ws': sgu_ws[l], 'sgu_b': sgu_b[l], 'w_sgu_out': w_sgu_out[l], 'gla_w2': gla_w2[l],
             'gla_b': gla_b[l], 'gla_norm_g': gla_norm_g[l], 'w_gla_out': w_gla_out[l], 'w_o': w_o[l],
             'ln1_g': ln1_g[l], 'ln1_b': ln1_b[l], 'w_ada': w_ada[l], 'b_ada': b_ada[l], 'w_up': w_up[l],
             'w_dw': w_dw[l], 'b_dw': b_dw[l], 'w_down': w_down[l], 'ln2_g': ln2_g[l], 'ln2_b': ln2_b[l]}
        xp, s_f, s_b = _layer(xp, cond_ctx, False, zeros, zeros, alpha, p)
        new_states.append(jnp.stack([s_f, s_b], axis=1))
        xs, _, _ = _layer(xs, c, True, state_gla[:, l, 0].astype(jnp.float32),
                          state_gla[:, l, 1].astype(jnp.float32), alpha, p)
    new_state_gla = jnp.stack(new_states, axis=1).astype(x_prompt.dtype)
    y_prompt = xp.astype(x_prompt.dtype)
    y_sample = xs.astype(x_sample.dtype)
    return (y_prompt, y_sample, new_state_gla)
```

```cpp
#include <hip/hip_runtime.h>
#include <hip/hip_cooperative_groups.h>
#include <cstdio>
namespace cg = cooperative_groups;

#define LAS __attribute__((address_space(3)))
typedef unsigned short bf16_t;
typedef short bf16x8 __attribute__((ext_vector_type(8)));
typedef float f32x4 __attribute__((ext_vector_type(4)));
typedef float f32x2 __attribute__((ext_vector_type(2)));
typedef unsigned u32x4 __attribute__((ext_vector_type(4)));
typedef unsigned u32x2 __attribute__((ext_vector_type(2)));

constexpr int D = 1024, NTOK = 20480, NCTX = 4096, DEPTH = 4;
constexpr int ZLD = 7168;
constexpr int ZU = 0, ZV = 512, ZQ = 1024, ZK = 1536, ZVV = 2048, ZR = 3072, ZG = 4096;
constexpr int N1 = 8448;
constexpr int DFF = 2816;
constexpr int NFFT_WG = 96;

constexpr size_t WS_MOD  = 0;
constexpr size_t WS_DLAT = WS_MOD + 4ull * 9 * 6144 * 4;
constexpr size_t WS_DCTX = WS_DLAT + 2048ull * 4096 * 2;
constexpr size_t WS_W1T  = WS_DCTX + 256ull * 512 * 2;
constexpr size_t WS_WUPT = WS_W1T;
constexpr size_t WS_WDNT = WS_W1T + 5632ull * 1024 * 2;
constexpr size_t WS_WMT  = WS_W1T + (size_t)N1 * 1024 * 2;
constexpr size_t WS_WOT  = WS_WMT + 1024ull * 2048 * 2;
constexpr size_t WS_H    = WS_WOT + 1024ull * 1024 * 2;
constexpr size_t WS_XT   = WS_H + (size_t)NTOK * 1024 * 2;
constexpr size_t WS_XTL  = WS_XT + 16ull * 512 * 512 * 2;
constexpr size_t WS_Z    = WS_XT + (size_t)NTOK * 1024 * 2;
constexpr size_t WS_LR   = WS_Z + (size_t)NTOK * ZLD * 2;
constexpr size_t WS_AM   = WS_LR + (size_t)NTOK * 32 * 4;
constexpr size_t WS_END  = WS_AM + (size_t)NTOK * 2048 * 2;
constexpr size_t WS_AG   = WS_Z;
constexpr size_t WS_FF   = WS_Z + (size_t)NTOK * 5632 * 2;
static_assert(WS_FF + (size_t)NTOK * DFF * 2 <= WS_END, "ffn alias");

constexpr int LDS_BYTES = 131072 + 8192;

struct P {
    const float* in[27];
    float* out;
    unsigned char* ws;
};

__device__ __forceinline__ int ltid() { int t = threadIdx.x; asm volatile("" : "+v"(t)); return t; }
__device__ __forceinline__ int lwg() { int b = blockIdx.x; asm volatile("" : "+s"(b)); return b; }
__device__ __forceinline__ int lnwg() { int b = gridDim.x; asm volatile("" : "+s"(b)); return b; }

__device__ __forceinline__ float bf2f(unsigned v) { return __uint_as_float(v << 16); }
typedef __bf16 bf2_t __attribute__((ext_vector_type(2)));
__device__ __forceinline__ unsigned cvt_pk_bf16(float lo, float hi) { const f32x2 v = {lo, hi}; const bf2_t b = __builtin_convertvector(v, bf2_t); return __builtin_bit_cast(unsigned, b); }
__device__ __forceinline__ bf16_t f2bf(float f) { return (bf16_t)(cvt_pk_bf16(f, 0.f) & 0xffffu); }
__device__ __forceinline__ float sigmoidf_(float x) { return 1.0f / (1.0f + __expf(-x)); }
__device__ __forceinline__ float siluf_(float x) { return x / (1.0f + __expf(-x)); }
__device__ __forceinline__ float geluf_(float x) { const float y = 1.5957691216057308f * (x + 0.044715f * x * x * x); return x / (1.0f + __expf(-y)); }
__device__ __forceinline__ float wave_sum(float v) {
#pragma unroll
    for (int o = 32; o >= 1; o >>= 1) v += __shfl_xor(v, o);
    return v;
}
__device__ __forceinline__ void unpack8(const u32x4 w, float (&f)[8]) {
    f[0] = bf2f(w.x & 0xffffu); f[1] = bf2f(w.x >> 16); f[2] = bf2f(w.y & 0xffffu); f[3] = bf2f(w.y >> 16);
    f[4] = bf2f(w.z & 0xffffu); f[5] = bf2f(w.z >> 16); f[6] = bf2f(w.w & 0xffffu); f[7] = bf2f(w.w >> 16);
}
__device__ __forceinline__ u32x4 pack8(const float (&f)[8]) {
    u32x4 w; w.x = cvt_pk_bf16(f[0], f[1]); w.y = cvt_pk_bf16(f[2], f[3]); w.z = cvt_pk_bf16(f[4], f[5]); w.w = cvt_pk_bf16(f[6], f[7]); return w;
}

constexpr int BM = 256, BK = 64, HALF = 128, HTB = HALF * BK * 2;
__device__ __forceinline__ int lds_byte(int r, int c) { const int st = (r >> 4) * 2 + (c >> 5), rr = r & 15, cc = c & 31, ob = rr * 64 + cc * 2; return st * 1024 + (ob ^ (((ob >> 9) & 1) << 5)); }
__device__ __forceinline__ void stage_rc(int b, int& R, int& C) { const int st = b / 1024, sb = b % 1024, swz = sb ^ (((sb >> 9) & 1) << 5); R = (st >> 1) * 16 + swz / 64; C = (st & 1) * 32 + (swz % 64) / 2; }
__device__ __forceinline__ int perm32(int rho) { const int n = rho >> 4, i = rho & 15; return 8 * (i >> 2) + 4 * n + (i & 3); }

struct Unit { int pm, pn, aux; };

__device__ __forceinline__ void tile_map(int L, int nM, int nN, int& pm, int& pn) {
    const int nwg = nM * nN; int wgid = L;
    { const int q = nwg / 8, r = nwg % 8, xcd = wgid % 8, off = wgid / 8; wgid = (xcd < r ? xcd * (q + 1) : r * (q + 1) + (xcd - r) * q) + off; }
    const int nig = 8 * nN, gid = wgid / nig, fm = gid * 8, gsz = (nM - fm) < 8 ? (nM - fm) : 8;
    pm = fm + ((wgid % nig) % gsz); pn = (wgid % nig) / gsz;
}

struct SchedStd {
    const bf16_t* A; const bf16_t* Bt; int lda, ldb, K, nM, nN, G, c;
    __device__ __forceinline__ bool next(int i, Unit& u) const { const int L = i * G + c; if (L >= nM * nN) return false; tile_map(L, nM, nN, u.pm, u.pn); u.aux = 0; return true; }
    __device__ __forceinline__ const char* a_ptr(const Unit& u) const { return (const char*)A + (size_t)u.pm * 256 * lda * 2; }
    __device__ __forceinline__ const char* b_ptr(const Unit& u) const { return (const char*)Bt + (size_t)u.pn * 256 * ldb * 2; }
};
struct SchedMerge {
    const bf16_t* A; const bf16_t* Bt; int lda, ldb, K, G, c;
    __device__ __forceinline__ bool next(int i, Unit& u) const { const int L = (i >> 2) * G + c; if (L >= 320) return false; tile_map(L, 80, 4, u.pm, u.pn); u.aux = i & 3; return true; }
    __device__ __forceinline__ const char* a_ptr(const Unit& u) const { return (const char*)A + ((size_t)u.pm * 256 * lda + u.aux * 512) * 2; }
    __device__ __forceinline__ const char* b_ptr(const Unit& u) const { return (const char*)Bt + ((size_t)u.pn * 256 * ldb + u.aux * 512) * 2; }
};
struct SchedFftL {
    const bf16_t* A; const bf16_t* Bt; int lda, ldb, K, G, c;
    __device__ __forceinline__ bool next(int i, Unit& u) const { const int L = i * G + c; if (L >= 128) return false; const int b = L >> 4, rem = L & 15; u.pm = 16 + b * 8 + (rem >> 1); u.pn = rem & 1; u.aux = b; return true; }
    __device__ __forceinline__ const char* a_ptr(const Unit& u) const { return (const char*)A + (size_t)((u.pm - 16) & 7) * 256 * 4096 * 2; }
    __device__ __forceinline__ const char* b_ptr(const Unit& u) const { return (const char*)Bt + ((size_t)u.aux * 512 + u.pn * 256) * 4096 * 2; }
};
struct SchedFftC {
    const bf16_t* A; const bf16_t* Bt; int lda, ldb, K, G, c;
    __device__ __forceinline__ bool next(int i, Unit& u) const { const int L = i * G + c; if (L >= 32) return false; u.pm = L >> 1; u.pn = L & 1; u.aux = 0; return true; }
    __device__ __forceinline__ const char* a_ptr(const Unit&) const { return (const char*)A; }
    __device__ __forceinline__ const char* b_ptr(const Unit& u) const { return (const char*)Bt + ((size_t)u.pm * 512 + u.pn * 256) * 512 * 2; }
};

struct EpiIn {
    static constexpr bool PERM = true;
    bf16_t* Z; bf16_t* XTc; bf16_t* XTl; float* LR; const float* bmerge;
    __device__ __forceinline__ void operator()(const f32x4 (&acc)[2][2][4][2], const Unit& u, int wr, int wc, int fr, int fq) const {
        const int pn = u.pn, cl = wc * 32 + 8 * fq;
        if (pn < 4) {
            bf16_t* base; int ldk, t0; const int cs = pn >> 1;
            if (u.pm < 16) { base = XTc + (size_t)u.pm * 512 * 512; ldk = 512; t0 = cs * 256; }
            else { const int b = (u.pm - 16) >> 3; base = XTl + (size_t)b * 512 * 4096; ldk = 4096; t0 = cs * 2048 + ((u.pm - 16) & 7) * 256; }
            t0 += wr * 64 + fr;
#pragma unroll
            for (int ai = 0; ai < 2; ++ai)
#pragma unroll
                for (int m = 0; m < 4; ++m) { const int t = t0 + ai * 128 + m * 16;
#pragma unroll
                    for (int bj = 0; bj < 2; ++bj)
#pragma unroll
                        for (int n = 0; n < 2; ++n) { const int c = (pn & 1) * 256 + bj * 128 + cl + n * 4; const f32x4 v = acc[ai][bj][m][n];
                            const unsigned p0 = cvt_pk_bf16(v[0], v[1]), p1 = cvt_pk_bf16(v[2], v[3]);
                            bf16_t* q = base + (size_t)c * ldk + t;
                            q[0] = (bf16_t)(p0 & 0xffffu); q[ldk] = (bf16_t)(p0 >> 16); q[2 * ldk] = (bf16_t)(p1 & 0xffffu); q[3 * ldk] = (bf16_t)(p1 >> 16); } }
        } else if (pn < 32) {
            const int zc0 = (pn - 4) * 256 + cl;
            const int mode = pn < 8 ? 1 : (pn < 16 ? 0 : (pn < 20 ? 2 : 3));
            f32x4 bv[2][2];
#pragma unroll
            for (int bj = 0; bj < 2; ++bj)
#pragma unroll
                for (int n = 0; n < 2; ++n) bv[bj][n] = (mode == 3) ? *(const f32x4*)(bmerge + (zc0 - ZG) + bj * 128 + n * 4) : (f32x4){0.f, 0.f, 0.f, 0.f};
            const int row0 = u.pm * 256 + wr * 64 + fr;
#pragma unroll
            for (int ai = 0; ai < 2; ++ai)
#pragma unroll
                for (int m = 0; m < 4; ++m) { bf16_t* rowp = Z + (size_t)(row0 + ai * 128 + m * 16) * ZLD + zc0;
#pragma unroll
                    for (int bj = 0; bj < 2; ++bj) { float f[8];
#pragma unroll
                        for (int j = 0; j < 4; ++j) { f[j] = acc[ai][bj][m][0][j] + bv[bj][0][j]; f[4 + j] = acc[ai][bj][m][1][j] + bv[bj][1][j]; }
                        if (mode == 1) {
#pragma unroll
                            for (int j = 0; j < 8; ++j) f[j] = geluf_(f[j]); }
                        else if (mode == 2) {
#pragma unroll
                            for (int j = 0; j < 8; ++j) f[j] = siluf_(f[j]); }
                        else if (mode == 3) {
#pragma unroll
                            for (int j = 0; j < 8; ++j) f[j] = sigmoidf_(f[j]); }
                        *(u32x4*)(rowp + bj * 128) = pack8(f); } }
        } else {
            if (wc == 0) { const int row0 = u.pm * 256 + wr * 64 + fr;
#pragma unroll
                for (int ai = 0; ai < 2; ++ai)
#pragma unroll
                    for (int m = 0; m < 4; ++m) { float* q = LR + (size_t)(row0 + ai * 128 + m * 16) * 32 + 8 * fq;
                        *(f32x4*)q = acc[ai][0][m][0]; *(f32x4*)(q + 4) = acc[ai][0][m][1]; } }
        }
    }
};
struct EpiBf16 {
    static constexpr bool PERM = true;
    bf16_t* O; int ldc;
    __device__ __forceinline__ void operator()(const f32x4 (&acc)[2][2][4][2], const Unit& u, int wr, int wc, int fr, int fq) const {
        const int row0 = u.pm * 256 + wr * 64 + fr, col0 = u.pn * 256 + wc * 32 + 8 * fq;
#pragma unroll
        for (int ai = 0; ai < 2; ++ai)
#pragma unroll
            for (int m = 0; m < 4; ++m) { bf16_t* rowp = O + (size_t)(row0 + ai * 128 + m * 16) * ldc + col0;
#pragma unroll
                for (int bj = 0; bj < 2; ++bj) { const f32x4 v0 = acc[ai][bj][m][0], v1 = acc[ai][bj][m][1];
                    u32x4 w; w.x = cvt_pk_bf16(v0[0], v0[1]); w.y = cvt_pk_bf16(v0[2], v0[3]); w.z = cvt_pk_bf16(v1[0], v1[1]); w.w = cvt_pk_bf16(v1[2], v1[3]);
                    *(u32x4*)(rowp + bj * 128) = w; } }
    }
};
struct EpiMerge {
    static constexpr bool PERM = true;
    bf16_t* Mo; const bf16_t* Z;
    __device__ __forceinline__ void operator()(const f32x4 (&acc)[2][2][4][2], const Unit& u, int wr, int wc, int fr, int fq) const {
        const int br = u.aux, gb = br < 2 ? br : 2;
        const int row0 = u.pm * 256 + wr * 64 + fr, col0 = u.pn * 256 + wc * 32 + 8 * fq;
#pragma unroll
        for (int ai = 0; ai < 2; ++ai)
#pragma unroll
            for (int m = 0; m < 4; ++m) { const size_t row = (size_t)(row0 + ai * 128 + m * 16);
#pragma unroll
                for (int bj = 0; bj < 2; ++bj) {
                    float g[8], f[8]; unpack8(*(const u32x4*)(Z + row * ZLD + ZG + gb * 1024 + col0 + bj * 128), g);
#pragma unroll
                    for (int j = 0; j < 4; ++j) { f[j] = acc[ai][bj][m][0][j] * g[j]; f[4 + j] = acc[ai][bj][m][1][j] * g[4 + j]; }
                    bf16_t* op = Mo + row * 1024 + col0 + bj * 128;
                    if (br > 0) { float pv[8]; unpack8(*(const u32x4*)op, pv);
#pragma unroll
                        for (int j = 0; j < 8; ++j) f[j] += pv[j]; }
                    *(u32x4*)op = pack8(f); } }
    }
};
struct EpiResid {
    static constexpr bool PERM = false;
    const float* xin_ctx; const float* xin_lat; float* xout; const float* gate;
    __device__ __forceinline__ void operator()(const f32x4 (&acc)[2][2][4][2], const Unit& u, int wr, int wc, int fr, int fq) const {
        const float alpha = 1.681792830507429f;
        const int cond = u.pm < 16 ? 0 : 1 + ((u.pm - 16) >> 3);
        const int col0 = u.pn * 256 + wc * 32 + 4 * fq, row0 = u.pm * 256 + wr * 64 + fr;
        const float* gp = gate + (size_t)cond * 6144 + col0;
        f32x4 gv[2][2];
#pragma unroll
        for (int bj = 0; bj < 2; ++bj)
#pragma unroll
            for (int n = 0; n < 2; ++n) gv[bj][n] = *(const f32x4*)(gp + bj * 128 + n * 16);
        const float* xin = u.pm < 16 ? xin_ctx : xin_lat - (size_t)NCTX * 1024;
#pragma unroll
        for (int ai = 0; ai < 2; ++ai)
#pragma unroll
            for (int m = 0; m < 4; ++m) { const size_t off = (size_t)(row0 + ai * 128 + m * 16) * 1024 + col0;
#pragma unroll
                for (int bj = 0; bj < 2; ++bj)
#pragma unroll
                    for (int n = 0; n < 2; ++n) { const f32x4 xv = *(const f32x4*)(xin + off + bj * 128 + n * 16);
                        *(f32x4*)(xout + off + bj * 128 + n * 16) = alpha * xv + gv[bj][n] * acc[ai][bj][m][n]; } }
    }
};

template <class Epi, class Sched>
__device__ __forceinline__ void gemm_phase(LAS unsigned char* lds, const Sched& S, const Epi& E) {
    const int tid = ltid(), wid = __builtin_amdgcn_readfirstlane(tid >> 6), lane = tid & 63, wr = wid >> 2, wc = wid & 3, fr = lane & 15, fq = lane >> 4;
    const int K = S.K, nt = K / BK, lda = S.lda, ldb = S.ldb;
    unsigned voffA[2], voffB[2];
#pragma unroll
    for (int i = 0; i < 2; ++i) { int R, C; stage_rc(tid * 16 + i * 8192, R, C); const int Rb = Epi::PERM ? ((R & ~31) + perm32(R & 31)) : R;
        voffA[i] = (unsigned)(R * lda + C) * 2u; voffB[i] = (unsigned)(Rb * ldb + C) * 2u; }
    const size_t kstep = (size_t)(BK * 2);
    const size_t hstepA = (size_t)HALF * lda * 2, hstepB = (size_t)HALF * ldb * 2;
    const unsigned ldsw = (unsigned)wid * 1024u;
    const int aoff = lds_byte(wr * 64 + fr, fq * 8), boff = lds_byte(wc * 32 + fr, fq * 8);
#define PG8_SA(b, h) (((b) * 2 + (h)) * HTB)
#define PG8_SB(b, h) ((4 + (b) * 2 + (h)) * HTB)
#define PG8_STAGE(bufoff, gbase, voff) do { _Pragma("unroll") for (int _i = 0; _i < 2; ++_i) \
        __builtin_amdgcn_global_load_lds((const unsigned*)((const char*)(gbase) + (voff)[_i]), (LAS unsigned*)(lds + (bufoff) + ldsw + _i * 8192), 16, 0, 0); } while (0)
#define PG8_LDA(dst, b, h) do { _Pragma("unroll") for (int m = 0; m < 4; ++m) _Pragma("unroll") for (int k = 0; k < 2; ++k) dst[m][k] = *(const LAS bf16x8*)(lds + PG8_SA(b, h) + aoff + m * 2048 + k * 1024); } while (0)
#define PG8_LDB(dst, b, h) do { _Pragma("unroll") for (int n = 0; n < 2; ++n) _Pragma("unroll") for (int k = 0; k < 2; ++k) dst[n][k] = *(const LAS bf16x8*)(lds + PG8_SB(b, h) + boff + n * 2048 + k * 1024); } while (0)
#define PG8_MMA(ai, bj, At, Bt) do { __builtin_amdgcn_s_setprio(1); _Pragma("unroll") for (int m = 0; m < 4; ++m) _Pragma("unroll") for (int n = 0; n < 2; ++n) _Pragma("unroll") for (int k = 0; k < 2; ++k) \
        acc[ai][bj][m][n] = __builtin_amdgcn_mfma_f32_16x16x32_bf16(Bt[n][k], At[m][k], acc[ai][bj][m][n], 0, 0, 0); __builtin_amdgcn_s_setprio(0); } while (0)
#define PG8_WAIT_V(n) asm volatile("s_waitcnt vmcnt(" #n ")" ::: "memory")
#define PG8_WAIT_L(n) asm volatile("s_waitcnt lgkmcnt(" #n ")" ::: "memory")
#define PG8_BAR __builtin_amdgcn_s_barrier()
#define PG8_SCHED __builtin_amdgcn_sched_barrier(0)
    Unit cur, nxt; int ui = 0;
    if (!S.next(0, cur)) return;
    f32x4 acc[2][2][4][2];
#pragma unroll
    for (int a = 0; a < 2; ++a)
#pragma unroll
        for (int b = 0; b < 2; ++b)
#pragma unroll
            for (int m = 0; m < 4; ++m)
#pragma unroll
                for (int n = 0; n < 2; ++n) acc[a][b][m][n] = (f32x4){0.f, 0.f, 0.f, 0.f};
    bf16x8 At[4][2], B0[2][2], B1[2][2];
    const char* cA = S.a_ptr(cur); const char* cB = S.b_ptr(cur);
    PG8_STAGE(PG8_SB(0, 0), cB, voffB); PG8_STAGE(PG8_SA(0, 0), cA, voffA); PG8_STAGE(PG8_SB(0, 1), cB + hstepB, voffB); PG8_STAGE(PG8_SA(0, 1), cA + hstepA, voffA);
    if (wr == 1) PG8_BAR;
    PG8_WAIT_V(4); PG8_BAR;
    PG8_STAGE(PG8_SB(1, 0), cB + kstep, voffB); PG8_STAGE(PG8_SA(1, 0), cA + kstep, voffA); PG8_STAGE(PG8_SB(1, 1), cB + hstepB + kstep, voffB);
    PG8_WAIT_V(6); PG8_BAR;
    for (;;) {
        const bool has_next = S.next(ui + 1, nxt);
        const char* nA = has_next ? S.a_ptr(nxt) : cA; const char* nB = has_next ? S.b_ptr(nxt) : cB;
        for (int t = 0; t < nt; t += 2) {
            const bool last = (t == nt - 2);
            const char* a1 = cA + (size_t)(t + 1) * kstep;
            const char* a2 = last ? nA : cA + (size_t)(t + 2) * kstep; const char* b2 = last ? nB : cB + (size_t)(t + 2) * kstep;
            const char* a3 = a2 + kstep; const char* b3 = b2 + kstep;
            PG8_LDB(B0, 0, 0); PG8_SCHED; PG8_LDA(At, 0, 0); PG8_STAGE(PG8_SA(1, 1), a1 + hstepA, voffA);
            PG8_WAIT_L(8); PG8_BAR; PG8_WAIT_L(0); PG8_MMA(0, 0, At, B0); PG8_BAR; PG8_SCHED;
            PG8_LDB(B1, 0, 1); PG8_STAGE(PG8_SB(0, 0), b2, voffB);
            PG8_BAR; PG8_WAIT_L(0); PG8_MMA(0, 1, At, B1); PG8_BAR;
            PG8_LDA(At, 0, 1); PG8_STAGE(PG8_SA(0, 0), a2, voffA);
            PG8_BAR; PG8_WAIT_L(0); PG8_MMA(1, 0, At, B0); PG8_BAR; PG8_SCHED;
            PG8_STAGE(PG8_SB(0, 1), b2 + hstepB, voffB);
            PG8_WAIT_V(6); PG8_BAR; PG8_MMA(1, 1, At, B1); PG8_BAR;
            PG8_LDB(B0, 1, 0); PG8_SCHED; PG8_LDA(At, 1, 0); PG8_STAGE(PG8_SA(0, 1), a2 + hstepA, voffA);
            PG8_WAIT_L(8); PG8_BAR; PG8_WAIT_L(0); PG8_MMA(0, 0, At, B0); PG8_BAR; PG8_SCHED;
            PG8_LDB(B1, 1, 1); PG8_STAGE(PG8_SB(1, 0), b3, voffB);
            PG8_BAR; PG8_WAIT_L(0); PG8_MMA(0, 1, At, B1); PG8_BAR;
            PG8_LDA(At, 1, 1); PG8_STAGE(PG8_SA(1, 0), a3, voffA);
            PG8_BAR; PG8_WAIT_L(0); PG8_MMA(1, 0, At, B0); PG8_BAR; PG8_SCHED;
            PG8_STAGE(PG8_SB(1, 1), b3 + hstepB, voffB);
            PG8_WAIT_V(6); PG8_BAR; PG8_MMA(1, 1, At, B1); PG8_BAR;
        }
        E(acc, cur, wr, wc, fr, fq);
        if (!has_next) break;
#pragma unroll
        for (int a = 0; a < 2; ++a)
#pragma unroll
            for (int b = 0; b < 2; ++b)
#pragma unroll
                for (int m = 0; m < 4; ++m)
#pragma unroll
                    for (int n = 0; n < 2; ++n) acc[a][b][m][n] = (f32x4){0.f, 0.f, 0.f, 0.f};
        cur = nxt; cA = nA; cB = nB; ++ui;
    }
    PG8_WAIT_V(0);
    if (wr == 0) PG8_BAR;
    PG8_BAR;
#undef PG8_SA
#undef PG8_SB
#undef PG8_STAGE
#undef PG8_LDA
#undef PG8_LDB
#undef PG8_MMA
#undef PG8_WAIT_V
#undef PG8_WAIT_L
#undef PG8_BAR
#undef PG8_SCHED
}

__device__ __forceinline__ void mods_phase(const P& p, float* MOD, float* ldsf) {
    const int tid = ltid(), wid = tid >> 6, lane = tid & 63;
    float* sc = ldsf;
    float* red = ldsf + 9 * 1024;
    for (int i = tid; i < 9 * 1024; i += 512) { const int j = i >> 10, k = i & 1023; const float v = j == 0 ? p.in[4][k] : p.in[3][(j - 1) * 1024 + k]; sc[i] = siluf_(v); }
    __syncthreads();
    for (int item = lwg(); item < 384; item += lnwg()) {
        const int l = item / 96, col0 = (item % 96) * 64;
        const float* w = p.in[19] + (size_t)l * 1024 * 6144 + col0 + lane;
        float a[9];
#pragma unroll
        for (int j = 0; j < 9; ++j) a[j] = 0.f;
        const int kb = wid * 128;
#pragma unroll 8
        for (int k = 0; k < 128; ++k) { const float wv = w[(size_t)(kb + k) * 6144];
#pragma unroll
            for (int j = 0; j < 9; ++j) a[j] += sc[j * 1024 + kb + k] * wv; }
#pragma unroll
        for (int j = 0; j < 9; ++j) red[(wid * 9 + j) * 64 + lane] = a[j];
        __syncthreads();
        for (int i = tid; i < 576; i += 512) { const int j = i >> 6, ln = i & 63; float s = p.in[20][l * 6144 + col0 + ln];
#pragma unroll
            for (int w8 = 0; w8 < 8; ++w8) s += red[(w8 * 9 + j) * 64 + ln];
            MOD[(size_t)(l * 9 + j) * 6144 + col0 + ln] = s; }
        __syncthreads();
    }
}

__device__ __forceinline__ void dft_phase(bf16_t* DL, bf16_t* DC) {
    const size_t gt = (size_t)lwg() * 512 + ltid(), gn = (size_t)lnwg() * 512;
    for (size_t i = gt; i < 2048ull * 4096 / 8; i += gn) { const int k = (int)(i / 512), t0 = (int)(i % 512) * 8; float f[8];
#pragma unroll
        for (int j = 0; j < 8; ++j) { const int tt = t0 + j, t = tt & 2047; const int m = (k * t) & 2047; const float x = (float)m * (1.0f / 1024.0f);
            f[j] = (tt < 2048 ? cospif(x) : -sinpif(x)) * (1.0f / 512.0f); }
        *(u32x4*)(DL + i * 8) = pack8(f); }
    for (size_t i = gt; i < 256ull * 512 / 8; i += gn) { const int k = (int)(i / 64), t0 = (int)(i % 64) * 8; float f[8];
#pragma unroll
        for (int j = 0; j < 8; ++j) { const int tt = t0 + j, t = tt & 255; const int m = (k * t) & 255; const float x = (float)m * (1.0f / 128.0f);
            f[j] = (tt < 256 ? cospif(x) : -sinpif(x)) * 0.005524271728019903f; }
        *(u32x4*)(DC + i * 8) = pack8(f); }
}

__device__ __forceinline__ void tconv_tile(const float* src, int ld_src, bf16_t* dst, int ld_dst, int k0, int n0, float scale, float* tl) {
    const int tid = ltid();
#pragma unroll
    for (int ps = 0; ps < 4; ++ps) { const int kr = ps * 16 + (tid >> 5), nc = (tid & 31) * 4;
        const f32x4 v = *(const f32x4*)(src + (size_t)(k0 + kr) * ld_src + n0 + nc);
        float* q = tl + kr * 129 + nc; q[0] = v[0]; q[1] = v[1]; q[2] = v[2]; q[3] = v[3]; }
    __syncthreads();
    { const int n = tid >> 2, kq = tid & 3; float f[8], g[8];
#pragma unroll
      for (int j = 0; j < 8; ++j) { f[j] = tl[(kq * 16 + j) * 129 + n] * scale; g[j] = tl[(kq * 16 + 8 + j) * 129 + n] * scale; }
      bf16_t* q = dst + (size_t)(n0 + n) * ld_dst + k0 + kq * 16;
      *(u32x4*)q = pack8(f); *(u32x4*)(q + 8) = pack8(g); }
    __syncthreads();
}

__device__ __forceinline__ void wfft_item(int item, const float* win, bf16_t* W1T, float* tl) {
    const int tid = ltid(), kb = item >> 2, g = item & 3;
    float* xin = tl;
    float* ct = tl + 2048;
    { const int r = tid >> 5, c4 = (tid & 31) * 4; const f32x4 v = *(const f32x4*)(win + (size_t)(kb * 16 + r) * 7712 + g * 128 + c4); *(f32x4*)(xin + r * 128 + c4) = v; }
    if (tid < 128) { ct[tid] = cospif((float)tid * (1.0f / 64.0f)); ct[128 + tid] = sinpif((float)tid * (1.0f / 64.0f)); }
    __syncthreads();
    { const int jj = tid & 255, cs = jj >> 7, j = jj & 127, half = tid >> 8; float a[8];
#pragma unroll
      for (int r = 0; r < 8; ++r) a[r] = 0.f;
      const float* tb = ct + cs * 128; const float* xr = xin + half * 8 * 128;
      for (int c = 0; c < 128; ++c) { const float w = tb[(j * c) & 127];
#pragma unroll
          for (int r = 0; r < 8; ++r) a[r] += xr[r * 128 + c] * w; }
      *(u32x4*)(W1T + (size_t)(cs * 512 + g * 128 + j) * 1024 + kb * 16 + half * 8) = pack8(a); }
    __syncthreads();
}

__device__ __forceinline__ void wconv_phase(const P& p, int set, int l, float* tl) {
    bf16_t* W1T = (bf16_t*)(p.ws + WS_W1T); bf16_t* WMT = (bf16_t*)(p.ws + WS_WMT); bf16_t* WOT = (bf16_t*)(p.ws + WS_WOT);
    bf16_t* WUPT = (bf16_t*)(p.ws + WS_WUPT); bf16_t* WDNT = (bf16_t*)(p.ws + WS_WDNT);
    const float* win = p.in[5] + (size_t)l * 1024 * 7712;
    if (set == 0) {
        for (int it = lwg(); it < 1153; it += lnwg()) {
            if (it < 256) wfft_item(it, win, W1T, tl);
            else if (it < 768) { const int j = it - 256, tk = j & 15, tn = j >> 4; const int n0 = tn * 128;
                tconv_tile(win + 512, 7712, W1T + (size_t)1024 * 1024, 1024, tk * 64, n0, (n0 >= 1024 && n0 < 1536) ? 0.08838834764831845f : 1.0f, tl); }
            else if (it < 1152) { const int j = it - 768, tk = j & 15, tn = j >> 4;
                tconv_tile(win + 4640, 7712, W1T + (size_t)5120 * 1024, 1024, tk * 64, tn * 128, 1.0f, tl); }
            else { for (int i = ltid(); i < 256 * 1024; i += 512) { const int n = i >> 10, k = i & 1023;
                    W1T[(size_t)(8192 + n) * 1024 + k] = n < 32 ? f2bf(win[(size_t)k * 7712 + 4608 + n]) : (bf16_t)0; } }
        }
    } else if (set == 1) {
        for (int it = lwg(); it < 384; it += lnwg()) {
            if (it < 64) { const int tk = it & 7, tn = it >> 3; tconv_tile(p.in[7] + (size_t)l * 512 * 1024, 1024, WMT, 2048, tk * 64, tn * 128, 1.0f, tl); }
            else if (it < 128) { const int j = it - 64, tk = j & 7, tn = j >> 3; tconv_tile(p.in[11] + (size_t)l * 512 * 1024, 1024, WMT + 512, 2048, tk * 64, tn * 128, 1.0f, tl); }
            else if (it < 256) { const int j = it - 128, tk = j & 15, tn = j >> 4; tconv_tile(p.in[15] + (size_t)l * 1024 * 1024, 1024, WMT + 1024, 2048, tk * 64, tn * 128, 1.0f, tl); }
            else { const int j = it - 256, tk = j & 15, tn = j >> 4; tconv_tile(p.in[16] + (size_t)l * 1024 * 1024, 1024, WOT, 1024, tk * 64, tn * 128, 1.0f, tl); }
        }
    } else {
        for (int it = lwg(); it < 1056; it += lnwg()) {
            if (it < 704) { const int tk = it & 15, tn = it >> 4; tconv_tile(p.in[21] + (size_t)l * 1024 * 5632, 5632, WUPT, 1024, tk * 64, tn * 128, 1.0f, tl); }
            else { const int j = it - 704, tn = j & 7, tk = j >> 3; tconv_tile(p.in[24] + (size_t)l * DFF * 1024, 1024, WDNT, DFF, tk * 64, tn * 128, 1.0f, tl); }
        }
    }
}

__device__ __forceinline__ void ln_phase(const float* src_ctx, const float* src_lat, float* xout, const float* g, const float* b, bool doLN,
                                         bool doH, const float* modl, int sci, int shi, bf16_t* H) {
    const int lane = ltid() & 63, gw = lwg() * 8 + (ltid() >> 6), nw = lnwg() * 8;
    for (int row = gw; row < NTOK; row += nw) {
        const float* src = row < NCTX ? src_ctx + (size_t)row * 1024 : src_lat + (size_t)(row - NCTX) * 1024;
        f32x4 v[4];
#pragma unroll
        for (int i = 0; i < 4; ++i) v[i] = *(const f32x4*)(src + i * 256 + lane * 4);
        if (doLN) {
            float s = 0.f;
#pragma unroll
            for (int i = 0; i < 4; ++i) s += (v[i][0] + v[i][1]) + (v[i][2] + v[i][3]);
            const float mean = wave_sum(s) * (1.0f / 1024.0f); float q = 0.f;
#pragma unroll
            for (int i = 0; i < 4; ++i) { const f32x4 d = v[i] - mean; q += (d[0] * d[0] + d[1] * d[1]) + (d[2] * d[2] + d[3] * d[3]); }
            const float rstd = rsqrtf(wave_sum(q) * (1.0f / 1024.0f) + 1e-5f);
#pragma unroll
            for (int i = 0; i < 4; ++i) { const f32x4 gg = *(const f32x4*)(g + i * 256 + lane * 4), bb = *(const f32x4*)(b + i * 256 + lane * 4);
                v[i] = (v[i] - mean) * rstd * gg + bb; *(f32x4*)(xout + (size_t)row * 1024 + i * 256 + lane * 4) = v[i]; }
        }
        if (doH) {
            const int cond = row < NCTX ? 0 : 1 + ((row - NCTX) >> 11);
            const float* mp = modl + (size_t)cond * 6144;
            float s = 0.f;
#pragma unroll
            for (int i = 0; i < 4; ++i) s += (v[i][0] + v[i][1]) + (v[i][2] + v[i][3]);
            const float mean = wave_sum(s) * (1.0f / 1024.0f); float q = 0.f;
#pragma unroll
            for (int i = 0; i < 4; ++i) { const f32x4 d = v[i] - mean; q += (d[0] * d[0] + d[1] * d[1]) + (d[2] * d[2] + d[3] * d[3]); }
            const float rstd = rsqrtf(wave_sum(q) * (1.0f / 1024.0f) + 1e-5f);
#pragma unroll
            for (int i = 0; i < 4; ++i) { const f32x4 scv = *(const f32x4*)(mp + sci * 1024 + i * 256 + lane * 4), shv = *(const f32x4*)(mp + shi * 1024 + i * 256 + lane * 4);
                const f32x4 h = (v[i] - mean) * rstd * (1.0f + scv) + shv;
                u32x2 w; w.x = cvt_pk_bf16(h[0], h[1]); w.y = cvt_pk_bf16(h[2], h[3]);
                *(u32x2*)(H + (size_t)row * 1024 + i * 256 + lane * 4) = w; }
        }
    }
}

__device__ __forceinline__ void glapost_phase(bf16_t* AM, const bf16_t* OB, const bf16_t* Z, const float* ng) {
    const int lane = ltid() & 63, gw = lwg() * 8 + (ltid() >> 6), nw = lnwg() * 8;
    float gn[16];
#pragma unroll
    for (int j = 0; j < 16; ++j) gn[j] = ng[(lane & 15) * 16 + j];
    for (int row = gw; row < NTOK; row += nw) {
        bf16_t* op = AM + (size_t)row * 2048 + 1024 + lane * 16;
        const bf16_t* bp = OB + (size_t)row * 1024 + lane * 16;
        const bf16_t* rp = Z + (size_t)row * ZLD + ZR + lane * 16;
        float a[16], bq[16], r[16];
        { float t[8]; unpack8(*(const u32x4*)op, t);
#pragma unroll
          for (int j = 0; j < 8; ++j) a[j] = t[j];
          unpack8(*(const u32x4*)(op + 8), t);
#pragma unroll
          for (int j = 0; j < 8; ++j) a[8 + j] = t[j];
          unpack8(*(const u32x4*)bp, t);
#pragma unroll
          for (int j = 0; j < 8; ++j) bq[j] = t[j];
          unpack8(*(const u32x4*)(bp + 8), t);
#pragma unroll
          for (int j = 0; j < 8; ++j) bq[8 + j] = t[j];
          unpack8(*(const u32x4*)rp, t);
#pragma unroll
          for (int j = 0; j < 8; ++j) r[j] = t[j];
          unpack8(*(const u32x4*)(rp + 8), t);
#pragma unroll
          for (int j = 0; j < 8; ++j) r[8 + j] = t[j]; }
        float ss = 0.f;
#pragma unroll
        for (int j = 0; j < 16; ++j) { a[j] += bq[j]; ss += a[j] * a[j]; }
        ss += __shfl_xor(ss, 1); ss += __shfl_xor(ss, 2); ss += __shfl_xor(ss, 4); ss += __shfl_xor(ss, 8);
        const float rs = rsqrtf(ss * (1.0f / 256.0f) + 1e-5f);
        float o0[8], o1[8];
#pragma unroll
        for (int j = 0; j < 8; ++j) { o0[j] = a[j] * rs * gn[j] * r[j]; o1[j] = a[8 + j] * rs * gn[8 + j] * r[8 + j]; }
        *(u32x4*)op = pack8(o0); *(u32x4*)(op + 8) = pack8(o1);
    }
}

__device__ __forceinline__ void conv_phase(const bf16_t* AG, bf16_t* FF, const float* wdw, const float* bdw) {
    const size_t gt = (size_t)lwg() * 512 + ltid(), gn = (size_t)lnwg() * 512;
    for (size_t idx = gt; idx < (size_t)NTOK * 352; idx += gn) {
        const int row = (int)(idx / 352), ch = (int)(idx % 352) * 8;
        float acc[8];
        { const f32x4 b0 = *(const f32x4*)(bdw + ch), b1 = *(const f32x4*)(bdw + ch + 4);
#pragma unroll
          for (int j = 0; j < 4; ++j) { acc[j] = b0[j]; acc[4 + j] = b1[j]; } }
        if (row < NCTX) {
            const int t = row & 255;
#pragma unroll
            for (int dx = 0; dx < 3; ++dx) { const int tt = t + dx - 1; if (tt < 0 || tt > 255) continue;
                float a[8]; unpack8(*(const u32x4*)(AG + (size_t)(row + dx - 1) * 5632 + ch), a);
                const float* w = wdw + (3 + dx) * DFF + ch; const f32x4 w0 = *(const f32x4*)w, w1 = *(const f32x4*)(w + 4);
#pragma unroll
                for (int j = 0; j < 4; ++j) { acc[j] += a[j] * w0[j]; acc[4 + j] += a[4 + j] * w1[j]; } }
        } else {
            const int t = (row - NCTX) & 2047, gy = t >> 6, gx = t & 63;
#pragma unroll
            for (int dy = 0; dy < 3; ++dy) { const int yy = gy + dy - 1; if (yy < 0 || yy > 31) continue;
#pragma unroll
                for (int dx = 0; dx < 3; ++dx) { const int xx = gx + dx - 1; if (xx < 0 || xx > 63) continue;
                    float a[8]; unpack8(*(const u32x4*)(AG + (size_t)(row + (dy - 1) * 64 + (dx - 1)) * 5632 + ch), a);
                    const float* w = wdw + (dy * 3 + dx) * DFF + ch; const f32x4 w0 = *(const f32x4*)w, w1 = *(const f32x4*)(w + 4);
#pragma unroll
                    for (int j = 0; j < 4; ++j) { acc[j] += a[j] * w0[j]; acc[4 + j] += a[4 + j] * w1[j]; } } }
        }
        float gg[8]; unpack8(*(const u32x4*)(AG + (size_t)row * 5632 + DFF + ch), gg);
#pragma unroll
        for (int j = 0; j < 8; ++j) acc[j] = geluf_(acc[j]) * gg[j];
        *(u32x4*)(FF + (size_t)row * DFF + ch) = pack8(acc);
    }
}

__device__ __forceinline__ void sgu_item(int item, int l, const P& p, const bf16_t* Z, bf16_t* AM, unsigned char* lds) {
    const int tid = ltid(), wid = tid >> 6, lane = tid & 63, fr = lane & 15, fq = lane >> 4;
    float* STAT = (float*)lds;
    bf16_t* VT = (bf16_t*)(lds + 1024);
    const int row0 = item * 128;
    for (int i = 0; i < 16; ++i) { const int q = wid * 16 + i; float f[8]; unpack8(*(const u32x4*)(Z + (size_t)(row0 + q) * ZLD + ZV + lane * 8), f);
        float s = 0.f;
#pragma unroll
        for (int j = 0; j < 8; ++j) s += f[j];
        const float mean = wave_sum(s) * (1.0f / 512.0f); float qq = 0.f;
#pragma unroll
        for (int j = 0; j < 8; ++j) { const float d = f[j] - mean; qq += d * d; }
        const float rstd = rsqrtf(wave_sum(qq) * (1.0f / 512.0f) + 1e-5f);
        if (lane == 0) { STAT[q * 2] = mean; STAT[q * 2 + 1] = rstd; } }
    __syncthreads();
    for (int g = 0; g < 4; ++g) {
        { const int q = tid >> 2, seg = tid & 3; const float mean = STAT[q * 2], rstd = STAT[q * 2 + 1];
#pragma unroll
          for (int j4 = 0; j4 < 4; ++j4) { const int c0 = seg * 32 + j4 * 8; float f[8]; unpack8(*(const u32x4*)(Z + (size_t)(row0 + q) * ZLD + ZV + g * 128 + c0), f);
              const float* sg = p.in[8] + l * 512 + g * 128 + c0;
#pragma unroll
              for (int j = 0; j < 8; ++j) VT[(c0 + j) * 136 + q] = f2bf((f[j] - mean) * rstd * sg[j]); } }
        __syncthreads();
        bf16x8 Yf[4];
        { const float* wp = p.in[9] + ((size_t)(l * 4 + g) * 128 + wid * 16 + fr) * 128 + 8 * fq;
#pragma unroll
          for (int kk = 0; kk < 4; ++kk) { const f32x4 a = *(const f32x4*)(wp + kk * 32), b = *(const f32x4*)(wp + kk * 32 + 4);
              u32x4 w; w.x = cvt_pk_bf16(a[0], a[1]); w.y = cvt_pk_bf16(a[2], a[3]); w.z = cvt_pk_bf16(b[0], b[1]); w.w = cvt_pk_bf16(b[2], b[3]);
              Yf[kk] = __builtin_bit_cast(bf16x8, w); } }
        const int pp = wid * 16 + fr; const size_t tok = (size_t)(row0 + pp);
        const float bias = p.in[10][(l * 4 + g) * 128 + pp];
#pragma unroll
        for (int ct = 0; ct < 8; ++ct) { f32x4 acc = {0.f, 0.f, 0.f, 0.f};
#pragma unroll
            for (int kk = 0; kk < 4; ++kk) { const bf16x8 X = *(const bf16x8*)(VT + (ct * 16 + fr) * 136 + kk * 32 + 8 * fq);
                acc = __builtin_amdgcn_mfma_f32_16x16x32_bf16(X, Yf[kk], acc, 0, 0, 0); }
            const int c = ct * 16 + 4 * fq;
            const u32x2 uw = *(const u32x2*)(Z + tok * ZLD + ZU + g * 128 + c);
            const float u0 = bf2f(uw.x & 0xffffu), u1 = bf2f(uw.x >> 16), u2 = bf2f(uw.y & 0xffffu), u3 = bf2f(uw.y >> 16);
            u32x2 ow; ow.x = cvt_pk_bf16(u0 * (acc[0] + bias), u1 * (acc[1] + bias)); ow.y = cvt_pk_bf16(u2 * (acc[2] + bias), u3 * (acc[3] + bias));
            *(u32x2*)(AM + tok * 2048 + 512 + g * 128 + c) = ow; }
        __syncthreads();
    }
}

__device__ __forceinline__ void gla_item(int item, int l, const P& p, const bf16_t* Z, const float* LR, bf16_t* AM, bf16_t* OB, unsigned char* lds) {
    const int tid = ltid(), wid = tid >> 6, lane = tid & 63, fr = lane & 15, fq = lane >> 4;
    bf16_t* QG = (bf16_t*)lds;
    bf16_t* KG = (bf16_t*)(lds + 17408);
    bf16_t* KDT = (bf16_t*)(lds + 34816);
    bf16_t* VT = (bf16_t*)(lds + 53248);
    bf16_t* ST = (bf16_t*)(lds + 62464);
    bf16_t* AB = (bf16_t*)(lds + 79872);
    float* LRS = (float*)(lds + 89088);
    float* GT = (float*)(lds + 93184);
    float* GLAST = (float*)(lds + 95232);
    int b, h, dir, vs, T, seq0; const bool lat = item < 256;
    { const int idx = lat ? item : item - 256; vs = idx & 3; dir = (idx >> 2) & 1; h = (idx >> 3) & 3; b = idx >> 5; }
    if (lat) { T = 2048; seq0 = NCTX + b * 2048; } else { T = 256; seq0 = b * 256; }
    const int kc = tid & 127, lg = tid >> 7;
    float w2r[16];
#pragma unroll
    for (int r = 0; r < 16; ++r) w2r[r] = p.in[12][((size_t)(l * 2 + dir) * 16 + r) * 512 + h * 128 + kc];
    const float gbias = p.in[13][(l * 2 + dir) * 512 + h * 128 + kc];
    f32x4 S[4];
    if (lat) { const float* sp = p.in[2] + ((size_t)((b * 4 + l) * 2 + dir) * 4 + h) * 128 * 256 + vs * 64;
#pragma unroll
        for (int jt = 0; jt < 4; ++jt)
#pragma unroll
            for (int r = 0; r < 4; ++r) S[jt][r] = sp[(size_t)(wid * 16 + 4 * fq + r) * 256 + jt * 16 + fr]; }
    else {
#pragma unroll
        for (int jt = 0; jt < 4; ++jt) S[jt] = (f32x4){0.f, 0.f, 0.f, 0.f}; }
    bf16_t* obuf = dir ? OB : AM + 1024; const int ldo = dir ? 1024 : 2048;
    const int nch = T / 64;
    for (int n = 0; n < nch; ++n) {
#pragma unroll
        for (int jt = 0; jt < 4; ++jt) { u32x2 w; w.x = cvt_pk_bf16(S[jt][0], S[jt][1]); w.y = cvt_pk_bf16(S[jt][2], S[jt][3]);
            *(u32x2*)(ST + (jt * 16 + fr) * 136 + wid * 16 + 4 * fq) = w; }
        const int pos0 = n * 64;
        if (tid < 256) { const int li = tid >> 2, part = tid & 3; const int tok = seq0 + (dir ? T - 1 - (pos0 + li) : pos0 + li);
            *(f32x4*)(LRS + li * 16 + part * 4) = *(const f32x4*)(LR + (size_t)tok * 32 + dir * 16 + part * 4); }
        { const int li = tid >> 3, seg = tid & 7; const int tok = seq0 + (dir ? T - 1 - (pos0 + li) : pos0 + li);
          const u32x4 w = *(const u32x4*)(Z + (size_t)tok * ZLD + ZVV + h * 256 + vs * 64 + seg * 8);
          bf16_t* q = VT + (seg * 8) * 72 + li;
          q[0] = (bf16_t)(w.x & 0xffffu); q[72] = (bf16_t)(w.x >> 16); q[144] = (bf16_t)(w.y & 0xffffu); q[216] = (bf16_t)(w.y >> 16);
          q[288] = (bf16_t)(w.z & 0xffffu); q[360] = (bf16_t)(w.z >> 16); q[432] = (bf16_t)(w.w & 0xffffu); q[504] = (bf16_t)(w.w >> 16); }
        float qv[16], kv[16];
#pragma unroll
        for (int i = 0; i < 16; ++i) { const int li = lg * 16 + i; const int tok = seq0 + (dir ? T - 1 - (pos0 + li) : pos0 + li);
            const bf16_t* zr = Z + (size_t)tok * ZLD + h * 128 + kc; qv[i] = bf2f(zr[ZQ]); kv[i] = bf2f(zr[ZK]); }
        __syncthreads();
        float Gl[16]; float run = 0.f;
#pragma unroll
        for (int i = 0; i < 16; ++i) { const float* lr = LRS + (lg * 16 + i) * 16; float z = gbias;
#pragma unroll
            for (int r = 0; r < 16; ++r) z += lr[r] * w2r[r];
            const float ls = fminf(z, 0.f) - __logf(1.0f + __expf(-fabsf(z)));
            run += ls * (1.0f / 16.0f); Gl[i] = run; }
        GT[lg * 128 + kc] = run;
        __syncthreads();
        float pre = 0.f, tot = 0.f;
#pragma unroll
        for (int g4 = 0; g4 < 4; ++g4) { const float t = GT[g4 * 128 + kc]; tot += t; if (g4 < lg) pre += t; }
        if (lg == 0) GLAST[kc] = tot;
        { float kd[16];
#pragma unroll
          for (int i = 0; i < 16; ++i) { const float G = pre + Gl[i]; const int li = lg * 16 + i;
              QG[li * 136 + kc] = f2bf(qv[i] * __expf(G)); KG[li * 136 + kc] = f2bf(kv[i] * __expf(-G)); kd[i] = kv[i] * __expf(tot - G); }
          float k0[8], k1[8];
#pragma unroll
          for (int j = 0; j < 8; ++j) { k0[j] = kd[j]; k1[j] = kd[8 + j]; }
          *(u32x4*)(KDT + kc * 72 + lg * 16) = pack8(k0); *(u32x4*)(KDT + kc * 72 + lg * 16 + 8) = pack8(k1); }
        __syncthreads();
        { const int jt = wid >> 1, it0 = (wid & 1) * 2;
#pragma unroll
          for (int t = 0; t < 2; ++t) { const int it = it0 + t; f32x4 acc = {0.f, 0.f, 0.f, 0.f};
              if (it <= jt) {
#pragma unroll
                  for (int kk = 0; kk < 4; ++kk) { const bf16x8 X = *(const bf16x8*)(KG + (it * 16 + fr) * 136 + kk * 32 + 8 * fq), Y = *(const bf16x8*)(QG + (jt * 16 + fr) * 136 + kk * 32 + 8 * fq);
                      acc = __builtin_amdgcn_mfma_f32_16x16x32_bf16(X, Y, acc, 0, 0, 0); } }
              const int li = jt * 16 + fr, m0 = it * 16 + 4 * fq;
              u32x2 w; w.x = cvt_pk_bf16(m0 <= li ? acc[0] : 0.f, m0 + 1 <= li ? acc[1] : 0.f); w.y = cvt_pk_bf16(m0 + 2 <= li ? acc[2] : 0.f, m0 + 3 <= li ? acc[3] : 0.f);
              *(u32x2*)(AB + li * 72 + m0) = w; } }
        __syncthreads();
        { const int jt = wid >> 1, it0 = (wid & 1) * 2; const int li = jt * 16 + fr; const int tok = seq0 + (dir ? T - 1 - (pos0 + li) : pos0 + li);
#pragma unroll
          for (int t = 0; t < 2; ++t) { const int it = it0 + t; f32x4 acc = {0.f, 0.f, 0.f, 0.f};
#pragma unroll
              for (int kk = 0; kk < 2; ++kk) { const bf16x8 X = *(const bf16x8*)(VT + (it * 16 + fr) * 72 + kk * 32 + 8 * fq), Y = *(const bf16x8*)(AB + (jt * 16 + fr) * 72 + kk * 32 + 8 * fq);
                  acc = __builtin_amdgcn_mfma_f32_16x16x32_bf16(X, Y, acc, 0, 0, 0); }
#pragma unroll
              for (int kk = 0; kk < 4; ++kk) { const bf16x8 X = *(const bf16x8*)(ST + (it * 16 + fr) * 136 + kk * 32 + 8 * fq), Y = *(const bf16x8*)(QG + (jt * 16 + fr) * 136 + kk * 32 + 8 * fq);
                  acc = __builtin_amdgcn_mfma_f32_16x16x32_bf16(X, Y, acc, 0, 0, 0); }
              u32x2 w; w.x = cvt_pk_bf16(acc[0], acc[1]); w.y = cvt_pk_bf16(acc[2], acc[3]);
              *(u32x2*)(obuf + (size_t)tok * ldo + h * 256 + vs * 64 + it * 16 + 4 * fq) = w; } }
        { float dec[4];
#pragma unroll
          for (int r = 0; r < 4; ++r) dec[r] = __expf(GLAST[wid * 16 + 4 * fq + r]);
#pragma unroll
          for (int jt = 0; jt < 4; ++jt) { f32x4 acc;
#pragma unroll
              for (int r = 0; r < 4; ++r) acc[r] = S[jt][r] * dec[r];
#pragma unroll
              for (int kk = 0; kk < 2; ++kk) { const bf16x8 X = *(const bf16x8*)(KDT + (wid * 16 + fr) * 72 + kk * 32 + 8 * fq), Y = *(const bf16x8*)(VT + (jt * 16 + fr) * 72 + kk * 32 + 8 * fq);
                  acc = __builtin_amdgcn_mfma_f32_16x16x32_bf16(X, Y, acc, 0, 0, 0); }
              S[jt] = acc; } }
        __syncthreads();
    }
    if (!lat) { float* sp = p.out + (size_t)NTOK * 1024 + ((size_t)((b * 4 + l) * 2 + dir) * 4 + h) * 128 * 256 + vs * 64;
#pragma unroll
        for (int jt = 0; jt < 4; ++jt)
#pragma unroll
            for (int r = 0; r < 4; ++r) sp[(size_t)(wid * 16 + 4 * fq + r) * 256 + jt * 16 + fr] = S[jt][r]; }
}

template <int PH>
__device__ __forceinline__ void run_phase(const P& p, int l, unsigned char* shm) {
    LAS unsigned char* lds = (LAS unsigned char*)shm;
    const int wg = lwg(), nwg = lnwg();
    unsigned char* wsb = p.ws; asm volatile("" : "+s"(wsb));
    float* MOD = (float*)(wsb + WS_MOD);
    bf16_t* DLAT = (bf16_t*)(wsb + WS_DLAT); bf16_t* DCTX = (bf16_t*)(wsb + WS_DCTX);
    bf16_t* W1T = (bf16_t*)(wsb + WS_W1T); bf16_t* WMT = (bf16_t*)(wsb + WS_WMT); bf16_t* WOT = (bf16_t*)(wsb + WS_WOT);
    bf16_t* WUPT = (bf16_t*)(wsb + WS_WUPT); bf16_t* WDNT = (bf16_t*)(wsb + WS_WDNT);
    bf16_t* H = (bf16_t*)(wsb + WS_H); bf16_t* XTc = (bf16_t*)(wsb + WS_XT); bf16_t* XTl = (bf16_t*)(wsb + WS_XTL); bf16_t* Mb = (bf16_t*)(wsb + WS_XT);
    bf16_t* Z = (bf16_t*)(wsb + WS_Z); float* LR = (float*)(wsb + WS_LR); bf16_t* AM = (bf16_t*)(wsb + WS_AM);
    bf16_t* AG = (bf16_t*)(wsb + WS_AG); bf16_t* FF = (bf16_t*)(wsb + WS_FF);
    float* X = p.out;
    const float* modl = MOD + (size_t)l * 9 * 6144;
    if constexpr (PH == 0) {
        mods_phase(p, MOD, (float*)shm);
        dft_phase(DLAT, DCTX);
        wconv_phase(p, 0, 0, (float*)shm);
        wconv_phase(p, 1, 0, (float*)shm);
    } else if constexpr (PH == 1) {
        ln_phase(p.in[0], p.in[1], nullptr, nullptr, nullptr, false, true, MOD, 1, 0, H);
    } else if constexpr (PH == 2) {
        SchedStd S{H, W1T, 1024, 1024, 1024, 80, 33, nwg, wg}; EpiIn E{Z, XTc, XTl, LR, p.in[6] + l * 3072}; gemm_phase(lds, S, E);
    } else if constexpr (PH == 3) {
        if (wg < NFFT_WG) {
            { SchedFftL S{DLAT, XTl, 4096, 4096, 4096, NFFT_WG, wg}; EpiBf16 E{AM, 2048}; gemm_phase(lds, S, E); }
            { SchedFftC S{DCTX, XTc, 512, 512, 512, NFFT_WG, wg}; EpiBf16 E{AM, 2048}; gemm_phase(lds, S, E); }
        }
    } else if constexpr (PH == 4) {
        if (wg >= NFFT_WG) {
            const int gi = wg - NFFT_WG, gn = nwg - NFFT_WG;
            for (int it = gi; it < 768; it += gn) gla_item(it, l, p, Z, LR, AM, H, shm);
            for (int it = gi; it < 160; it += gn) sgu_item(it, l, p, Z, AM, shm);
        }
    } else if constexpr (PH == 5) {
        glapost_phase(AM, H, Z, p.in[14] + l * 256);
        wconv_phase(p, 2, l, (float*)shm);
    } else if constexpr (PH == 6) {
        SchedMerge S{AM, WMT, 2048, 2048, 512, nwg, wg}; EpiMerge E{Mb, Z}; gemm_phase(lds, S, E);
    } else if constexpr (PH == 7) {
        const float* xc = l == 0 ? p.in[0] : X; const float* xl = l == 0 ? p.in[1] : X + (size_t)NCTX * 1024;
        SchedStd S{Mb, WOT, 1024, 1024, 1024, 80, 4, nwg, wg}; EpiResid E{xc, xl, X, modl + 2 * 1024}; gemm_phase(lds, S, E);
    } else if constexpr (PH == 8) {
        ln_phase(X, X + (size_t)NCTX * 1024, X, p.in[17] + l * 1024, p.in[18] + l * 1024, true, true, modl, 4, 3, H);
    } else if constexpr (PH == 9) {
        SchedStd S{H, WUPT, 1024, 1024, 1024, 80, 22, nwg, wg}; EpiBf16 E{AG, 5632}; gemm_phase(lds, S, E);
    } else if constexpr (PH == 10) {
        conv_phase(AG, FF, p.in[22] + (size_t)l * 9 * DFF, p.in[23] + l * DFF);
        if (l + 1 < DEPTH) wconv_phase(p, 1, l + 1, (float*)shm);
    } else if constexpr (PH == 11) {
        SchedStd S{FF, WDNT, DFF, DFF, DFF, 80, 4, nwg, wg}; EpiResid E{X, X + (size_t)NCTX * 1024, X, modl + 5 * 1024}; gemm_phase(lds, S, E);
    } else if constexpr (PH == 12) {
        ln_phase(X, X + (size_t)NCTX * 1024, X, p.in[25] + l * 1024, p.in[26] + l * 1024, true, l + 1 < DEPTH, modl + 9 * 6144, 1, 0, H);
        if (l + 1 < DEPTH) wconv_phase(p, 0, l + 1, (float*)shm);
    }
}

#ifndef MULTI
#define MULTI 0
#endif

#if MULTI
template <int PH> __global__ void __launch_bounds__(512) k_phase(P p, int l) {
    extern __shared__ __attribute__((aligned(16))) unsigned char shm[];
    run_phase<PH>(p, l, shm);
}
template <int PH> static void launch_phase(const P& p, int l, int grid, hipStream_t stream) {
    static bool attr = false;
    if (!attr) { (void)hipFuncSetAttribute((const void*)k_phase<PH>, hipFuncAttributeMaxDynamicSharedMemorySize, LDS_BYTES); attr = true; }
    hipLaunchKernelGGL((k_phase<PH>), dim3(grid), dim3(512), LDS_BYTES, stream, p, l);
}
#else
#ifndef STOP_PH
#define STOP_PH 99
#endif
__device__ __forceinline__ void dump_phase(const P& p, int which) {
    unsigned char* wsb = p.ws; asm volatile("" : "+s"(wsb));
    const size_t gt = (size_t)lwg() * 512 + ltid(), gn = (size_t)lnwg() * 512;
    const bf16_t* AM = (const bf16_t*)(wsb + WS_AM); const bf16_t* Z = (const bf16_t*)(wsb + WS_Z); const bf16_t* Mb = (const bf16_t*)(wsb + WS_XT);
    const bf16_t* H = (const bf16_t*)(wsb + WS_H); const float* LR = (const float*)(wsb + WS_LR);
    for (size_t i = gt; i < (size_t)NTOK * 1024; i += gn) { const size_t row = i >> 10, c = i & 1023; float v = 0.f;
        if (which == 0) v = bf2f(AM[row * 2048 + c]) + bf2f(AM[row * 2048 + 1024 + c]);
        else if (which == 1) { for (int j = 0; j < 7; ++j) v += bf2f(Z[row * ZLD + j * 1024 + c]); v += LR[row * 32 + (c & 31)] + bf2f(Mb[i]); }
        else if (which == 2) v = bf2f(Mb[i]);
        else if (which == 3) v = bf2f(H[i]);
        else if (which == 4) { const bf16_t* AG = (const bf16_t*)(wsb + WS_AG); for (int j = 0; j < 5; ++j) v += bf2f(AG[row * 5632 + j * 1024 + c]); }
        else if (which == 5) { const bf16_t* FF = (const bf16_t*)(wsb + WS_FF); v = bf2f(FF[row * DFF + c]) + bf2f(FF[row * DFF + 1024 + c]); }
        p.out[i] = v; }
}
__global__ void __launch_bounds__(512) fwd_megakernel(P p) {
    extern __shared__ __attribute__((aligned(16))) unsigned char shm[];
    cg::grid_group grid = cg::this_grid();
    run_phase<0>(p, 0, shm); grid.sync();
    run_phase<1>(p, 0, shm); grid.sync();
#pragma unroll 1
    for (int l = 0; l < DEPTH; ++l) {
        run_phase<2>(p, l, shm); grid.sync();
        if (STOP_PH == 2) { dump_phase(p, 1); return; }
        run_phase<3>(p, l, shm);
        run_phase<4>(p, l, shm); grid.sync();
        run_phase<5>(p, l, shm); grid.sync();
        if (STOP_PH == 5) { dump_phase(p, 0); return; }
        run_phase<6>(p, l, shm); grid.sync();
        if (STOP_PH == 6) { dump_phase(p, 2); return; }
        run_phase<7>(p, l, shm); grid.sync();
        if (STOP_PH == 7) return;
        run_phase<8>(p, l, shm); grid.sync();
        if (STOP_PH == 8) { grid.sync(); dump_phase(p, 3); return; }
        run_phase<9>(p, l, shm); grid.sync();
        if (STOP_PH == 9) { dump_phase(p, 4); return; }
        run_phase<10>(p, l, shm); grid.sync();
        if (STOP_PH == 10) { dump_phase(p, 5); return; }
        run_phase<11>(p, l, shm); grid.sync();
        if (STOP_PH == 11) return;
        run_phase<12>(p, l, shm); grid.sync();
        if (STOP_PH == 12) return;
    }
}
#endif

extern "C" void kernel_launch(void* const* d_in, const int* in_sizes, int n_in, void* d_out, int out_size, void* d_ws, size_t ws_size, hipStream_t stream) {
    P p{};
    for (int i = 0; i < 27; ++i) p.in[i] = (const float*)d_in[i];
    p.out = (float*)d_out; p.ws = (unsigned char*)d_ws;
    if (ws_size < WS_END) { fprintf(stderr, "kernel_launch: workspace too small: %zu < %zu\n", ws_size, (size_t)WS_END); }
#if MULTI
    const int grid = 256;
    launch_phase<0>(p, 0, grid, stream);
    launch_phase<1>(p, 0, grid, stream);
    for (int l = 0; l < DEPTH; ++l) {
        launch_phase<2>(p, l, grid, stream);
        launch_phase<3>(p, l, grid, stream);
        launch_phase<4>(p, l, grid, stream);
        launch_phase<5>(p, l, grid, stream);
        launch_phase<6>(p, l, grid, stream);
        launch_phase<7>(p, l, grid, stream);
        launch_phase<8>(p, l, grid, stream);
        launch_phase<9>(p, l, grid, stream);
        launch_phase<10>(p, l, grid, stream);
        launch_phase<11>(p, l, grid, stream);
        launch_phase<12>(p, l, grid, stream);
    }
#else
    static int grid_blocks = 0;
    if (!grid_blocks) {
        int dev = 0, cus = 0, per_cu = 0;
        (void)hipGetDevice(&dev);
        (void)hipDeviceGetAttribute(&cus, hipDeviceAttributeMultiprocessorCount, dev);
        (void)hipFuncSetAttribute((const void*)fwd_megakernel, hipFuncAttributeMaxDynamicSharedMemorySize, LDS_BYTES);
        (void)hipOccupancyMaxActiveBlocksPerMultiprocessor(&per_cu, (const void*)fwd_megakernel, 512, LDS_BYTES);
        if (per_cu < 1) per_cu = 1;
        grid_blocks = cus * per_cu;
    }
    void* args[] = {&p};
    hipError_t e = hipLaunchCooperativeKernel((const void*)fwd_megakernel, dim3(grid_blocks), dim3(512), args, LDS_BYTES, stream);
    if (e != hipSuccess) fprintf(stderr, "cooperative launch failed: %s (grid %d)\n", hipGetErrorString(e), grid_blocks);
#endif
}
```

```cpp
#include <hip/hip_runtime.h>
#include <hip/hip_cooperative_groups.h>
#include <cstdio>
namespace cg = cooperative_groups;

#define LAS __attribute__((address_space(3)))
typedef unsigned short bf16_t;
typedef short bf16x8 __attribute__((ext_vector_type(8)));
typedef float f32x4 __attribute__((ext_vector_type(4)));
typedef float f32x2 __attribute__((ext_vector_type(2)));
typedef unsigned u32x4 __attribute__((ext_vector_type(4)));
typedef unsigned u32x2 __attribute__((ext_vector_type(2)));

constexpr int D = 1024, NTOK = 20480, NCTX = 4096, DEPTH = 4;
constexpr int ZLD = 7168;
constexpr int ZU = 0, ZV = 512, ZQ = 1024, ZK = 1536, ZVV = 2048, ZR = 3072, ZG = 4096;
constexpr int N1 = 8448;
constexpr int DFF = 2816;
constexpr int NFFT_WG = 128;

constexpr size_t WS_MOD  = 0;
constexpr size_t WS_DLAT = WS_MOD + 4ull * 9 * 6144 * 4;
constexpr size_t WS_DCTX = WS_DLAT + 2048ull * 4096 * 2;
constexpr size_t WS_W1T  = WS_DCTX + 256ull * 512 * 2;
constexpr size_t WS_WUPT = WS_W1T;
constexpr size_t WS_WDNT = WS_W1T + 5632ull * 1024 * 2;
constexpr size_t WS_WMT  = WS_W1T + (size_t)N1 * 1024 * 2;
constexpr size_t WS_WOT  = WS_WMT + 1024ull * 2048 * 2;
constexpr size_t WS_H    = WS_WOT + 1024ull * 1024 * 2;
constexpr size_t WS_XT   = WS_H + (size_t)NTOK * 1024 * 2;
constexpr size_t WS_XTL  = WS_XT + 16ull * 512 * 512 * 2;
constexpr size_t WS_Z    = WS_XT + (size_t)NTOK * 1024 * 2;
constexpr size_t WS_LR   = WS_Z + (size_t)NTOK * ZLD * 2;
constexpr size_t WS_AM   = WS_LR + (size_t)NTOK * 32 * 4;
constexpr size_t WS_END  = WS_AM + (size_t)NTOK * 2048 * 2;
constexpr size_t WS_AG   = WS_Z;
constexpr size_t WS_FF   = WS_Z + (size_t)NTOK * 5632 * 2;
static_assert(WS_FF + (size_t)NTOK * DFF * 2 <= WS_END, "ffn alias");

constexpr int LDS_BYTES = 131072 + 8192;

struct P {
    const float* in[27];
    float* out;
    unsigned char* ws;
};

__device__ __forceinline__ int ltid() { int t = threadIdx.x; asm volatile("" : "+v"(t)); return t; }
__device__ __forceinline__ int lwg() { int b = blockIdx.x; asm volatile("" : "+s"(b)); return b; }
__device__ __forceinline__ int lnwg() { int b = gridDim.x; asm volatile("" : "+s"(b)); return b; }

__device__ __forceinline__ float bf2f(unsigned v) { return __uint_as_float(v << 16); }
typedef __bf16 bf2_t __attribute__((ext_vector_type(2)));
__device__ __forceinline__ unsigned cvt_pk_bf16(float lo, float hi) { const f32x2 v = {lo, hi}; const bf2_t b = __builtin_convertvector(v, bf2_t); return __builtin_bit_cast(unsigned, b); }
__device__ __forceinline__ bf16_t f2bf(float f) { return (bf16_t)(cvt_pk_bf16(f, 0.f) & 0xffffu); }
__device__ __forceinline__ float sigmoidf_(float x) { return 1.0f / (1.0f + __expf(-x)); }
__device__ __forceinline__ float siluf_(float x) { return x / (1.0f + __expf(-x)); }
__device__ __forceinline__ float geluf_(float x) { const float y = 1.5957691216057308f * (x + 0.044715f * x * x * x); return x / (1.0f + __expf(-y)); }
__device__ __forceinline__ float wave_sum(float v) {
#pragma unroll
    for (int o = 32; o >= 1; o >>= 1) v += __shfl_xor(v, o);
    return v;
}
__device__ __forceinline__ void unpack8(const u32x4 w, float (&f)[8]) {
    f[0] = bf2f(w.x & 0xffffu); f[1] = bf2f(w.x >> 16); f[2] = bf2f(w.y & 0xffffu); f[3] = bf2f(w.y >> 16);
    f[4] = bf2f(w.z & 0xffffu); f[5] = bf2f(w.z >> 16); f[6] = bf2f(w.w & 0xffffu); f[7] = bf2f(w.w >> 16);
}
__device__ __forceinline__ u32x4 pack8(const float (&f)[8]) {
    u32x4 w; w.x = cvt_pk_bf16(f[0], f[1]); w.y = cvt_pk_bf16(f[2], f[3]); w.z = cvt_pk_bf16(f[4], f[5]); w.w = cvt_pk_bf16(f[6], f[7]); return w;
}

constexpr int BM = 256, BK = 64, HALF = 128, HTB = HALF * BK * 2;
__device__ __forceinline__ int lds_byte(int r, int c) { const int st = (r >> 4) * 2 + (c >> 5), rr = r & 15, cc = c & 31, ob = rr * 64 + cc * 2; return st * 1024 + (ob ^ (((ob >> 9) & 1) << 5)); }
__device__ __forceinline__ void stage_rc(int b, int& R, int& C) { const int st = b / 1024, sb = b % 1024, swz = sb ^ (((sb >> 9) & 1) << 5); R = (st >> 1) * 16 + swz / 64; C = (st & 1) * 32 + (swz % 64) / 2; }
__device__ __forceinline__ int perm32(int rho) { const int n = rho >> 4, i = rho & 15; return 8 * (i >> 2) + 4 * n + (i & 3); }

struct Unit { int pm, pn, aux; };

__device__ __forceinline__ void tile_map(int L, int nM, int nN, int& pm, int& pn) {
    const int nwg = nM * nN; int wgid = L;
    { const int q = nwg / 8, r = nwg % 8, xcd = wgid % 8, off = wgid / 8; wgid = (xcd < r ? xcd * (q + 1) : r * (q + 1) + (xcd - r) * q) + off; }
    const int nig = 8 * nN, gid = wgid / nig, fm = gid * 8, gsz = (nM - fm) < 8 ? (nM - fm) : 8;
    pm = fm + ((wgid % nig) % gsz); pn = (wgid % nig) / gsz;
}

struct SchedStd {
    const bf16_t* A; const bf16_t* Bt; int lda, ldb, K, nM, nN, G, c;
    __device__ __forceinline__ bool next(int i, Unit& u) const { const int L = i * G + c; if (L >= nM * nN) return false; tile_map(L, nM, nN, u.pm, u.pn); u.aux = 0; return true; }
    __device__ __forceinline__ const char* a_ptr(const Unit& u) const { return (const char*)A + (size_t)u.pm * 256 * lda * 2; }
    __device__ __forceinline__ const char* b_ptr(const Unit& u) const { return (const char*)Bt + (size_t)u.pn * 256 * ldb * 2; }
};
struct SchedMerge {
    const bf16_t* A; const bf16_t* Bt; int lda, ldb, K, G, c;
    __device__ __forceinline__ bool next(int i, Unit& u) const { const int L = (i >> 2) * G + c; if (L >= 320) return false; tile_map(L, 80, 4, u.pm, u.pn); u.aux = i & 3; return true; }
    __device__ __forceinline__ const char* a_ptr(const Unit& u) const { return (const char*)A + ((size_t)u.pm * 256 * lda + u.aux * 512) * 2; }
    __device__ __forceinline__ const char* b_ptr(const Unit& u) const { return (const char*)Bt + ((size_t)u.pn * 256 * ldb + u.aux * 512) * 2; }
};
struct SchedFftL {
    const bf16_t* A; const bf16_t* Bt; int lda, ldb, K, G, c;
    __device__ __forceinline__ bool next(int i, Unit& u) const { const int L = i * G + c; if (L >= 128) return false; const int b = L >> 4, rem = L & 15; u.pm = 16 + b * 8 + (rem >> 1); u.pn = rem & 1; u.aux = b; return true; }
    __device__ __forceinline__ const char* a_ptr(const Unit& u) const { return (const char*)A + (size_t)((u.pm - 16) & 7) * 256 * 4096 * 2; }
    __device__ __forceinline__ const char* b_ptr(const Unit& u) const { return (const char*)Bt + ((size_t)u.aux * 512 + u.pn * 256) * 4096 * 2; }
};
struct SchedFftC {
    const bf16_t* A; const bf16_t* Bt; int lda, ldb, K, G, c;
    __device__ __forceinline__ bool next(int i, Unit& u) const { const int L = i * G + c; if (L >= 32) return false; u.pm = L >> 1; u.pn = L & 1; u.aux = 0; return true; }
    __device__ __forceinline__ const char* a_ptr(const Unit&) const { return (const char*)A; }
    __device__ __forceinline__ const char* b_ptr(const Unit& u) const { return (const char*)Bt + ((size_t)u.pm * 512 + u.pn * 256) * 512 * 2; }
};

struct EpiIn {
    static constexpr bool PERM = true;
    bf16_t* Z; bf16_t* XTc; bf16_t* XTl; float* LR; const float* bmerge;
    __device__ __forceinline__ void operator()(const f32x4 (&acc)[2][2][4][2], const Unit& u, int wr, int wc, int fr, int fq) const {
        const int pn = u.pn, cl = wc * 32 + 8 * fq;
        if (pn < 4) {
            bf16_t* base; int ldk, t0; const int cs = pn >> 1;
            if (u.pm < 16) { base = XTc + (size_t)u.pm * 512 * 512; ldk = 512; t0 = cs * 256; }
            else { const int b = (u.pm - 16) >> 3; base = XTl + (size_t)b * 512 * 4096; ldk = 4096; t0 = cs * 2048 + ((u.pm - 16) & 7) * 256; }
            t0 += wr * 64 + fr;
#pragma unroll
            for (int ai = 0; ai < 2; ++ai)
#pragma unroll
                for (int m = 0; m < 4; ++m) { const int t = t0 + ai * 128 + m * 16;
#pragma unroll
                    for (int bj = 0; bj < 2; ++bj)
#pragma unroll
                        for (int n = 0; n < 2; ++n) { const int c = (pn & 1) * 256 + bj * 128 + cl + n * 4; const f32x4 v = acc[ai][bj][m][n];
                            const unsigned p0 = cvt_pk_bf16(v[0], v[1]), p1 = cvt_pk_bf16(v[2], v[3]);
                            bf16_t* q = base + (size_t)c * ldk + t;
                            q[0] = (bf16_t)(p0 & 0xffffu); q[ldk] = (bf16_t)(p0 >> 16); q[2 * ldk] = (bf16_t)(p1 & 0xffffu); q[3 * ldk] = (bf16_t)(p1 >> 16); } }
        } else if (pn < 32) {
            const int zc0 = (pn - 4) * 256 + cl;
            const int mode = pn < 8 ? 1 : (pn < 16 ? 0 : (pn < 20 ? 2 : 3));
            f32x4 bv[2][2];
#pragma unroll
            for (int bj = 0; bj < 2; ++bj)
#pragma unroll
                for (int n = 0; n < 2; ++n) bv[bj][n] = (mode == 3) ? *(const f32x4*)(bmerge + (zc0 - ZG) + bj * 128 + n * 4) : (f32x4){0.f, 0.f, 0.f, 0.f};
            const int row0 = u.pm * 256 + wr * 64 + fr;
#pragma unroll
            for (int ai = 0; ai < 2; ++ai)
#pragma unroll
                for (int m = 0; m < 4; ++m) { bf16_t* rowp = Z + (size_t)(row0 + ai * 128 + m * 16) * ZLD + zc0;
#pragma unroll
                    for (int bj = 0; bj < 2; ++bj) { float f[8];
#pragma unroll
                        for (int j = 0; j < 4; ++j) { f[j] = acc[ai][bj][m][0][j] + bv[bj][0][j]; f[4 + j] = acc[ai][bj][m][1][j] + bv[bj][1][j]; }
                        if (mode == 1) {
#pragma unroll
                            for (int j = 0; j < 8; ++j) f[j] = geluf_(f[j]); }
                        else if (mode == 2) {
#pragma unroll
                            for (int j = 0; j < 8; ++j) f[j] = siluf_(f[j]); }
                        else if (mode == 3) {
#pragma unroll
                            for (int j = 0; j < 8; ++j) f[j] = sigmoidf_(f[j]); }
                        *(u32x4*)(rowp + bj * 128) = pack8(f); } }
        } else {
            if (wc == 0) { const int row0 = u.pm * 256 + wr * 64 + fr;
#pragma unroll
                for (int ai = 0; ai < 2; ++ai)
#pragma unroll
                    for (int m = 0; m < 4; ++m) { float* q = LR + (size_t)(row0 + ai * 128 + m * 16) * 32 + 8 * fq;
                        *(f32x4*)q = acc[ai][0][m][0]; *(f32x4*)(q + 4) = acc[ai][0][m][1]; } }
        }
    }
};
struct EpiBf16 {
    static constexpr bool PERM = true;
    bf16_t* O; int ldc;
    __device__ __forceinline__ void operator()(const f32x4 (&acc)[2][2][4][2], const Unit& u, int wr, int wc, int fr, int fq) const {
        const int row0 = u.pm * 256 + wr * 64 + fr, col0 = u.pn * 256 + wc * 32 + 8 * fq;
#pragma unroll
        for (int ai = 0; ai < 2; ++ai)
#pragma unroll
            for (int m = 0; m < 4; ++m) { bf16_t* rowp = O + (size_t)(row0 + ai * 128 + m * 16) * ldc + col0;
#pragma unroll
                for (int bj = 0; bj < 2; ++bj) { const f32x4 v0 = acc[ai][bj][m][0], v1 = acc[ai][bj][m][1];
                    u32x4 w; w.x = cvt_pk_bf16(v0[0], v0[1]); w.y = cvt_pk_bf16(v0[2], v0[3]); w.z = cvt_pk_bf16(v1[0], v1[1]); w.w = cvt_pk_bf16(v1[2], v1[3]);
                    *(u32x4*)(rowp + bj * 128) = w; } }
    }
};
struct EpiMerge {
    static constexpr bool PERM = true;
    bf16_t* Mo; const bf16_t* Z;
    __device__ __forceinline__ void operator()(const f32x4 (&acc)[2][2][4][2], const Unit& u, int wr, int wc, int fr, int fq) const {
        const int br = u.aux, gb = br < 2 ? br : 2;
        const int row0 = u.pm * 256 + wr * 64 + fr, col0 = u.pn * 256 + wc * 32 + 8 * fq;
#pragma unroll
        for (int ai = 0; ai < 2; ++ai)
#pragma unroll
            for (int m = 0; m < 4; ++m) { const size_t row = (size_t)(row0 + ai * 128 + m * 16);
#pragma unroll
                for (int bj = 0; bj < 2; ++bj) {
                    float g[8], f[8]; unpack8(*(const u32x4*)(Z + row * ZLD + ZG + gb * 1024 + col0 + bj * 128), g);
#pragma unroll
                    for (int j = 0; j < 4; ++j) { f[j] = acc[ai][bj][m][0][j] * g[j]; f[4 + j] = acc[ai][bj][m][1][j] * g[4 + j]; }
                    bf16_t* op = Mo + row * 1024 + col0 + bj * 128;
                    if (br > 0) { float pv[8]; unpack8(*(const u32x4*)op, pv);
#pragma unroll
                        for (int j = 0; j < 8; ++j) f[j] += pv[j]; }
                    *(u32x4*)op = pack8(f); } }
    }
};
struct EpiResid {
    static constexpr bool PERM = false;
    const float* xin_ctx; const float* xin_lat; float* xout; const float* gate;
    __device__ __forceinline__ void operator()(const f32x4 (&acc)[2][2][4][2], const Unit& u, int wr, int wc, int fr, int fq) const {
        const float alpha = 1.681792830507429f;
        const int cond = u.pm < 16 ? 0 : 1 + ((u.pm - 16) >> 3);
        const int col0 = u.pn * 256 + wc * 32 + 4 * fq, row0 = u.pm * 256 + wr * 64 + fr;
        const float* gp = gate + (size_t)cond * 6144 + col0;
        f32x4 gv[2][2];
#pragma unroll
        for (int bj = 0; bj < 2; ++bj)
#pragma unroll
            for (int n = 0; n < 2; ++n) gv[bj][n] = *(const f32x4*)(gp + bj * 128 + n * 16);
        const float* xin = u.pm < 16 ? xin_ctx : xin_lat - (size_t)NCTX * 1024;
#pragma unroll
        for (int ai = 0; ai < 2; ++ai)
#pragma unroll
            for (int m = 0; m < 4; ++m) { const size_t off = (size_t)(row0 + ai * 128 + m * 16) * 1024 + col0;
#pragma unroll
                for (int bj = 0; bj < 2; ++bj)
#pragma unroll
                    for (int n = 0; n < 2; ++n) { const f32x4 xv = *(const f32x4*)(xin + off + bj * 128 + n * 16);
                        *(f32x4*)(xout + off + bj * 128 + n * 16) = alpha * xv + gv[bj][n] * acc[ai][bj][m][n]; } }
    }
};

template <class Epi, class Sched>
__device__ __forceinline__ void gemm_phase(LAS unsigned char* lds, const Sched& S, const Epi& E) {
    const int tid = ltid(), wid = __builtin_amdgcn_readfirstlane(tid >> 6), lane = tid & 63, wr = wid >> 2, wc = wid & 3, fr = lane & 15, fq = lane >> 4;
    const int K = S.K, nt = K / BK, lda = S.lda, ldb = S.ldb;
    unsigned voffA[2], voffB[2];
#pragma unroll
    for (int i = 0; i < 2; ++i) { int R, C; stage_rc(tid * 16 + i * 8192, R, C); const int Rb = Epi::PERM ? ((R & ~31) + perm32(R & 31)) : R;
        voffA[i] = (unsigned)(R * lda + C) * 2u; voffB[i] = (unsigned)(Rb * ldb + C) * 2u; }
    const size_t kstep = (size_t)(BK * 2);
    const size_t hstepA = (size_t)HALF * lda * 2, hstepB = (size_t)HALF * ldb * 2;
    const unsigned ldsw = (unsigned)wid * 1024u;
    const int aoff = lds_byte(wr * 64 + fr, fq * 8), boff = lds_byte(wc * 32 + fr, fq * 8);
#define PG8_SA(b, h) (((b) * 2 + (h)) * HTB)
#define PG8_SB(b, h) ((4 + (b) * 2 + (h)) * HTB)
#define PG8_STAGE(bufoff, gbase, voff) do { _Pragma("unroll") for (int _i = 0; _i < 2; ++_i) \
        __builtin_amdgcn_global_load_lds((const unsigned*)((const char*)(gbase) + (voff)[_i]), (LAS unsigned*)(lds + (bufoff) + ldsw + _i * 8192), 16, 0, 0); } while (0)
#define PG8_LDA(dst, b, h) do { _Pragma("unroll") for (int m = 0; m < 4; ++m) _Pragma("unroll") for (int k = 0; k < 2; ++k) dst[m][k] = *(const LAS bf16x8*)(lds + PG8_SA(b, h) + aoff + m * 2048 + k * 1024); } while (0)
#define PG8_LDB(dst, b, h) do { _Pragma("unroll") for (int n = 0; n < 2; ++n) _Pragma("unroll") for (int k = 0; k < 2; ++k) dst[n][k] = *(const LAS bf16x8*)(lds + PG8_SB(b, h) + boff + n * 2048 + k * 1024); } while (0)
#define PG8_MMA(ai, bj, At, Bt) do { __builtin_amdgcn_s_setprio(1); _Pragma("unroll") for (int m = 0; m < 4; ++m) _Pragma("unroll") for (int n = 0; n < 2; ++n) _Pragma("unroll") for (int k = 0; k < 2; ++k) \
        acc[ai][bj][m][n] = __builtin_amdgcn_mfma_f32_16x16x32_bf16(Bt[n][k], At[m][k], acc[ai][bj][m][n], 0, 0, 0); __builtin_amdgcn_s_setprio(0); } while (0)
#define PG8_WAIT_V(n) asm volatile("s_waitcnt vmcnt(" #n ")" ::: "memory")
#define PG8_WAIT_L(n) asm volatile("s_waitcnt lgkmcnt(" #n ")" ::: "memory")
#define PG8_BAR __builtin_amdgcn_s_barrier()
#define PG8_SCHED __builtin_amdgcn_sched_barrier(0)
    Unit cur, nxt; int ui = 0;
    if (!S.next(0, cur)) return;
    f32x4 acc[2][2][4][2];
#pragma unroll
    for (int a = 0; a < 2; ++a)
#pragma unroll
        for (int b = 0; b < 2; ++b)
#pragma unroll
            for (int m = 0; m < 4; ++m)
#pragma unroll
                for (int n = 0; n < 2; ++n) acc[a][b][m][n] = (f32x4){0.f, 0.f, 0.f, 0.f};
    bf16x8 At[4][2], B0[2][2], B1[2][2];
    const char* cA = S.a_ptr(cur); const char* cB = S.b_ptr(cur);
    PG8_STAGE(PG8_SB(0, 0), cB, voffB); PG8_STAGE(PG8_SA(0, 0), cA, voffA); PG8_STAGE(PG8_SB(0, 1), cB + hstepB, voffB); PG8_STAGE(PG8_SA(0, 1), cA + hstepA, voffA);
    if (wr == 1) PG8_BAR;
    PG8_WAIT_V(4); PG8_BAR;
    PG8_STAGE(PG8_SB(1, 0), cB + kstep, voffB); PG8_STAGE(PG8_SA(1, 0), cA + kstep, voffA); PG8_STAGE(PG8_SB(1, 1), cB + hstepB + kstep, voffB);
    PG8_WAIT_V(6); PG8_BAR;
    for (;;) {
        const bool has_next = S.next(ui + 1, nxt);
        const char* nA = has_next ? S.a_ptr(nxt) : cA; const char* nB = has_next ? S.b_ptr(nxt) : cB;
        for (int t = 0; t < nt; t += 2) {
            const bool last = (t == nt - 2);
            const char* a1 = cA + (size_t)(t + 1) * kstep;
            const char* a2 = last ? nA : cA + (size_t)(t + 2) * kstep; const char* b2 = last ? nB : cB + (size_t)(t + 2) * kstep;
            const char* a3 = a2 + kstep; const char* b3 = b2 + kstep;
            PG8_LDB(B0, 0, 0); PG8_SCHED; PG8_LDA(At, 0, 0); PG8_STAGE(PG8_SA(1, 1), a1 + hstepA, voffA);
            PG8_WAIT_L(8); PG8_BAR; PG8_WAIT_L(0); PG8_MMA(0, 0, At, B0); PG8_BAR; PG8_SCHED;
            PG8_LDB(B1, 0, 1); PG8_STAGE(PG8_SB(0, 0), b2, voffB);
            PG8_BAR; PG8_WAIT_L(0); PG8_MMA(0, 1, At, B1); PG8_BAR;
            PG8_LDA(At, 0, 1); PG8_STAGE(PG8_SA(0, 0), a2, voffA);
            PG8_BAR; PG8_WAIT_L(0); PG8_MMA(1, 0, At, B0); PG8_BAR; PG8_SCHED;
            PG8_STAGE(PG8_SB(0, 1), b2 + hstepB, voffB);
            PG8_WAIT_V(6); PG8_BAR; PG8_MMA(1, 1, At, B1); PG8_BAR;
            PG8_LDB(B0, 1, 0); PG8_SCHED; PG8_LDA(At, 1, 0); PG8_STAGE(PG8_SA(0, 1), a2 + hstepA, voffA);
            PG8_WAIT_L(8); PG8_BAR; PG8_WAIT_L(0); PG8_MMA(0, 0, At, B0); PG8_BAR; PG8_SCHED;
            PG8_LDB(B1, 1, 1); PG8_STAGE(PG8_SB(1, 0), b3, voffB);
            PG8_BAR; PG8_WAIT_L(0); PG8_MMA(0, 1, At, B1); PG8_BAR;
            PG8_LDA(At, 1, 1); PG8_STAGE(PG8_SA(1, 0), a3, voffA);
            PG8_BAR; PG8_WAIT_L(0); PG8_MMA(1, 0, At, B0); PG8_BAR; PG8_SCHED;
            PG8_STAGE(PG8_SB(1, 1), b3 + hstepB, voffB);
            PG8_WAIT_V(6); PG8_BAR; PG8_MMA(1, 1, At, B1); PG8_BAR;
        }
        E(acc, cur, wr, wc, fr, fq);
        if (!has_next) break;
#pragma unroll
        for (int a = 0; a < 2; ++a)
#pragma unroll
            for (int b = 0; b < 2; ++b)
#pragma unroll
                for (int m = 0; m < 4; ++m)
#pragma unroll
                    for (int n = 0; n < 2; ++n) acc[a][b][m][n] = (f32x4){0.f, 0.f, 0.f, 0.f};
        cur = nxt; cA = nA; cB = nB; ++ui;
    }
    PG8_WAIT_V(0);
    if (wr == 0) PG8_BAR;
    PG8_BAR;
#undef PG8_SA
#undef PG8_SB
#undef PG8_STAGE
#undef PG8_LDA
#undef PG8_LDB
#undef PG8_MMA
#undef PG8_WAIT_V
#undef PG8_WAIT_L
#undef PG8_BAR
#undef PG8_SCHED
}

__device__ __forceinline__ void mods_phase(const P& p, float* MOD, float* ldsf) {
    const int tid = ltid(), wid = tid >> 6, lane = tid & 63;
    float* sc = ldsf;
    float* red = ldsf + 9 * 1024;
    for (int i = tid; i < 9 * 1024; i += 512) { const int j = i >> 10, k = i & 1023; const float v = j == 0 ? p.in[4][k] : p.in[3][(j - 1) * 1024 + k]; sc[i] = siluf_(v); }
    __syncthreads();
    for (int item = lwg(); item < 384; item += lnwg()) {
        const int l = item / 96, col0 = (item % 96) * 64;
        const float* w = p.in[19] + (size_t)l * 1024 * 6144 + col0 + lane;
        float a[9];
#pragma unroll
        for (int j = 0; j < 9; ++j) a[j] = 0.f;
        const int kb = wid * 128;
#pragma unroll 8
        for (int k = 0; k < 128; ++k) { const float wv = w[(size_t)(kb + k) * 6144];
#pragma unroll
            for (int j = 0; j < 9; ++j) a[j] += sc[j * 1024 + kb + k] * wv; }
#pragma unroll
        for (int j = 0; j < 9; ++j) red[(wid * 9 + j) * 64 + lane] = a[j];
        __syncthreads();
        for (int i = tid; i < 576; i += 512) { const int j = i >> 6, ln = i & 63; float s = p.in[20][l * 6144 + col0 + ln];
#pragma unroll
            for (int w8 = 0; w8 < 8; ++w8) s += red[(w8 * 9 + j) * 64 + ln];
            MOD[(size_t)(l * 9 + j) * 6144 + col0 + ln] = s; }
        __syncthreads();
    }
}

__device__ __forceinline__ void dft_phase(bf16_t* DL, bf16_t* DC) {
    const size_t gt = (size_t)lwg() * 512 + ltid(), gn = (size_t)lnwg() * 512;
    for (size_t i = gt; i < 2048ull * 4096 / 8; i += gn) { const int k = (int)(i / 512), t0 = (int)(i % 512) * 8; float f[8];
#pragma unroll
        for (int j = 0; j < 8; ++j) { const int tt = t0 + j, t = tt & 2047; const int m = (k * t) & 2047; const float x = (float)m * (1.0f / 1024.0f);
            f[j] = (tt < 2048 ? cospif(x) : -sinpif(x)) * (1.0f / 512.0f); }
        *(u32x4*)(DL + i * 8) = pack8(f); }
    for (size_t i = gt; i < 256ull * 512 / 8; i += gn) { const int k = (int)(i / 64), t0 = (int)(i % 64) * 8; float f[8];
#pragma unroll
        for (int j = 0; j < 8; ++j) { const int tt = t0 + j, t = tt & 255; const int m = (k * t) & 255; const float x = (float)m * (1.0f / 128.0f);
            f[j] = (tt < 256 ? cospif(x) : -sinpif(x)) * 0.005524271728019903f; }
        *(u32x4*)(DC + i * 8) = pack8(f); }
}

__device__ __forceinline__ void tconv_tile(const float* src, int ld_src, bf16_t* dst, int ld_dst, int k0, int n0, float scale, float* tl) {
    const int tid = ltid();
#pragma unroll
    for (int ps = 0; ps < 4; ++ps) { const int kr = ps * 16 + (tid >> 5), nc = (tid & 31) * 4;
        const f32x4 v = *(const f32x4*)(src + (size_t)(k0 + kr) * ld_src + n0 + nc);
        float* q = tl + kr * 129 + nc; q[0] = v[0]; q[1] = v[1]; q[2] = v[2]; q[3] = v[3]; }
    __syncthreads();
    { const int n = tid >> 2, kq = tid & 3; float f[8], g[8];
#pragma unroll
      for (int j = 0; j < 8; ++j) { f[j] = tl[(kq * 16 + j) * 129 + n] * scale; g[j] = tl[(kq * 16 + 8 + j) * 129 + n] * scale; }
      bf16_t* q = dst + (size_t)(n0 + n) * ld_dst + k0 + kq * 16;
      *(u32x4*)q = pack8(f); *(u32x4*)(q + 8) = pack8(g); }
    __syncthreads();
}

__device__ __forceinline__ void wfft_item(int item, const float* win, bf16_t* W1T, float* tl) {
    const int tid = ltid(), kb = item >> 2, g = item & 3;
    float* xin = tl;
    float* ct = tl + 2048;
    { const int r = tid >> 5, c4 = (tid & 31) * 4; const f32x4 v = *(const f32x4*)(win + (size_t)(kb * 16 + r) * 7712 + g * 128 + c4); *(f32x4*)(xin + r * 128 + c4) = v; }
    if (tid < 128) { ct[tid] = cospif((float)tid * (1.0f / 64.0f)); ct[128 + tid] = sinpif((float)tid * (1.0f / 64.0f)); }
    __syncthreads();
    { const int jj = tid & 255, cs = jj >> 7, j = jj & 127, half = tid >> 8; float a[8];
#pragma unroll
      for (int r = 0; r < 8; ++r) a[r] = 0.f;
      const float* tb = ct + cs * 128; const float* xr = xin + half * 8 * 128;
      for (int c = 0; c < 128; ++c) { const float w = tb[(j * c) & 127];
#pragma unroll
          for (int r = 0; r < 8; ++r) a[r] += xr[r * 128 + c] * w; }
      *(u32x4*)(W1T + (size_t)(cs * 512 + g * 128 + j) * 1024 + kb * 16 + half * 8) = pack8(a); }
    __syncthreads();
}

__device__ __forceinline__ void wconv_phase(const P& p, int set, int l, float* tl) {
    bf16_t* W1T = (bf16_t*)(p.ws + WS_W1T); bf16_t* WMT = (bf16_t*)(p.ws + WS_WMT); bf16_t* WOT = (bf16_t*)(p.ws + WS_WOT);
    bf16_t* WUPT = (bf16_t*)(p.ws + WS_WUPT); bf16_t* WDNT = (bf16_t*)(p.ws + WS_WDNT);
    const float* win = p.in[5] + (size_t)l * 1024 * 7712;
    if (set == 0) {
        for (int it = lwg(); it < 1153; it += lnwg()) {
            if (it < 256) wfft_item(it, win, W1T, tl);
            else if (it < 768) { const int j = it - 256, tk = j & 15, tn = j >> 4; const int n0 = tn * 128;
                tconv_tile(win + 512, 7712, W1T + (size_t)1024 * 1024, 1024, tk * 64, n0, (n0 >= 1024 && n0 < 1536) ? 0.08838834764831845f : 1.0f, tl); }
            else if (it < 1152) { const int j = it - 768, tk = j & 15, tn = j >> 4;
                tconv_tile(win + 4640, 7712, W1T + (size_t)5120 * 1024, 1024, tk * 64, tn * 128, 1.0f, tl); }
            else { for (int i = ltid(); i < 256 * 1024; i += 512) { const int n = i >> 10, k = i & 1023;
                    W1T[(size_t)(8192 + n) * 1024 + k] = n < 32 ? f2bf(win[(size_t)k * 7712 + 4608 + n]) : (bf16_t)0; } }
        }
    } else if (set == 1) {
        for (int it = lwg(); it < 384; it += lnwg()) {
            if (it < 64) { const int tk = it & 7, tn = it >> 3; tconv_tile(p.in[7] + (size_t)l * 512 * 1024, 1024, WMT, 2048, tk * 64, tn * 128, 1.0f, tl); }
            else if (it < 128) { const int j = it - 64, tk = j & 7, tn = j >> 3; tconv_tile(p.in[11] + (size_t)l * 512 * 1024, 1024, WMT + 512, 2048, tk * 64, tn * 128, 1.0f, tl); }
            else if (it < 256) { const int j = it - 128, tk = j & 15, tn = j >> 4; tconv_tile(p.in[15] + (size_t)l * 1024 * 1024, 1024, WMT + 1024, 2048, tk * 64, tn * 128, 1.0f, tl); }
            else { const int j = it - 256, tk = j & 15, tn = j >> 4; tconv_tile(p.in[16] + (size_t)l * 1024 * 1024, 1024, WOT, 1024, tk * 64, tn * 128, 1.0f, tl); }
        }
    } else {
        for (int it = lwg(); it < 1056; it += lnwg()) {
            if (it < 704) { const int tk = it & 15, tn = it >> 4; tconv_tile(p.in[21] + (size_t)l * 1024 * 5632, 5632, WUPT, 1024, tk * 64, tn * 128, 1.0f, tl); }
            else { const int j = it - 704, tn = j & 7, tk = j >> 3; tconv_tile(p.in[24] + (size_t)l * DFF * 1024, 1024, WDNT, DFF, tk * 64, tn * 128, 1.0f, tl); }
        }
    }
}

__device__ __forceinline__ void ln_phase(const float* src_ctx, const float* src_lat, float* xout, const float* g, const float* b, bool doLN,
                                         bool doH, const float* modl, int sci, int shi, bf16_t* H) {
    const int lane = ltid() & 63, gw = lwg() * 8 + (ltid() >> 6), nw = lnwg() * 8;
    for (int row = gw; row < NTOK; row += nw) {
        const float* src = row < NCTX ? src_ctx + (size_t)row * 1024 : src_lat + (size_t)(row - NCTX) * 1024;
        f32x4 v[4];
#pragma unroll
        for (int i = 0; i < 4; ++i) v[i] = *(const f32x4*)(src + i * 256 + lane * 4);
        if (doLN) {
            float s = 0.f;
#pragma unroll
            for (int i = 0; i < 4; ++i) s += (v[i][0] + v[i][1]) + (v[i][2] + v[i][3]);
            const float mean = wave_sum(s) * (1.0f / 1024.0f); float q = 0.f;
#pragma unroll
            for (int i = 0; i < 4; ++i) { const f32x4 d = v[i] - mean; q += (d[0] * d[0] + d[1] * d[1]) + (d[2] * d[2] + d[3] * d[3]); }
            const float rstd = rsqrtf(wave_sum(q) * (1.0f / 1024.0f) + 1e-5f);
#pragma unroll
            for (int i = 0; i < 4; ++i) { const f32x4 gg = *(const f32x4*)(g + i * 256 + lane * 4), bb = *(const f32x4*)(b + i * 256 + lane * 4);
                v[i] = (v[i] - mean) * rstd * gg + bb; *(f32x4*)(xout + (size_t)row * 1024 + i * 256 + lane * 4) = v[i]; }
        }
        if (doH) {
            const int cond = row < NCTX ? 0 : 1 + ((row - NCTX) >> 11);
            const float* mp = modl + (size_t)cond * 6144;
            float s = 0.f;
#pragma unroll
            for (int i = 0; i < 4; ++i) s += (v[i][0] + v[i][1]) + (v[i][2] + v[i][3]);
            const float mean = wave_sum(s) * (1.0f / 1024.0f); float q = 0.f;
#pragma unroll
            for (int i = 0; i < 4; ++i) { const f32x4 d = v[i] - mean; q += (d[0] * d[0] + d[1] * d[1]) + (d[2] * d[2] + d[3] * d[3]); }
            const float rstd = rsqrtf(wave_sum(q) * (1.0f / 1024.0f) + 1e-5f);
#pragma unroll
            for (int i = 0; i < 4; ++i) { const f32x4 scv = *(const f32x4*)(mp + sci * 1024 + i * 256 + lane * 4), shv = *(const f32x4*)(mp + shi * 1024 + i * 256 + lane * 4);
                const f32x4 h = (v[i] - mean) * rstd * (1.0f + scv) + shv;
                u32x2 w; w.x = cvt_pk_bf16(h[0], h[1]); w.y = cvt_pk_bf16(h[2], h[3]);
                *(u32x2*)(H + (size_t)row * 1024 + i * 256 + lane * 4) = w; }
        }
    }
}

__device__ __forceinline__ void glapost_phase(bf16_t* AM, const bf16_t* OB, const bf16_t* Z, const float* ng) {
    const int lane = ltid() & 63, gw = lwg() * 8 + (ltid() >> 6), nw = lnwg() * 8;
    float gn[16];
#pragma unroll
    for (int j = 0; j < 16; ++j) gn[j] = ng[(lane & 15) * 16 + j];
    for (int row = gw; row < NTOK; row += nw) {
        bf16_t* op = AM + (size_t)row * 2048 + 1024 + lane * 16;
        const bf16_t* bp = OB + (size_t)row * 1024 + lane * 16;
        const bf16_t* rp = Z + (size_t)row * ZLD + ZR + lane * 16;
        float a[16], bq[16], r[16];
        { float t[8]; unpack8(*(const u32x4*)op, t);
#pragma unroll
          for (int j = 0; j < 8; ++j) a[j] = t[j];
          unpack8(*(const u32x4*)(op + 8), t);
#pragma unroll
          for (int j = 0; j < 8; ++j) a[8 + j] = t[j];
          unpack8(*(const u32x4*)bp, t);
#pragma unroll
          for (int j = 0; j < 8; ++j) bq[j] = t[j];
          unpack8(*(const u32x4*)(bp + 8), t);
#pragma unroll
          for (int j = 0; j < 8; ++j) bq[8 + j] = t[j];
          unpack8(*(const u32x4*)rp, t);
#pragma unroll
          for (int j = 0; j < 8; ++j) r[j] = t[j];
          unpack8(*(const u32x4*)(rp + 8), t);
#pragma unroll
          for (int j = 0; j < 8; ++j) r[8 + j] = t[j]; }
        float ss = 0.f;
#pragma unroll
        for (int j = 0; j < 16; ++j) { a[j] += bq[j]; ss += a[j] * a[j]; }
        ss += __shfl_xor(ss, 1); ss += __shfl_xor(ss, 2); ss += __shfl_xor(ss, 4); ss += __shfl_xor(ss, 8);
        const float rs = rsqrtf(ss * (1.0f / 256.0f) + 1e-5f);
        float o0[8], o1[8];
#pragma unroll
        for (int j = 0; j < 8; ++j) { o0[j] = a[j] * rs * gn[j] * r[j]; o1[j] = a[8 + j] * rs * gn[8 + j] * r[8 + j]; }
        *(u32x4*)op = pack8(o0); *(u32x4*)(op + 8) = pack8(o1);
    }
}

__device__ __forceinline__ void conv_phase(const bf16_t* AG, bf16_t* FF, const float* wdw, const float* bdw) {
    const int g = lwg() * 512 + ltid();
    const int run = g / 352, cb = g - run * 352, ch = cb * 8;
    if (run < 320) {
        const bool lat = run >= 64;
        const int tok0 = lat ? NCTX + (run - 64) * 64 : run * 64;
        const int gy = (run - 64) & 31;
        const bool up = lat && gy > 0, dn = lat && gy < 31;
        const int xlo = lat ? 0 : -(tok0 & 255), xhi = lat ? 63 : 255 - (tok0 & 255);
        float w[9][8], bias[8];
#pragma unroll
        for (int t = 0; t < 9; ++t) { const f32x4 a = *(const f32x4*)(wdw + t * DFF + ch), b = *(const f32x4*)(wdw + t * DFF + ch + 4);
#pragma unroll
            for (int j = 0; j < 4; ++j) { w[t][j] = a[j]; w[t][4 + j] = b[j]; } }
        { const f32x4 a = *(const f32x4*)(bdw + ch), b = *(const f32x4*)(bdw + ch + 4);
#pragma unroll
          for (int j = 0; j < 4; ++j) { bias[j] = a[j]; bias[4 + j] = b[j]; } }
        const bf16_t* base = AG + (size_t)tok0 * 5632 + ch;
        const u32x4 zero4 = {0u, 0u, 0u, 0u};
        u32x4 c0[3], c1[3], c2[3], nx[3];
#define CONV_LOADCOL(dst, x) do { const bool okx = (x) >= xlo && (x) <= xhi; const bf16_t* q_ = base + (ptrdiff_t)(x) * 5632; \
            dst[0] = (okx && up) ? *(const u32x4*)(q_ - 64 * 5632) : zero4; dst[1] = okx ? *(const u32x4*)q_ : zero4; dst[2] = (okx && dn) ? *(const u32x4*)(q_ + 64 * 5632) : zero4; } while (0)
        CONV_LOADCOL(c0, -1); CONV_LOADCOL(c1, 0); CONV_LOADCOL(c2, 1);
#pragma unroll 1
        for (int x = 0; x < 64; ++x) {
            CONV_LOADCOL(nx, x + 2);
            const u32x4 gw = *(const u32x4*)(base + (size_t)x * 5632 + DFF);
            float acc[8];
#pragma unroll
            for (int j = 0; j < 8; ++j) acc[j] = bias[j];
#pragma unroll
            for (int dy = 0; dy < 3; ++dy) { float a[8];
                unpack8(c0[dy], a);
#pragma unroll
                for (int j = 0; j < 8; ++j) acc[j] += a[j] * w[dy * 3 + 0][j];
                unpack8(c1[dy], a);
#pragma unroll
                for (int j = 0; j < 8; ++j) acc[j] += a[j] * w[dy * 3 + 1][j];
                unpack8(c2[dy], a);
#pragma unroll
                for (int j = 0; j < 8; ++j) acc[j] += a[j] * w[dy * 3 + 2][j]; }
            float gg[8]; unpack8(gw, gg);
#pragma unroll
            for (int j = 0; j < 8; ++j) acc[j] = geluf_(acc[j]) * gg[j];
            *(u32x4*)(FF + (size_t)(tok0 + x) * DFF + ch) = pack8(acc);
#pragma unroll
            for (int dy = 0; dy < 3; ++dy) { c0[dy] = c1[dy]; c1[dy] = c2[dy]; c2[dy] = nx[dy]; }
        }
#undef CONV_LOADCOL
    }
}

__device__ __forceinline__ void sgu_item(int item, int l, const P& p, const bf16_t* Z, bf16_t* AM, LAS unsigned char* lds) {
    const int tid = ltid(), wid = tid >> 6, lane = tid & 63, fr = lane & 15, fq = lane >> 4;
    LAS float* STAT = (LAS float*)lds;
    LAS bf16_t* VT = (LAS bf16_t*)(lds + 1024);
    const int row0 = item * 128;
    for (int i = 0; i < 16; ++i) { const int q = wid * 16 + i; float f[8]; unpack8(*(const u32x4*)(Z + (size_t)(row0 + q) * ZLD + ZV + lane * 8), f);
        float s = 0.f;
#pragma unroll
        for (int j = 0; j < 8; ++j) s += f[j];
        const float mean = wave_sum(s) * (1.0f / 512.0f); float qq = 0.f;
#pragma unroll
        for (int j = 0; j < 8; ++j) { const float d = f[j] - mean; qq += d * d; }
        const float rstd = rsqrtf(wave_sum(qq) * (1.0f / 512.0f) + 1e-5f);
        if (lane == 0) { STAT[q * 2] = mean; STAT[q * 2 + 1] = rstd; } }
    __syncthreads();
    for (int g = 0; g < 4; ++g) {
        { const int q = tid >> 2, seg = tid & 3; const float mean = STAT[q * 2], rstd = STAT[q * 2 + 1];
#pragma unroll
          for (int j4 = 0; j4 < 4; ++j4) { const int c0 = seg * 32 + j4 * 8; float f[8]; unpack8(*(const u32x4*)(Z + (size_t)(row0 + q) * ZLD + ZV + g * 128 + c0), f);
              const float* sg = p.in[8] + l * 512 + g * 128 + c0;
#pragma unroll
              for (int j = 0; j < 8; ++j) VT[(c0 + j) * 136 + q] = f2bf((f[j] - mean) * rstd * sg[j]); } }
        __syncthreads();
        bf16x8 Yf[4];
        { const float* wp = p.in[9] + ((size_t)(l * 4 + g) * 128 + wid * 16 + fr) * 128 + 8 * fq;
#pragma unroll
          for (int kk = 0; kk < 4; ++kk) { const f32x4 a = *(const f32x4*)(wp + kk * 32), b = *(const f32x4*)(wp + kk * 32 + 4);
              u32x4 w; w.x = cvt_pk_bf16(a[0], a[1]); w.y = cvt_pk_bf16(a[2], a[3]); w.z = cvt_pk_bf16(b[0], b[1]); w.w = cvt_pk_bf16(b[2], b[3]);
              Yf[kk] = __builtin_bit_cast(bf16x8, w); } }
        const int pp = wid * 16 + fr; const size_t tok = (size_t)(row0 + pp);
        const float bias = p.in[10][(l * 4 + g) * 128 + pp];
#pragma unroll
        for (int ct = 0; ct < 8; ++ct) { f32x4 acc = {0.f, 0.f, 0.f, 0.f};
#pragma unroll
            for (int kk = 0; kk < 4; ++kk) { const bf16x8 X = *(const LAS bf16x8*)(VT + (ct * 16 + fr) * 136 + kk * 32 + 8 * fq);
                acc = __builtin_amdgcn_mfma_f32_16x16x32_bf16(X, Yf[kk], acc, 0, 0, 0); }
            const int c = ct * 16 + 4 * fq;
            const u32x2 uw = *(const u32x2*)(Z + tok * ZLD + ZU + g * 128 + c);
            const float u0 = bf2f(uw.x & 0xffffu), u1 = bf2f(uw.x >> 16), u2 = bf2f(uw.y & 0xffffu), u3 = bf2f(uw.y >> 16);
            u32x2 ow; ow.x = cvt_pk_bf16(u0 * (acc[0] + bias), u1 * (acc[1] + bias)); ow.y = cvt_pk_bf16(u2 * (acc[2] + bias), u3 * (acc[3] + bias));
            *(u32x2*)(AM + tok * 2048 + 512 + g * 128 + c) = ow; }
        __syncthreads();
    }
}

__device__ __forceinline__ void gla_item(int item, int l, const P& p, const bf16_t* Z, const float* LR, bf16_t* AM, bf16_t* OB, LAS unsigned char* lds) {
    const int tid = ltid(), wid = tid >> 6, lane = tid & 63, fr = lane & 15, fq = lane >> 4;
    LAS bf16_t* QG = (LAS bf16_t*)lds;
    LAS bf16_t* KG = (LAS bf16_t*)(lds + 17408);
    LAS bf16_t* KDT = (LAS bf16_t*)(lds + 34816);
    LAS bf16_t* VT = (LAS bf16_t*)(lds + 53248);
    LAS bf16_t* ST = (LAS bf16_t*)(lds + 71680);
    LAS bf16_t* AB = (LAS bf16_t*)(lds + 106496);
    LAS float* LRS = (LAS float*)(lds + 115712);
    LAS float* GT = (LAS float*)(lds + 119808);
    LAS float* GLAST = (LAS float*)(lds + 121856);
    int b, h, dir, vs, T, seq0; const bool lat = item < 128;
    { const int idx = lat ? item : item - 128; vs = idx & 1; dir = (idx >> 1) & 1; h = (idx >> 2) & 3; b = idx >> 4; }
    if (lat) { T = 2048; seq0 = NCTX + b * 2048; } else { T = 256; seq0 = b * 256; }
    const int kc = tid & 127, lg = tid >> 7;
    float w2r[16];
#pragma unroll
    for (int r = 0; r < 16; ++r) w2r[r] = p.in[12][((size_t)(l * 2 + dir) * 16 + r) * 512 + h * 128 + kc];
    const float gbias = p.in[13][(l * 2 + dir) * 512 + h * 128 + kc];
    f32x4 S[8];
    if (lat) { const float* sp = p.in[2] + ((size_t)((b * 4 + l) * 2 + dir) * 4 + h) * 128 * 256 + vs * 128;
#pragma unroll
        for (int jt = 0; jt < 8; ++jt)
#pragma unroll
            for (int r = 0; r < 4; ++r) S[jt][r] = sp[(size_t)(wid * 16 + 4 * fq + r) * 256 + jt * 16 + fr]; }
    else {
#pragma unroll
        for (int jt = 0; jt < 8; ++jt) S[jt] = (f32x4){0.f, 0.f, 0.f, 0.f}; }
    bf16_t* obuf = dir ? OB : AM + 1024; const int ldo = dir ? 1024 : 2048;
    const int nch = T / 64;
    u32x4 pv0, pv1; f32x4 plr = {0.f, 0.f, 0.f, 0.f}; bf16_t pq[16], pk[16];
#define GLA_TOK(pos) (seq0 + (dir ? T - 1 - (pos) : (pos)))
#define GLA_ISSUE(n_) do { const int pos0_ = (n_) * 64; \
        { const int li_ = tid >> 3, seg_ = tid & 7; const bf16_t* vp_ = Z + (size_t)GLA_TOK(pos0_ + li_) * ZLD + ZVV + h * 256 + vs * 128 + seg_ * 16; pv0 = *(const u32x4*)vp_; pv1 = *(const u32x4*)(vp_ + 8); } \
        if (tid < 256) { const int li_ = tid >> 2, part_ = tid & 3; plr = *(const f32x4*)(LR + (size_t)GLA_TOK(pos0_ + li_) * 32 + dir * 16 + part_ * 4); } \
        _Pragma("unroll") for (int i_ = 0; i_ < 16; ++i_) { const bf16_t* zr_ = Z + (size_t)GLA_TOK(pos0_ + lg * 16 + i_) * ZLD + h * 128 + kc; pq[i_] = zr_[ZQ]; pk[i_] = zr_[ZK]; } } while (0)
    GLA_ISSUE(0);
    for (int n = 0; n < nch; ++n) {
        const int pos0 = n * 64;
#pragma unroll
        for (int jt = 0; jt < 8; ++jt) { u32x2 w; w.x = cvt_pk_bf16(S[jt][0], S[jt][1]); w.y = cvt_pk_bf16(S[jt][2], S[jt][3]);
            *(LAS u32x2*)(ST + (jt * 16 + fr) * 136 + wid * 16 + 4 * fq) = w; }
        { const int li = tid >> 3, seg = tid & 7; LAS bf16_t* q = VT + (seg * 16) * 72 + li;
          q[0] = (bf16_t)(pv0.x & 0xffffu); q[72] = (bf16_t)(pv0.x >> 16); q[144] = (bf16_t)(pv0.y & 0xffffu); q[216] = (bf16_t)(pv0.y >> 16);
          q[288] = (bf16_t)(pv0.z & 0xffffu); q[360] = (bf16_t)(pv0.z >> 16); q[432] = (bf16_t)(pv0.w & 0xffffu); q[504] = (bf16_t)(pv0.w >> 16);
          q += 8 * 72;
          q[0] = (bf16_t)(pv1.x & 0xffffu); q[72] = (bf16_t)(pv1.x >> 16); q[144] = (bf16_t)(pv1.y & 0xffffu); q[216] = (bf16_t)(pv1.y >> 16);
          q[288] = (bf16_t)(pv1.z & 0xffffu); q[360] = (bf16_t)(pv1.z >> 16); q[432] = (bf16_t)(pv1.w & 0xffffu); q[504] = (bf16_t)(pv1.w >> 16); }
        if (tid < 256) *(LAS f32x4*)(LRS + (tid >> 2) * 16 + (tid & 3) * 4) = plr;
        float qv[16], kv[16];
#pragma unroll
        for (int i = 0; i < 16; ++i) { qv[i] = bf2f(pq[i]); kv[i] = bf2f(pk[i]); }
        __syncthreads();
        float Gl[16]; float run = 0.f;
#pragma unroll
        for (int i = 0; i < 16; ++i) { const LAS float* lr = LRS + (lg * 16 + i) * 16; float z = gbias;
            const f32x4 l0 = *(const LAS f32x4*)lr, l1 = *(const LAS f32x4*)(lr + 4), l2 = *(const LAS f32x4*)(lr + 8), l3 = *(const LAS f32x4*)(lr + 12);
#pragma unroll
            for (int r = 0; r < 4; ++r) { z += l0[r] * w2r[r]; z += l1[r] * w2r[4 + r]; z += l2[r] * w2r[8 + r]; z += l3[r] * w2r[12 + r]; }
            const float ls = fminf(z, 0.f) - __logf(1.0f + __expf(-fabsf(z)));
            run += ls * (1.0f / 16.0f); Gl[i] = run; }
        GT[lg * 128 + kc] = run;
        __syncthreads();
        float pre = 0.f, tot = 0.f;
#pragma unroll
        for (int g4 = 0; g4 < 4; ++g4) { const float t = GT[g4 * 128 + kc]; tot += t; if (g4 < lg) pre += t; }
        if (lg == 0) GLAST[kc] = tot;
        { float kd[16]; const float etot = __expf(tot);
#pragma unroll
          for (int i = 0; i < 16; ++i) { const float G = pre + Gl[i]; const int li = lg * 16 + i; const float eg = __expf(G), ieg = __expf(-G);
              QG[li * 136 + kc] = f2bf(qv[i] * eg); const float kgv = kv[i] * ieg; KG[li * 136 + kc] = f2bf(kgv); kd[i] = kgv * etot; }
          float k0[8], k1[8];
#pragma unroll
          for (int j = 0; j < 8; ++j) { k0[j] = kd[j]; k1[j] = kd[8 + j]; }
          *(LAS u32x4*)(KDT + kc * 72 + lg * 16) = pack8(k0); *(LAS u32x4*)(KDT + kc * 72 + lg * 16 + 8) = pack8(k1); }
        __syncthreads();
        if (n + 1 < nch) GLA_ISSUE(n + 1);
        { const int jt = wid >> 1, it0 = (wid & 1) * 2;
#pragma unroll
          for (int t = 0; t < 2; ++t) { const int it = it0 + t; f32x4 acc = {0.f, 0.f, 0.f, 0.f};
              if (it <= jt) {
#pragma unroll
                  for (int kk = 0; kk < 4; ++kk) { const bf16x8 X = *(const LAS bf16x8*)(KG + (it * 16 + fr) * 136 + kk * 32 + 8 * fq), Y = *(const LAS bf16x8*)(QG + (jt * 16 + fr) * 136 + kk * 32 + 8 * fq);
                      acc = __builtin_amdgcn_mfma_f32_16x16x32_bf16(X, Y, acc, 0, 0, 0); } }
              const int li = jt * 16 + fr, m0 = it * 16 + 4 * fq;
              u32x2 w; w.x = cvt_pk_bf16(m0 <= li ? acc[0] : 0.f, m0 + 1 <= li ? acc[1] : 0.f); w.y = cvt_pk_bf16(m0 + 2 <= li ? acc[2] : 0.f, m0 + 3 <= li ? acc[3] : 0.f);
              *(LAS u32x2*)(AB + li * 72 + m0) = w; } }
        __syncthreads();
        { const int jt = wid >> 1, it0 = (wid & 1) * 4; const int li = jt * 16 + fr; const int tok = GLA_TOK(pos0 + li);
          bf16x8 Ya[2], Yq[4];
#pragma unroll
          for (int kk = 0; kk < 2; ++kk) Ya[kk] = *(const LAS bf16x8*)(AB + (jt * 16 + fr) * 72 + kk * 32 + 8 * fq);
#pragma unroll
          for (int kk = 0; kk < 4; ++kk) Yq[kk] = *(const LAS bf16x8*)(QG + (jt * 16 + fr) * 136 + kk * 32 + 8 * fq);
#pragma unroll
          for (int t = 0; t < 4; ++t) { const int it = it0 + t; f32x4 acc = {0.f, 0.f, 0.f, 0.f};
#pragma unroll
              for (int kk = 0; kk < 2; ++kk) { const bf16x8 X = *(const LAS bf16x8*)(VT + (it * 16 + fr) * 72 + kk * 32 + 8 * fq);
                  acc = __builtin_amdgcn_mfma_f32_16x16x32_bf16(X, Ya[kk], acc, 0, 0, 0); }
#pragma unroll
              for (int kk = 0; kk < 4; ++kk) { const bf16x8 X = *(const LAS bf16x8*)(ST + (it * 16 + fr) * 136 + kk * 32 + 8 * fq);
                  acc = __builtin_amdgcn_mfma_f32_16x16x32_bf16(X, Yq[kk], acc, 0, 0, 0); }
              u32x2 w; w.x = cvt_pk_bf16(acc[0], acc[1]); w.y = cvt_pk_bf16(acc[2], acc[3]);
              *(u32x2*)(obuf + (size_t)tok * ldo + h * 256 + vs * 128 + it * 16 + 4 * fq) = w; } }
        { float dec[4];
#pragma unroll
          for (int r = 0; r < 4; ++r) dec[r] = __expf(GLAST[wid * 16 + 4 * fq + r]);
          bf16x8 Xk[2];
#pragma unroll
          for (int kk = 0; kk < 2; ++kk) Xk[kk] = *(const LAS bf16x8*)(KDT + (wid * 16 + fr) * 72 + kk * 32 + 8 * fq);
#pragma unroll
          for (int jt = 0; jt < 8; ++jt) { f32x4 acc;
#pragma unroll
              for (int r = 0; r < 4; ++r) acc[r] = S[jt][r] * dec[r];
#pragma unroll
              for (int kk = 0; kk < 2; ++kk) { const bf16x8 Y = *(const LAS bf16x8*)(VT + (jt * 16 + fr) * 72 + kk * 32 + 8 * fq);
                  acc = __builtin_amdgcn_mfma_f32_16x16x32_bf16(Xk[kk], Y, acc, 0, 0, 0); }
              S[jt] = acc; } }
        __syncthreads();
    }
#undef GLA_ISSUE
#undef GLA_TOK
    if (!lat) { float* sp = p.out + (size_t)NTOK * 1024 + ((size_t)((b * 4 + l) * 2 + dir) * 4 + h) * 128 * 256 + vs * 128;
#pragma unroll
        for (int jt = 0; jt < 8; ++jt)
#pragma unroll
            for (int r = 0; r < 4; ++r) sp[(size_t)(wid * 16 + 4 * fq + r) * 256 + jt * 16 + fr] = S[jt][r]; }
}

template <int PH>
__device__ __forceinline__ void run_phase(const P& p, int l, unsigned char* shm) {
    LAS unsigned char* lds = (LAS unsigned char*)shm;
    const int wg = lwg(), nwg = lnwg();
    size_t wso = 0; asm volatile("" : "+s"(wso)); unsigned char* wsb = p.ws + wso;
    float* MOD = (float*)(wsb + WS_MOD);
    bf16_t* DLAT = (bf16_t*)(wsb + WS_DLAT); bf16_t* DCTX = (bf16_t*)(wsb + WS_DCTX);
    bf16_t* W1T = (bf16_t*)(wsb + WS_W1T); bf16_t* WMT = (bf16_t*)(wsb + WS_WMT); bf16_t* WOT = (bf16_t*)(wsb + WS_WOT);
    bf16_t* WUPT = (bf16_t*)(wsb + WS_WUPT); bf16_t* WDNT = (bf16_t*)(wsb + WS_WDNT);
    bf16_t* H = (bf16_t*)(wsb + WS_H); bf16_t* XTc = (bf16_t*)(wsb + WS_XT); bf16_t* XTl = (bf16_t*)(wsb + WS_XTL); bf16_t* Mb = (bf16_t*)(wsb + WS_XT);
    bf16_t* Z = (bf16_t*)(wsb + WS_Z); float* LR = (float*)(wsb + WS_LR); bf16_t* AM = (bf16_t*)(wsb + WS_AM);
    bf16_t* AG = (bf16_t*)(wsb + WS_AG); bf16_t* FF = (bf16_t*)(wsb + WS_FF);
    float* X = p.out;
    const float* modl = MOD + (size_t)l * 9 * 6144;
    if constexpr (PH == 0) {
        mods_phase(p, MOD, (float*)shm);
        dft_phase(DLAT, DCTX);
        wconv_phase(p, 0, 0, (float*)shm);
        wconv_phase(p, 1, 0, (float*)shm);
    } else if constexpr (PH == 1) {
        ln_phase(p.in[0], p.in[1], nullptr, nullptr, nullptr, false, true, MOD, 1, 0, H);
    } else if constexpr (PH == 2) {
        SchedStd S{H, W1T, 1024, 1024, 1024, 80, 33, nwg, wg}; EpiIn E{Z, XTc, XTl, LR, p.in[6] + l * 3072}; gemm_phase(lds, S, E);
    } else if constexpr (PH == 3) {
        if (wg < NFFT_WG) {
            { SchedFftL S{DLAT, XTl, 4096, 4096, 4096, NFFT_WG, wg}; EpiBf16 E{AM, 2048}; gemm_phase(lds, S, E); }
            { SchedFftC S{DCTX, XTc, 512, 512, 512, NFFT_WG, wg}; EpiBf16 E{AM, 2048}; gemm_phase(lds, S, E); }
            if (wg >= 32) for (int it = wg - 32; it < 160; it += NFFT_WG - 32) sgu_item(it, l, p, Z, AM, lds);
        }
    } else if constexpr (PH == 4) {
        if (wg >= NFFT_WG) {
            const int gi = wg - NFFT_WG, gn = nwg - NFFT_WG;
            for (int it = gi; it < 384; it += gn) gla_item(it, l, p, Z, LR, AM, H, lds);
        }
    } else if constexpr (PH == 5) {
        glapost_phase(AM, H, Z, p.in[14] + l * 256);
        wconv_phase(p, 2, l, (float*)shm);
    } else if constexpr (PH == 6) {
        SchedMerge S{AM, WMT, 2048, 2048, 512, nwg, wg}; EpiMerge E{Mb, Z}; gemm_phase(lds, S, E);
    } else if constexpr (PH == 7) {
        const float* xc = l == 0 ? p.in[0] : X; const float* xl = l == 0 ? p.in[1] : X + (size_t)NCTX * 1024;
        SchedStd S{Mb, WOT, 1024, 1024, 1024, 80, 4, nwg, wg}; EpiResid E{xc, xl, X, modl + 2 * 1024}; gemm_phase(lds, S, E);
    } else if constexpr (PH == 8) {
        ln_phase(X, X + (size_t)NCTX * 1024, X, p.in[17] + l * 1024, p.in[18] + l * 1024, true, true, modl, 4, 3, H);
    } else if constexpr (PH == 9) {
        SchedStd S{H, WUPT, 1024, 1024, 1024, 80, 22, nwg, wg}; EpiBf16 E{AG, 5632}; gemm_phase(lds, S, E);
    } else if constexpr (PH == 10) {
        conv_phase(AG, FF, p.in[22] + (size_t)l * 9 * DFF, p.in[23] + l * DFF);
        if (l + 1 < DEPTH) wconv_phase(p, 1, l + 1, (float*)shm);
    } else if constexpr (PH == 11) {
        SchedStd S{FF, WDNT, DFF, DFF, DFF, 80, 4, nwg, wg}; EpiResid E{X, X + (size_t)NCTX * 1024, X, modl + 5 * 1024}; gemm_phase(lds, S, E);
    } else if constexpr (PH == 12) {
        ln_phase(X, X + (size_t)NCTX * 1024, X, p.in[25] + l * 1024, p.in[26] + l * 1024, true, l + 1 < DEPTH, modl + 9 * 6144, 1, 0, H);
        if (l + 1 < DEPTH) wconv_phase(p, 0, l + 1, (float*)shm);
    }
}

#ifndef MULTI
#define MULTI 0
#endif

#if MULTI
template <int PH> __global__ void __launch_bounds__(512) k_phase(P p, int l) {
    extern __shared__ __attribute__((aligned(16))) unsigned char shm[];
    run_phase<PH>(p, l, shm);
}
template <int PH> static void launch_phase(const P& p, int l, int grid, hipStream_t stream) {
    static bool attr = false;
    if (!attr) { (void)hipFuncSetAttribute((const void*)k_phase<PH>, hipFuncAttributeMaxDynamicSharedMemorySize, LDS_BYTES); attr = true; }
    hipLaunchKernelGGL((k_phase<PH>), dim3(grid), dim3(512), LDS_BYTES, stream, p, l);
}
#else
#ifndef REPEAT_PH
#define REPEAT_PH 0
#endif
#ifndef STOP_PH
#define STOP_PH 99
#endif
__device__ __forceinline__ void dump_phase(const P& p, int which) {
    size_t wso = 0; asm volatile("" : "+s"(wso)); unsigned char* wsb = p.ws + wso;
    const size_t gt = (size_t)lwg() * 512 + ltid(), gn = (size_t)lnwg() * 512;
    const bf16_t* AM = (const bf16_t*)(wsb + WS_AM); const bf16_t* Z = (const bf16_t*)(wsb + WS_Z); const bf16_t* Mb = (const bf16_t*)(wsb + WS_XT);
    const bf16_t* H = (const bf16_t*)(wsb + WS_H); const float* LR = (const float*)(wsb + WS_LR);
    for (size_t i = gt; i < (size_t)NTOK * 1024; i += gn) { const size_t row = i >> 10, c = i & 1023; float v = 0.f;
        if (which == 0) v = bf2f(AM[row * 2048 + c]) + bf2f(AM[row * 2048 + 1024 + c]);
        else if (which == 1) { for (int j = 0; j < 7; ++j) v += bf2f(Z[row * ZLD + j * 1024 + c]); v += LR[row * 32 + (c & 31)] + bf2f(Mb[i]); }
        else if (which == 2) v = bf2f(Mb[i]);
        else if (which == 3) v = bf2f(H[i]);
        else if (which == 4) { const bf16_t* AG = (const bf16_t*)(wsb + WS_AG); for (int j = 0; j < 5; ++j) v += bf2f(AG[row * 5632 + j * 1024 + c]); }
        else if (which == 5) { const bf16_t* FF = (const bf16_t*)(wsb + WS_FF); v = bf2f(FF[row * DFF + c]) + bf2f(FF[row * DFF + 1024 + c]); }
        p.out[i] = v; }
}
__global__ void __launch_bounds__(512) fwd_megakernel(P p) {
    extern __shared__ __attribute__((aligned(16))) unsigned char shm[];
    cg::grid_group grid = cg::this_grid();
    run_phase<0>(p, 0, shm); grid.sync();
    run_phase<1>(p, 0, shm); grid.sync();
#pragma unroll 1
    for (int l = 0; l < DEPTH; ++l) {
        run_phase<2>(p, l, shm); grid.sync();
        if (STOP_PH == 2) { dump_phase(p, 1); return; }
#if REPEAT_PH == 2
        run_phase<2>(p, l, shm); grid.sync();
#endif
        run_phase<3>(p, l, shm);
        run_phase<4>(p, l, shm); grid.sync();
#if REPEAT_PH == 34
        run_phase<3>(p, l, shm);
        run_phase<4>(p, l, shm); grid.sync();
#endif
        run_phase<5>(p, l, shm); grid.sync();
        if (STOP_PH == 5) { dump_phase(p, 0); return; }
        run_phase<6>(p, l, shm); grid.sync();
        if (STOP_PH == 6) { dump_phase(p, 2); return; }
        run_phase<7>(p, l, shm); grid.sync();
        if (STOP_PH == 7) return;
        run_phase<8>(p, l, shm); grid.sync();
        if (STOP_PH == 8) { grid.sync(); dump_phase(p, 3); return; }
        run_phase<9>(p, l, shm); grid.sync();
        if (STOP_PH == 9) { dump_phase(p, 4); return; }
        run_phase<10>(p, l, shm); grid.sync();
        if (STOP_PH == 10) { dump_phase(p, 5); return; }
        run_phase<11>(p, l, shm); grid.sync();
        if (STOP_PH == 11) return;
        run_phase<12>(p, l, shm); grid.sync();
        if (STOP_PH == 12) return;
    }
}
#endif

extern "C" void kernel_launch(void* const* d_in, const int* in_sizes, int n_in, void* d_out, int out_size, void* d_ws, size_t ws_size, hipStream_t stream) {
    P p{};
    for (int i = 0; i < 27; ++i) p.in[i] = (const float*)d_in[i];
    p.out = (float*)d_out; p.ws = (unsigned char*)d_ws;
    if (ws_size < WS_END) { fprintf(stderr, "kernel_launch: workspace too small: %zu < %zu\n", ws_size, (size_t)WS_END); }
#if MULTI
    const int grid = 256;
    launch_phase<0>(p, 0, grid, stream);
    launch_phase<1>(p, 0, grid, stream);
    for (int l = 0; l < DEPTH; ++l) {
        launch_phase<2>(p, l, grid, stream);
        launch_phase<3>(p, l, grid, stream);
        launch_phase<4>(p, l, grid, stream);
        launch_phase<5>(p, l, grid, stream);
        launch_phase<6>(p, l, grid, stream);
        launch_phase<7>(p, l, grid, stream);
        launch_phase<8>(p, l, grid, stream);
        launch_phase<9>(p, l, grid, stream);
        launch_phase<10>(p, l, grid, stream);
        launch_phase<11>(p, l, grid, stream);
        launch_phase<12>(p, l, grid, stream);
    }
#else
    static int grid_blocks = 0;
    if (!grid_blocks) {
        int dev = 0, cus = 0, per_cu = 0;
        (void)hipGetDevice(&dev);
        (void)hipDeviceGetAttribute(&cus, hipDeviceAttributeMultiprocessorCount, dev);
        (void)hipFuncSetAttribute((const void*)fwd_megakernel, hipFuncAttributeMaxDynamicSharedMemorySize, LDS_BYTES);
        (void)hipOccupancyMaxActiveBlocksPerMultiprocessor(&per_cu, (const void*)fwd_megakernel, 512, LDS_BYTES);
        if (per_cu < 1) per_cu = 1;
        grid_blocks = cus * per_cu;
    }
    void* args[] = {&p};
    hipError_t e = hipLaunchCooperativeKernel((const void*)fwd_megakernel, dim3(grid_blocks), dim3(512), args, LDS_BYTES, stream);
    if (e != hipSuccess) fprintf(stderr, "cooperative launch failed: %s (grid %d)\n", hipGetErrorString(e), grid_blocks);
#endif
}
```

```cpp
#include <hip/hip_runtime.h>
#include <hip/hip_cooperative_groups.h>
#include <cstdio>
namespace cg = cooperative_groups;

#define LAS __attribute__((address_space(3)))
typedef unsigned short bf16_t;
typedef short bf16x8 __attribute__((ext_vector_type(8)));
typedef float f32x4 __attribute__((ext_vector_type(4)));
typedef float f32x2 __attribute__((ext_vector_type(2)));
typedef unsigned u32x4 __attribute__((ext_vector_type(4)));
typedef unsigned u32x2 __attribute__((ext_vector_type(2)));

constexpr int D = 1024, NTOK = 20480, NCTX = 4096, DEPTH = 4;
constexpr int ZLD = 7168;
constexpr int ZU = 0, ZV = 512, ZQ = 1024, ZK = 1536, ZVV = 2048, ZR = 3072, ZG = 4096;
constexpr int N1 = 8448;
constexpr int DFF = 2816;
constexpr int NFFT_WG = 128;

constexpr size_t WS_MOD  = 0;
constexpr size_t WS_DLAT = WS_MOD + 4ull * 9 * 6144 * 4;
constexpr size_t WS_DCTX = WS_DLAT + 2048ull * 4096 * 2;
constexpr size_t WS_W1T  = WS_DCTX + 256ull * 512 * 2;
constexpr size_t WS_WUPT = WS_W1T;
constexpr size_t WS_WDNT = WS_W1T + 5632ull * 1024 * 2;
constexpr size_t WS_WMT  = WS_W1T + (size_t)N1 * 1024 * 2;
constexpr size_t WS_WOT  = WS_WMT + 1024ull * 2048 * 2;
constexpr size_t WS_H    = WS_WOT + 1024ull * 1024 * 2;
constexpr size_t WS_XT   = WS_H + (size_t)NTOK * 1024 * 2;
constexpr size_t WS_XTL  = WS_XT + 16ull * 512 * 512 * 2;
constexpr size_t WS_Z    = WS_XT + (size_t)NTOK * 1024 * 2;
constexpr size_t WS_LR   = WS_Z + (size_t)NTOK * ZLD * 2;
constexpr size_t WS_AM   = WS_LR + (size_t)NTOK * 32 * 4;
constexpr size_t WS_BAR  = WS_AM + (size_t)NTOK * 2048 * 2;
constexpr size_t WS_END  = WS_BAR + 16384;
constexpr size_t WS_AG   = WS_Z;
constexpr size_t WS_FF   = WS_Z + (size_t)NTOK * 5632 * 2;
static_assert(WS_FF + (size_t)NTOK * DFF * 2 <= WS_END, "ffn alias");

constexpr int LDS_BYTES = 131072 + 8192;

struct P {
    const float* in[27];
    float* out;
    unsigned char* ws;
};

__device__ __forceinline__ int ltid() { int t = threadIdx.x; asm volatile("" : "+v"(t)); return t; }
__device__ __forceinline__ int lwg() { int b = blockIdx.x; asm volatile("" : "+s"(b)); return b; }
__device__ __forceinline__ int lnwg() { int b = gridDim.x; asm volatile("" : "+s"(b)); return b; }

__device__ __forceinline__ float bf2f(unsigned v) { return __uint_as_float(v << 16); }
typedef __bf16 bf2_t __attribute__((ext_vector_type(2)));
__device__ __forceinline__ unsigned cvt_pk_bf16(float lo, float hi) { const f32x2 v = {lo, hi}; const bf2_t b = __builtin_convertvector(v, bf2_t); return __builtin_bit_cast(unsigned, b); }
__device__ __forceinline__ bf16_t f2bf(float f) { return (bf16_t)(cvt_pk_bf16(f, 0.f) & 0xffffu); }
__device__ __forceinline__ float sigmoidf_(float x) { return 1.0f / (1.0f + __expf(-x)); }
__device__ __forceinline__ float siluf_(float x) { return x / (1.0f + __expf(-x)); }
__device__ __forceinline__ float geluf_(float x) { const float y = 1.5957691216057308f * (x + 0.044715f * x * x * x); return x / (1.0f + __expf(-y)); }
__device__ __forceinline__ float wave_sum(float v) {
#pragma unroll
    for (int o = 32; o >= 1; o >>= 1) v += __shfl_xor(v, o);
    return v;
}
__device__ __forceinline__ void unpack8(const u32x4 w, float (&f)[8]) {
    f[0] = bf2f(w.x & 0xffffu); f[1] = bf2f(w.x >> 16); f[2] = bf2f(w.y & 0xffffu); f[3] = bf2f(w.y >> 16);
    f[4] = bf2f(w.z & 0xffffu); f[5] = bf2f(w.z >> 16); f[6] = bf2f(w.w & 0xffffu); f[7] = bf2f(w.w >> 16);
}
__device__ __forceinline__ u32x4 pack8(const float (&f)[8]) {
    u32x4 w; w.x = cvt_pk_bf16(f[0], f[1]); w.y = cvt_pk_bf16(f[2], f[3]); w.z = cvt_pk_bf16(f[4], f[5]); w.w = cvt_pk_bf16(f[6], f[7]); return w;
}

constexpr int BM = 256, BK = 64, HALF = 128, HTB = HALF * BK * 2;
__device__ __forceinline__ int lds_byte(int r, int c) { const int st = (r >> 4) * 2 + (c >> 5), rr = r & 15, cc = c & 31, ob = rr * 64 + cc * 2; return st * 1024 + (ob ^ (((ob >> 9) & 1) << 5)); }
__device__ __forceinline__ void stage_rc(int b, int& R, int& C) { const int st = b / 1024, sb = b % 1024, swz = sb ^ (((sb >> 9) & 1) << 5); R = (st >> 1) * 16 + swz / 64; C = (st & 1) * 32 + (swz % 64) / 2; }
__device__ __forceinline__ int perm32(int rho) { const int n = rho >> 4, i = rho & 15; return 8 * (i >> 2) + 4 * n + (i & 3); }

struct Unit { int pm, pn, aux; };

__device__ __forceinline__ void tile_map(int L, int nM, int nN, int& pm, int& pn) {
    const int nwg = nM * nN; int wgid = L;
    { const int q = nwg / 8, r = nwg % 8, xcd = wgid % 8, off = wgid / 8; wgid = (xcd < r ? xcd * (q + 1) : r * (q + 1) + (xcd - r) * q) + off; }
    const int nig = 8 * nN, gid = wgid / nig, fm = gid * 8, gsz = (nM - fm) < 8 ? (nM - fm) : 8;
    pm = fm + ((wgid % nig) % gsz); pn = (wgid % nig) / gsz;
}

struct SchedStd {
    const bf16_t* A; const bf16_t* Bt; int lda, ldb, K, nM, nN, G, c;
    __device__ __forceinline__ bool next(int i, Unit& u) const { const int L = i * G + c; if (L >= nM * nN) return false; tile_map(L, nM, nN, u.pm, u.pn); u.aux = 0; return true; }
    __device__ __forceinline__ const char* a_ptr(const Unit& u) const { return (const char*)A + (size_t)u.pm * 256 * lda * 2; }
    __device__ __forceinline__ const char* b_ptr(const Unit& u) const { return (const char*)Bt + (size_t)u.pn * 256 * ldb * 2; }
};
struct SchedMerge {
    const bf16_t* A; const bf16_t* Bt; int lda, ldb, K, G, c;
    __device__ __forceinline__ bool next(int i, Unit& u) const { const int L = (i >> 2) * G + c; if (L >= 320) return false; tile_map(L, 80, 4, u.pm, u.pn); u.aux = i & 3; return true; }
    __device__ __forceinline__ const char* a_ptr(const Unit& u) const { return (const char*)A + ((size_t)u.pm * 256 * lda + u.aux * 512) * 2; }
    __device__ __forceinline__ const char* b_ptr(const Unit& u) const { return (const char*)Bt + ((size_t)u.pn * 256 * ldb + u.aux * 512) * 2; }
};
struct SchedFftL {
    const bf16_t* A; const bf16_t* Bt; int lda, ldb, K, G, c;
    __device__ __forceinline__ bool next(int i, Unit& u) const { const int L = i * G + c; if (L >= 128) return false; const int b = L >> 4, rem = L & 15; u.pm = 16 + b * 8 + (rem >> 1); u.pn = rem & 1; u.aux = b; return true; }
    __device__ __forceinline__ const char* a_ptr(const Unit& u) const { return (const char*)A + (size_t)((u.pm - 16) & 7) * 256 * 4096 * 2; }
    __device__ __forceinline__ const char* b_ptr(const Unit& u) const { return (const char*)Bt + ((size_t)u.aux * 512 + u.pn * 256) * 4096 * 2; }
};
struct SchedFftC {
    const bf16_t* A; const bf16_t* Bt; int lda, ldb, K, G, c;
    __device__ __forceinline__ bool next(int i, Unit& u) const { const int L = i * G + c; if (L >= 32) return false; u.pm = L >> 1; u.pn = L & 1; u.aux = 0; return true; }
    __device__ __forceinline__ const char* a_ptr(const Unit&) const { return (const char*)A; }
    __device__ __forceinline__ const char* b_ptr(const Unit& u) const { return (const char*)Bt + ((size_t)u.pm * 512 + u.pn * 256) * 512 * 2; }
};

struct EpiIn {
    static constexpr bool PERM = true;
    bf16_t* Z; bf16_t* XTc; bf16_t* XTl; float* LR; const float* bmerge;
    __device__ __forceinline__ void operator()(const f32x4 (&acc)[2][2][4][2], const Unit& u, int wr, int wc, int fr, int fq) const {
        const int pn = u.pn, cl = wc * 32 + 8 * fq;
        if (pn < 4) {
            bf16_t* base; int ldk, t0; const int cs = pn >> 1;
            if (u.pm < 16) { base = XTc + (size_t)u.pm * 512 * 512; ldk = 512; t0 = cs * 256; }
            else { const int b = (u.pm - 16) >> 3; base = XTl + (size_t)b * 512 * 4096; ldk = 4096; t0 = cs * 2048 + ((u.pm - 16) & 7) * 256; }
            t0 += wr * 64 + fr;
#pragma unroll
            for (int ai = 0; ai < 2; ++ai)
#pragma unroll
                for (int m = 0; m < 4; ++m) { const int t = t0 + ai * 128 + m * 16;
#pragma unroll
                    for (int bj = 0; bj < 2; ++bj)
#pragma unroll
                        for (int n = 0; n < 2; ++n) { const int c = (pn & 1) * 256 + bj * 128 + cl + n * 4; const f32x4 v = acc[ai][bj][m][n];
                            const unsigned p0 = cvt_pk_bf16(v[0], v[1]), p1 = cvt_pk_bf16(v[2], v[3]);
                            bf16_t* q = base + (size_t)c * ldk + t;
                            q[0] = (bf16_t)(p0 & 0xffffu); q[ldk] = (bf16_t)(p0 >> 16); q[2 * ldk] = (bf16_t)(p1 & 0xffffu); q[3 * ldk] = (bf16_t)(p1 >> 16); } }
        } else if (pn < 32) {
            const int zc0 = (pn - 4) * 256 + cl;
            const int mode = pn < 8 ? 1 : (pn < 16 ? 0 : (pn < 20 ? 2 : 3));
            f32x4 bv[2][2];
#pragma unroll
            for (int bj = 0; bj < 2; ++bj)
#pragma unroll
                for (int n = 0; n < 2; ++n) bv[bj][n] = (mode == 3) ? *(const f32x4*)(bmerge + (zc0 - ZG) + bj * 128 + n * 4) : (f32x4){0.f, 0.f, 0.f, 0.f};
            const int row0 = u.pm * 256 + wr * 64 + fr;
#pragma unroll
            for (int ai = 0; ai < 2; ++ai)
#pragma unroll
                for (int m = 0; m < 4; ++m) { bf16_t* rowp = Z + (size_t)(row0 + ai * 128 + m * 16) * ZLD + zc0;
#pragma unroll
                    for (int bj = 0; bj < 2; ++bj) { float f[8];
#pragma unroll
                        for (int j = 0; j < 4; ++j) { f[j] = acc[ai][bj][m][0][j] + bv[bj][0][j]; f[4 + j] = acc[ai][bj][m][1][j] + bv[bj][1][j]; }
                        if (mode == 1) {
#pragma unroll
                            for (int j = 0; j < 8; ++j) f[j] = geluf_(f[j]); }
                        else if (mode == 2) {
#pragma unroll
                            for (int j = 0; j < 8; ++j) f[j] = siluf_(f[j]); }
                        else if (mode == 3) {
#pragma unroll
                            for (int j = 0; j < 8; ++j) f[j] = sigmoidf_(f[j]); }
                        *(u32x4*)(rowp + bj * 128) = pack8(f); } }
        } else {
            if (wc == 0) { const int row0 = u.pm * 256 + wr * 64 + fr;
#pragma unroll
                for (int ai = 0; ai < 2; ++ai)
#pragma unroll
                    for (int m = 0; m < 4; ++m) { float* q = LR + (size_t)(row0 + ai * 128 + m * 16) * 32 + 8 * fq;
                        *(f32x4*)q = acc[ai][0][m][0]; *(f32x4*)(q + 4) = acc[ai][0][m][1]; } }
        }
    }
};
struct EpiBf16 {
    static constexpr bool PERM = true;
    bf16_t* O; int ldc;
    __device__ __forceinline__ void operator()(const f32x4 (&acc)[2][2][4][2], const Unit& u, int wr, int wc, int fr, int fq) const {
        const int row0 = u.pm * 256 + wr * 64 + fr, col0 = u.pn * 256 + wc * 32 + 8 * fq;
#pragma unroll
        for (int ai = 0; ai < 2; ++ai)
#pragma unroll
            for (int m = 0; m < 4; ++m) { bf16_t* rowp = O + (size_t)(row0 + ai * 128 + m * 16) * ldc + col0;
#pragma unroll
                for (int bj = 0; bj < 2; ++bj) { const f32x4 v0 = acc[ai][bj][m][0], v1 = acc[ai][bj][m][1];
                    u32x4 w; w.x = cvt_pk_bf16(v0[0], v0[1]); w.y = cvt_pk_bf16(v0[2], v0[3]); w.z = cvt_pk_bf16(v1[0], v1[1]); w.w = cvt_pk_bf16(v1[2], v1[3]);
                    *(u32x4*)(rowp + bj * 128) = w; } }
    }
};
struct EpiMerge {
    static constexpr bool PERM = true;
    bf16_t* Mo; const bf16_t* Z;
    __device__ __forceinline__ void operator()(const f32x4 (&acc)[2][2][4][2], const Unit& u, int wr, int wc, int fr, int fq) const {
        const int br = u.aux, gb = br < 2 ? br : 2;
        const int row0 = u.pm * 256 + wr * 64 + fr, col0 = u.pn * 256 + wc * 32 + 8 * fq;
#pragma unroll
        for (int ai = 0; ai < 2; ++ai)
#pragma unroll
            for (int m = 0; m < 4; ++m) { const size_t row = (size_t)(row0 + ai * 128 + m * 16);
#pragma unroll
                for (int bj = 0; bj < 2; ++bj) {
                    float g[8], f[8]; unpack8(*(const u32x4*)(Z + row * ZLD + ZG + gb * 1024 + col0 + bj * 128), g);
#pragma unroll
                    for (int j = 0; j < 4; ++j) { f[j] = acc[ai][bj][m][0][j] * g[j]; f[4 + j] = acc[ai][bj][m][1][j] * g[4 + j]; }
                    bf16_t* op = Mo + row * 1024 + col0 + bj * 128;
                    if (br > 0) { float pv[8]; unpack8(*(const u32x4*)op, pv);
#pragma unroll
                        for (int j = 0; j < 8; ++j) f[j] += pv[j]; }
                    *(u32x4*)op = pack8(f); } }
    }
};
struct EpiResid {
    static constexpr bool PERM = false;
    const float* xin_ctx; const float* xin_lat; float* xout; const float* gate;
    __device__ __forceinline__ void operator()(const f32x4 (&acc)[2][2][4][2], const Unit& u, int wr, int wc, int fr, int fq) const {
        const float alpha = 1.681792830507429f;
        const int cond = u.pm < 16 ? 0 : 1 + ((u.pm - 16) >> 3);
        const int col0 = u.pn * 256 + wc * 32 + 4 * fq, row0 = u.pm * 256 + wr * 64 + fr;
        const float* gp = gate + (size_t)cond * 6144 + col0;
        f32x4 gv[2][2];
#pragma unroll
        for (int bj = 0; bj < 2; ++bj)
#pragma unroll
            for (int n = 0; n < 2; ++n) gv[bj][n] = *(const f32x4*)(gp + bj * 128 + n * 16);
        const float* xin = u.pm < 16 ? xin_ctx : xin_lat - (size_t)NCTX * 1024;
#pragma unroll
        for (int ai = 0; ai < 2; ++ai)
#pragma unroll
            for (int m = 0; m < 4; ++m) { const size_t off = (size_t)(row0 + ai * 128 + m * 16) * 1024 + col0;
#pragma unroll
                for (int bj = 0; bj < 2; ++bj)
#pragma unroll
                    for (int n = 0; n < 2; ++n) { const f32x4 xv = *(const f32x4*)(xin + off + bj * 128 + n * 16);
                        *(f32x4*)(xout + off + bj * 128 + n * 16) = alpha * xv + gv[bj][n] * acc[ai][bj][m][n]; } }
    }
};

template <class Epi, class Sched>
__device__ __forceinline__ void gemm_phase(LAS unsigned char* lds, const Sched& S, const Epi& E) {
    const int tid = ltid(), wid = __builtin_amdgcn_readfirstlane(tid >> 6), lane = tid & 63, wr = wid >> 2, wc = wid & 3, fr = lane & 15, fq = lane >> 4;
    const int K = S.K, nt = K / BK, lda = S.lda, ldb = S.ldb;
    unsigned voffA[2], voffB[2];
#pragma unroll
    for (int i = 0; i < 2; ++i) { int R, C; stage_rc(tid * 16 + i * 8192, R, C); const int Rb = Epi::PERM ? ((R & ~31) + perm32(R & 31)) : R;
        voffA[i] = (unsigned)(R * lda + C) * 2u; voffB[i] = (unsigned)(Rb * ldb + C) * 2u; }
    const size_t kstep = (size_t)(BK * 2);
    const size_t hstepA = (size_t)HALF * lda * 2, hstepB = (size_t)HALF * ldb * 2;
    const unsigned ldsw = (unsigned)wid * 1024u;
    const int aoff = lds_byte(wr * 64 + fr, fq * 8), boff = lds_byte(wc * 32 + fr, fq * 8);
#define PG8_SA(b, h) (((b) * 2 + (h)) * HTB)
#define PG8_SB(b, h) ((4 + (b) * 2 + (h)) * HTB)
#define PG8_STAGE(bufoff, gbase, voff) do { _Pragma("unroll") for (int _i = 0; _i < 2; ++_i) \
        __builtin_amdgcn_global_load_lds((const unsigned*)((const char*)(gbase) + (voff)[_i]), (LAS unsigned*)(lds + (bufoff) + ldsw + _i * 8192), 16, 0, 0); } while (0)
#define PG8_LDA(dst, b, h) do { _Pragma("unroll") for (int m = 0; m < 4; ++m) _Pragma("unroll") for (int k = 0; k < 2; ++k) dst[m][k] = *(const LAS bf16x8*)(lds + PG8_SA(b, h) + aoff + m * 2048 + k * 1024); } while (0)
#define PG8_LDB(dst, b, h) do { _Pragma("unroll") for (int n = 0; n < 2; ++n) _Pragma("unroll") for (int k = 0; k < 2; ++k) dst[n][k] = *(const LAS bf16x8*)(lds + PG8_SB(b, h) + boff + n * 2048 + k * 1024); } while (0)
#define PG8_MMA(ai, bj, At, Bt) do { __builtin_amdgcn_s_setprio(1); _Pragma("unroll") for (int m = 0; m < 4; ++m) _Pragma("unroll") for (int n = 0; n < 2; ++n) _Pragma("unroll") for (int k = 0; k < 2; ++k) \
        acc[ai][bj][m][n] = __builtin_amdgcn_mfma_f32_16x16x32_bf16(Bt[n][k], At[m][k], acc[ai][bj][m][n], 0, 0, 0); __builtin_amdgcn_s_setprio(0); } while (0)
#define PG8_WAIT_V(n) asm volatile("s_waitcnt vmcnt(" #n ")" ::: "memory")
#define PG8_WAIT_L(n) asm volatile("s_waitcnt lgkmcnt(" #n ")" ::: "memory")
#define PG8_BAR __builtin_amdgcn_s_barrier()
#define PG8_SCHED __builtin_amdgcn_sched_barrier(0)
    Unit cur, nxt; int ui = 0;
    if (!S.next(0, cur)) return;
    f32x4 acc[2][2][4][2];
#pragma unroll
    for (int a = 0; a < 2; ++a)
#pragma unroll
        for (int b = 0; b < 2; ++b)
#pragma unroll
            for (int m = 0; m < 4; ++m)
#pragma unroll
                for (int n = 0; n < 2; ++n) acc[a][b][m][n] = (f32x4){0.f, 0.f, 0.f, 0.f};
    bf16x8 At[4][2], B0[2][2], B1[2][2];
    const char* cA = S.a_ptr(cur); const char* cB = S.b_ptr(cur);
    PG8_STAGE(PG8_SB(0, 0), cB, voffB); PG8_STAGE(PG8_SA(0, 0), cA, voffA); PG8_STAGE(PG8_SB(0, 1), cB + hstepB, voffB); PG8_STAGE(PG8_SA(0, 1), cA + hstepA, voffA);
    if (wr == 1) PG8_BAR;
    PG8_WAIT_V(4); PG8_BAR;
    PG8_STAGE(PG8_SB(1, 0), cB + kstep, voffB); PG8_STAGE(PG8_SA(1, 0), cA + kstep, voffA); PG8_STAGE(PG8_SB(1, 1), cB + hstepB + kstep, voffB);
    PG8_WAIT_V(6); PG8_BAR;
    for (;;) {
        const bool has_next = S.next(ui + 1, nxt);
        const char* nA = has_next ? S.a_ptr(nxt) : cA; const char* nB = has_next ? S.b_ptr(nxt) : cB;
        for (int t = 0; t < nt; t += 2) {
            const bool last = (t == nt - 2);
            const char* a1 = cA + (size_t)(t + 1) * kstep;
            const char* a2 = last ? nA : cA + (size_t)(t + 2) * kstep; const char* b2 = last ? nB : cB + (size_t)(t + 2) * kstep;
            const char* a3 = a2 + kstep; const char* b3 = b2 + kstep;
            PG8_LDB(B0, 0, 0); PG8_SCHED; PG8_LDA(At, 0, 0); PG8_STAGE(PG8_SA(1, 1), a1 + hstepA, voffA);
            PG8_WAIT_L(8); PG8_BAR; PG8_WAIT_L(0); PG8_MMA(0, 0, At, B0); PG8_BAR; PG8_SCHED;
            PG8_LDB(B1, 0, 1); PG8_STAGE(PG8_SB(0, 0), b2, voffB);
            PG8_BAR; PG8_WAIT_L(0); PG8_MMA(0, 1, At, B1); PG8_BAR;
            PG8_LDA(At, 0, 1); PG8_STAGE(PG8_SA(0, 0), a2, voffA);
            PG8_BAR; PG8_WAIT_L(0); PG8_MMA(1, 0, At, B0); PG8_BAR; PG8_SCHED;
            PG8_STAGE(PG8_SB(0, 1), b2 + hstepB, voffB);
            PG8_WAIT_V(6); PG8_BAR; PG8_MMA(1, 1, At, B1); PG8_BAR;
            PG8_LDB(B0, 1, 0); PG8_SCHED; PG8_LDA(At, 1, 0); PG8_STAGE(PG8_SA(0, 1), a2 + hstepA, voffA);
            PG8_WAIT_L(8); PG8_BAR; PG8_WAIT_L(0); PG8_MMA(0, 0, At, B0); PG8_BAR; PG8_SCHED;
            PG8_LDB(B1, 1, 1); PG8_STAGE(PG8_SB(1, 0), b3, voffB);
            PG8_BAR; PG8_WAIT_L(0); PG8_MMA(0, 1, At, B1); PG8_BAR;
            PG8_LDA(At, 1, 1); PG8_STAGE(PG8_SA(1, 0), a3, voffA);
            PG8_BAR; PG8_WAIT_L(0); PG8_MMA(1, 0, At, B0); PG8_BAR; PG8_SCHED;
            PG8_STAGE(PG8_SB(1, 1), b3 + hstepB, voffB);
            PG8_WAIT_V(6); PG8_BAR; PG8_MMA(1, 1, At, B1); PG8_BAR;
        }
        E(acc, cur, wr, wc, fr, fq);
        if (!has_next) break;
#pragma unroll
        for (int a = 0; a < 2; ++a)
#pragma unroll
            for (int b = 0; b < 2; ++b)
#pragma unroll
                for (int m = 0; m < 4; ++m)
#pragma unroll
                    for (int n = 0; n < 2; ++n) acc[a][b][m][n] = (f32x4){0.f, 0.f, 0.f, 0.f};
        cur = nxt; cA = nA; cB = nB; ++ui;
    }
    PG8_WAIT_V(0);
    if (wr == 0) PG8_BAR;
    PG8_BAR;
#undef PG8_SA
#undef PG8_SB
#undef PG8_STAGE
#undef PG8_LDA
#undef PG8_LDB
#undef PG8_MMA
#undef PG8_WAIT_V
#undef PG8_WAIT_L
#undef PG8_BAR
#undef PG8_SCHED
}

__device__ __forceinline__ void mods_phase(const P& p, float* MOD, float* ldsf) {
    const int tid = ltid(), wid = tid >> 6, lane = tid & 63;
    float* sc = ldsf;
    float* red = ldsf + 9 * 1024;
    for (int i = tid; i < 9 * 1024; i += 512) { const int j = i >> 10, k = i & 1023; const float v = j == 0 ? p.in[4][k] : p.in[3][(j - 1) * 1024 + k]; sc[i] = siluf_(v); }
    __syncthreads();
    for (int item = lwg(); item < 384; item += lnwg()) {
        const int l = item / 96, col0 = (item % 96) * 64;
        const float* w = p.in[19] + (size_t)l * 1024 * 6144 + col0 + lane;
        float a[9];
#pragma unroll
        for (int j = 0; j < 9; ++j) a[j] = 0.f;
        const int kb = wid * 128;
#pragma unroll 8
        for (int k = 0; k < 128; ++k) { const float wv = w[(size_t)(kb + k) * 6144];
#pragma unroll
            for (int j = 0; j < 9; ++j) a[j] += sc[j * 1024 + kb + k] * wv; }
#pragma unroll
        for (int j = 0; j < 9; ++j) red[(wid * 9 + j) * 64 + lane] = a[j];
        __syncthreads();
        for (int i = tid; i < 576; i += 512) { const int j = i >> 6, ln = i & 63; float s = p.in[20][l * 6144 + col0 + ln];
#pragma unroll
            for (int w8 = 0; w8 < 8; ++w8) s += red[(w8 * 9 + j) * 64 + ln];
            MOD[(size_t)(l * 9 + j) * 6144 + col0 + ln] = s; }
        __syncthreads();
    }
}

__device__ __forceinline__ void dft_phase(bf16_t* DL, bf16_t* DC) {
    const size_t gt = (size_t)lwg() * 512 + ltid(), gn = (size_t)lnwg() * 512;
    for (size_t i = gt; i < 2048ull * 4096 / 8; i += gn) { const int k = (int)(i / 512), t0 = (int)(i % 512) * 8; float f[8];
#pragma unroll
        for (int j = 0; j < 8; ++j) { const int tt = t0 + j, t = tt & 2047; const int m = (k * t) & 2047; const float x = (float)m * (1.0f / 1024.0f);
            f[j] = (tt < 2048 ? cospif(x) : -sinpif(x)) * (1.0f / 512.0f); }
        *(u32x4*)(DL + i * 8) = pack8(f); }
    for (size_t i = gt; i < 256ull * 512 / 8; i += gn) { const int k = (int)(i / 64), t0 = (int)(i % 64) * 8; float f[8];
#pragma unroll
        for (int j = 0; j < 8; ++j) { const int tt = t0 + j, t = tt & 255; const int m = (k * t) & 255; const float x = (float)m * (1.0f / 128.0f);
            f[j] = (tt < 256 ? cospif(x) : -sinpif(x)) * 0.005524271728019903f; }
        *(u32x4*)(DC + i * 8) = pack8(f); }
}

__device__ __forceinline__ void tconv_tile(const float* src, int ld_src, bf16_t* dst, int ld_dst, int k0, int n0, float scale, float* tl) {
    const int tid = ltid();
#pragma unroll
    for (int ps = 0; ps < 4; ++ps) { const int kr = ps * 16 + (tid >> 5), nc = (tid & 31) * 4;
        const f32x4 v = *(const f32x4*)(src + (size_t)(k0 + kr) * ld_src + n0 + nc);
        float* q = tl + kr * 129 + nc; q[0] = v[0]; q[1] = v[1]; q[2] = v[2]; q[3] = v[3]; }
    __syncthreads();
    { const int n = tid >> 2, kq = tid & 3; float f[8], g[8];
#pragma unroll
      for (int j = 0; j < 8; ++j) { f[j] = tl[(kq * 16 + j) * 129 + n] * scale; g[j] = tl[(kq * 16 + 8 + j) * 129 + n] * scale; }
      bf16_t* q = dst + (size_t)(n0 + n) * ld_dst + k0 + kq * 16;
      *(u32x4*)q = pack8(f); *(u32x4*)(q + 8) = pack8(g); }
    __syncthreads();
}

__device__ __forceinline__ void wfft_item(int item, const float* win, bf16_t* W1T, float* tl) {
    const int tid = ltid(), kb = item >> 2, g = item & 3;
    float* xin = tl;
    float* ct = tl + 2048;
    { const int r = tid >> 5, c4 = (tid & 31) * 4; const f32x4 v = *(const f32x4*)(win + (size_t)(kb * 16 + r) * 7712 + g * 128 + c4); *(f32x4*)(xin + r * 128 + c4) = v; }
    if (tid < 128) { ct[tid] = cospif((float)tid * (1.0f / 64.0f)); ct[128 + tid] = sinpif((float)tid * (1.0f / 64.0f)); }
    __syncthreads();
    { const int jj = tid & 255, cs = jj >> 7, j = jj & 127, half = tid >> 8; float a[8];
#pragma unroll
      for (int r = 0; r < 8; ++r) a[r] = 0.f;
      const float* tb = ct + cs * 128; const float* xr = xin + half * 8 * 128;
      for (int c = 0; c < 128; ++c) { const float w = tb[(j * c) & 127];
#pragma unroll
          for (int r = 0; r < 8; ++r) a[r] += xr[r * 128 + c] * w; }
      *(u32x4*)(W1T + (size_t)(cs * 512 + g * 128 + j) * 1024 + kb * 16 + half * 8) = pack8(a); }
    __syncthreads();
}

__device__ __forceinline__ void wconv_phase(const P& p, int set, int l, float* tl) {
    bf16_t* W1T = (bf16_t*)(p.ws + WS_W1T); bf16_t* WMT = (bf16_t*)(p.ws + WS_WMT); bf16_t* WOT = (bf16_t*)(p.ws + WS_WOT);
    bf16_t* WUPT = (bf16_t*)(p.ws + WS_WUPT); bf16_t* WDNT = (bf16_t*)(p.ws + WS_WDNT);
    const float* win = p.in[5] + (size_t)l * 1024 * 7712;
    if (set == 0) {
        for (int it = lwg(); it < 1153; it += lnwg()) {
            if (it < 256) wfft_item(it, win, W1T, tl);
            else if (it < 768) { const int j = it - 256, tk = j & 15, tn = j >> 4; const int n0 = tn * 128;
                tconv_tile(win + 512, 7712, W1T + (size_t)1024 * 1024, 1024, tk * 64, n0, (n0 >= 1024 && n0 < 1536) ? 0.08838834764831845f : 1.0f, tl); }
            else if (it < 1152) { const int j = it - 768, tk = j & 15, tn = j >> 4;
                tconv_tile(win + 4640, 7712, W1T + (size_t)5120 * 1024, 1024, tk * 64, tn * 128, 1.0f, tl); }
            else { for (int i = ltid(); i < 256 * 1024; i += 512) { const int n = i >> 10, k = i & 1023;
                    W1T[(size_t)(8192 + n) * 1024 + k] = n < 32 ? f2bf(win[(size_t)k * 7712 + 4608 + n]) : (bf16_t)0; } }
        }
    } else if (set == 1) {
        for (int it = lwg(); it < 384; it += lnwg()) {
            if (it < 64) { const int tk = it & 7, tn = it >> 3; tconv_tile(p.in[7] + (size_t)l * 512 * 1024, 1024, WMT, 2048, tk * 64, tn * 128, 1.0f, tl); }
            else if (it < 128) { const int j = it - 64, tk = j & 7, tn = j >> 3; tconv_tile(p.in[11] + (size_t)l * 512 * 1024, 1024, WMT + 512, 2048, tk * 64, tn * 128, 1.0f, tl); }
            else if (it < 256) { const int j = it - 128, tk = j & 15, tn = j >> 4; tconv_tile(p.in[15] + (size_t)l * 1024 * 1024, 1024, WMT + 1024, 2048, tk * 64, tn * 128, 1.0f, tl); }
            else { const int j = it - 256, tk = j & 15, tn = j >> 4; tconv_tile(p.in[16] + (size_t)l * 1024 * 1024, 1024, WOT, 1024, tk * 64, tn * 128, 1.0f, tl); }
        }
    } else {
        for (int it = lwg(); it < 1056; it += lnwg()) {
            if (it < 704) { const int tk = it & 15, tn = it >> 4; tconv_tile(p.in[21] + (size_t)l * 1024 * 5632, 5632, WUPT, 1024, tk * 64, tn * 128, 1.0f, tl); }
            else { const int j = it - 704, tn = j & 7, tk = j >> 3; tconv_tile(p.in[24] + (size_t)l * DFF * 1024, 1024, WDNT, DFF, tk * 64, tn * 128, 1.0f, tl); }
        }
    }
}

__device__ __forceinline__ void ln_phase(const float* src_ctx, const float* src_lat, float* xout, const float* g, const float* b, bool doLN,
                                         bool doH, const float* modl, int sci, int shi, bf16_t* H) {
    const int lane = ltid() & 63, gw = lwg() * 8 + (ltid() >> 6), nw = lnwg() * 8;
    for (int row = gw; row < NTOK; row += nw) {
        const float* src = row < NCTX ? src_ctx + (size_t)row * 1024 : src_lat + (size_t)(row - NCTX) * 1024;
        f32x4 v[4];
#pragma unroll
        for (int i = 0; i < 4; ++i) v[i] = *(const f32x4*)(src + i * 256 + lane * 4);
        if (doLN) {
            float s = 0.f;
#pragma unroll
            for (int i = 0; i < 4; ++i) s += (v[i][0] + v[i][1]) + (v[i][2] + v[i][3]);
            const float mean = wave_sum(s) * (1.0f / 1024.0f); float q = 0.f;
#pragma unroll
            for (int i = 0; i < 4; ++i) { const f32x4 d = v[i] - mean; q += (d[0] * d[0] + d[1] * d[1]) + (d[2] * d[2] + d[3] * d[3]); }
            const float rstd = rsqrtf(wave_sum(q) * (1.0f / 1024.0f) + 1e-5f);
#pragma unroll
            for (int i = 0; i < 4; ++i) { const f32x4 gg = *(const f32x4*)(g + i * 256 + lane * 4), bb = *(const f32x4*)(b + i * 256 + lane * 4);
                v[i] = (v[i] - mean) * rstd * gg + bb; *(f32x4*)(xout + (size_t)row * 1024 + i * 256 + lane * 4) = v[i]; }
        }
        if (doH) {
            const int cond = row < NCTX ? 0 : 1 + ((row - NCTX) >> 11);
            const float* mp = modl + (size_t)cond * 6144;
            float s = 0.f;
#pragma unroll
            for (int i = 0; i < 4; ++i) s += (v[i][0] + v[i][1]) + (v[i][2] + v[i][3]);
            const float mean = wave_sum(s) * (1.0f / 1024.0f); float q = 0.f;
#pragma unroll
            for (int i = 0; i < 4; ++i) { const f32x4 d = v[i] - mean; q += (d[0] * d[0] + d[1] * d[1]) + (d[2] * d[2] + d[3] * d[3]); }
            const float rstd = rsqrtf(wave_sum(q) * (1.0f / 1024.0f) + 1e-5f);
#pragma unroll
            for (int i = 0; i < 4; ++i) { const f32x4 scv = *(const f32x4*)(mp + sci * 1024 + i * 256 + lane * 4), shv = *(const f32x4*)(mp + shi * 1024 + i * 256 + lane * 4);
                const f32x4 h = (v[i] - mean) * rstd * (1.0f + scv) + shv;
                u32x2 w; w.x = cvt_pk_bf16(h[0], h[1]); w.y = cvt_pk_bf16(h[2], h[3]);
                *(u32x2*)(H + (size_t)row * 1024 + i * 256 + lane * 4) = w; }
        }
    }
}

__device__ __forceinline__ void glapost_phase(bf16_t* AM, const bf16_t* OB, const bf16_t* Z, const float* ng) {
    const int lane = ltid() & 63, gw = lwg() * 8 + (ltid() >> 6), nw = lnwg() * 8;
    float gn[16];
#pragma unroll
    for (int j = 0; j < 16; ++j) gn[j] = ng[(lane & 15) * 16 + j];
    for (int row = gw; row < NTOK; row += nw) {
        bf16_t* op = AM + (size_t)row * 2048 + 1024 + lane * 16;
        const bf16_t* bp = OB + (size_t)row * 1024 + lane * 16;
        const bf16_t* rp = Z + (size_t)row * ZLD + ZR + lane * 16;
        float a[16], bq[16], r[16];
        { float t[8]; unpack8(*(const u32x4*)op, t);
#pragma unroll
          for (int j = 0; j < 8; ++j) a[j] = t[j];
          unpack8(*(const u32x4*)(op + 8), t);
#pragma unroll
          for (int j = 0; j < 8; ++j) a[8 + j] = t[j];
          unpack8(*(const u32x4*)bp, t);
#pragma unroll
          for (int j = 0; j < 8; ++j) bq[j] = t[j];
          unpack8(*(const u32x4*)(bp + 8), t);
#pragma unroll
          for (int j = 0; j < 8; ++j) bq[8 + j] = t[j];
          unpack8(*(const u32x4*)rp, t);
#pragma unroll
          for (int j = 0; j < 8; ++j) r[j] = t[j];
          unpack8(*(const u32x4*)(rp + 8), t);
#pragma unroll
          for (int j = 0; j < 8; ++j) r[8 + j] = t[j]; }
        float ss = 0.f;
#pragma unroll
        for (int j = 0; j < 16; ++j) { a[j] += bq[j]; ss += a[j] * a[j]; }
        ss += __shfl_xor(ss, 1); ss += __shfl_xor(ss, 2); ss += __shfl_xor(ss, 4); ss += __shfl_xor(ss, 8);
        const float rs = rsqrtf(ss * (1.0f / 256.0f) + 1e-5f);
        float o0[8], o1[8];
#pragma unroll
        for (int j = 0; j < 8; ++j) { o0[j] = a[j] * rs * gn[j] * r[j]; o1[j] = a[8 + j] * rs * gn[8 + j] * r[8 + j]; }
        *(u32x4*)op = pack8(o0); *(u32x4*)(op + 8) = pack8(o1);
    }
}

__device__ __forceinline__ void conv_phase(const bf16_t* AG, bf16_t* FF, const float* wdw, const float* bdw) {
    const int g = lwg() * 512 + ltid();
    const int run = g / 352, cb = g - run * 352, ch = cb * 8;
    if (run < 320) {
        const bool lat = run >= 64;
        const int tok0 = lat ? NCTX + (run - 64) * 64 : run * 64;
        const int gy = (run - 64) & 31;
        const bool up = lat && gy > 0, dn = lat && gy < 31;
        const int xlo = lat ? 0 : -(tok0 & 255), xhi = lat ? 63 : 255 - (tok0 & 255);
        float w[9][8], bias[8];
#pragma unroll
        for (int t = 0; t < 9; ++t) { const f32x4 a = *(const f32x4*)(wdw + t * DFF + ch), b = *(const f32x4*)(wdw + t * DFF + ch + 4);
#pragma unroll
            for (int j = 0; j < 4; ++j) { w[t][j] = a[j]; w[t][4 + j] = b[j]; } }
        { const f32x4 a = *(const f32x4*)(bdw + ch), b = *(const f32x4*)(bdw + ch + 4);
#pragma unroll
          for (int j = 0; j < 4; ++j) { bias[j] = a[j]; bias[4 + j] = b[j]; } }
        const bf16_t* base = AG + (size_t)tok0 * 5632 + ch;
        const u32x4 zero4 = {0u, 0u, 0u, 0u};
        u32x4 c0[3], c1[3], c2[3], nx[3];
#define CONV_LOADCOL(dst, x) do { const bool okx = (x) >= xlo && (x) <= xhi; const bf16_t* q_ = base + (ptrdiff_t)(x) * 5632; \
            dst[0] = (okx && up) ? *(const u32x4*)(q_ - 64 * 5632) : zero4; dst[1] = okx ? *(const u32x4*)q_ : zero4; dst[2] = (okx && dn) ? *(const u32x4*)(q_ + 64 * 5632) : zero4; } while (0)
        CONV_LOADCOL(c0, -1); CONV_LOADCOL(c1, 0); CONV_LOADCOL(c2, 1);
#pragma unroll 1
        for (int x = 0; x < 64; ++x) {
            CONV_LOADCOL(nx, x + 2);
            const u32x4 gw = *(const u32x4*)(base + (size_t)x * 5632 + DFF);
            float acc[8];
#pragma unroll
            for (int j = 0; j < 8; ++j) acc[j] = bias[j];
#pragma unroll
            for (int dy = 0; dy < 3; ++dy) { float a[8];
                unpack8(c0[dy], a);
#pragma unroll
                for (int j = 0; j < 8; ++j) acc[j] += a[j] * w[dy * 3 + 0][j];
                unpack8(c1[dy], a);
#pragma unroll
                for (int j = 0; j < 8; ++j) acc[j] += a[j] * w[dy * 3 + 1][j];
                unpack8(c2[dy], a);
#pragma unroll
                for (int j = 0; j < 8; ++j) acc[j] += a[j] * w[dy * 3 + 2][j]; }
            float gg[8]; unpack8(gw, gg);
#pragma unroll
            for (int j = 0; j < 8; ++j) acc[j] = geluf_(acc[j]) * gg[j];
            *(u32x4*)(FF + (size_t)(tok0 + x) * DFF + ch) = pack8(acc);
#pragma unroll
            for (int dy = 0; dy < 3; ++dy) { c0[dy] = c1[dy]; c1[dy] = c2[dy]; c2[dy] = nx[dy]; }
        }
#undef CONV_LOADCOL
    }
}

__device__ __forceinline__ void sgu_item(int item, int l, const P& p, const bf16_t* Z, bf16_t* AM, LAS unsigned char* lds) {
    const int tid = ltid(), wid = tid >> 6, lane = tid & 63, fr = lane & 15, fq = lane >> 4;
    LAS float* STAT = (LAS float*)lds;
    LAS bf16_t* VT = (LAS bf16_t*)(lds + 1024);
    const int row0 = item * 128;
    for (int i = 0; i < 16; ++i) { const int q = wid * 16 + i; float f[8]; unpack8(*(const u32x4*)(Z + (size_t)(row0 + q) * ZLD + ZV + lane * 8), f);
        float s = 0.f;
#pragma unroll
        for (int j = 0; j < 8; ++j) s += f[j];
        const float mean = wave_sum(s) * (1.0f / 512.0f); float qq = 0.f;
#pragma unroll
        for (int j = 0; j < 8; ++j) { const float d = f[j] - mean; qq += d * d; }
        const float rstd = rsqrtf(wave_sum(qq) * (1.0f / 512.0f) + 1e-5f);
        if (lane == 0) { STAT[q * 2] = mean; STAT[q * 2 + 1] = rstd; } }
    __syncthreads();
    for (int g = 0; g < 4; ++g) {
        { const int q = tid >> 2, seg = tid & 3; const float mean = STAT[q * 2], rstd = STAT[q * 2 + 1];
#pragma unroll
          for (int j4 = 0; j4 < 4; ++j4) { const int c0 = seg * 32 + j4 * 8; float f[8]; unpack8(*(const u32x4*)(Z + (size_t)(row0 + q) * ZLD + ZV + g * 128 + c0), f);
              const float* sg = p.in[8] + l * 512 + g * 128 + c0;
#pragma unroll
              for (int j = 0; j < 8; ++j) VT[(c0 + j) * 136 + q] = f2bf((f[j] - mean) * rstd * sg[j]); } }
        __syncthreads();
        bf16x8 Yf[4];
        { const float* wp = p.in[9] + ((size_t)(l * 4 + g) * 128 + wid * 16 + fr) * 128 + 8 * fq;
#pragma unroll
          for (int kk = 0; kk < 4; ++kk) { const f32x4 a = *(const f32x4*)(wp + kk * 32), b = *(const f32x4*)(wp + kk * 32 + 4);
              u32x4 w; w.x = cvt_pk_bf16(a[0], a[1]); w.y = cvt_pk_bf16(a[2], a[3]); w.z = cvt_pk_bf16(b[0], b[1]); w.w = cvt_pk_bf16(b[2], b[3]);
              Yf[kk] = __builtin_bit_cast(bf16x8, w); } }
        const int pp = wid * 16 + fr; const size_t tok = (size_t)(row0 + pp);
        const float bias = p.in[10][(l * 4 + g) * 128 + pp];
#pragma unroll
        for (int ct = 0; ct < 8; ++ct) { f32x4 acc = {0.f, 0.f, 0.f, 0.f};
#pragma unroll
            for (int kk = 0; kk < 4; ++kk) { const bf16x8 X = *(const LAS bf16x8*)(VT + (ct * 16 + fr) * 136 + kk * 32 + 8 * fq);
                acc = __builtin_amdgcn_mfma_f32_16x16x32_bf16(X, Yf[kk], acc, 0, 0, 0); }
            const int c = ct * 16 + 4 * fq;
            const u32x2 uw = *(const u32x2*)(Z + tok * ZLD + ZU + g * 128 + c);
            const float u0 = bf2f(uw.x & 0xffffu), u1 = bf2f(uw.x >> 16), u2 = bf2f(uw.y & 0xffffu), u3 = bf2f(uw.y >> 16);
            u32x2 ow; ow.x = cvt_pk_bf16(u0 * (acc[0] + bias), u1 * (acc[1] + bias)); ow.y = cvt_pk_bf16(u2 * (acc[2] + bias), u3 * (acc[3] + bias));
            *(u32x2*)(AM + tok * 2048 + 512 + g * 128 + c) = ow; }
        __syncthreads();
    }
}

__device__ __forceinline__ void gla_item(int item, int l, const P& p, const bf16_t* Z, const float* LR, bf16_t* AM, bf16_t* OB, LAS unsigned char* lds) {
    const int tid = ltid(), wid = tid >> 6, lane = tid & 63, fr = lane & 15, fq = lane >> 4;
    LAS bf16_t* QG = (LAS bf16_t*)lds;
    LAS bf16_t* KG = (LAS bf16_t*)(lds + 17408);
    LAS bf16_t* KDT = (LAS bf16_t*)(lds + 34816);
    LAS bf16_t* VT = (LAS bf16_t*)(lds + 53248);
    LAS bf16_t* ST = (LAS bf16_t*)(lds + 71680);
    LAS bf16_t* AB = (LAS bf16_t*)(lds + 106496);
    LAS float* LRS = (LAS float*)(lds + 115712);
    LAS float* GT = (LAS float*)(lds + 119808);
    LAS float* GLAST = (LAS float*)(lds + 121856);
    int b, h, dir, vs, T, seq0; const bool lat = item < 128;
    { const int idx = lat ? item : item - 128; vs = idx & 1; dir = (idx >> 1) & 1; h = (idx >> 2) & 3; b = idx >> 4; }
    if (lat) { T = 2048; seq0 = NCTX + b * 2048; } else { T = 256; seq0 = b * 256; }
    const int kc = tid & 127, lg = tid >> 7;
    float w2r[16];
#pragma unroll
    for (int r = 0; r < 16; ++r) w2r[r] = p.in[12][((size_t)(l * 2 + dir) * 16 + r) * 512 + h * 128 + kc];
    const float gbias = p.in[13][(l * 2 + dir) * 512 + h * 128 + kc];
    f32x4 S[8];
    if (lat) { const float* sp = p.in[2] + ((size_t)((b * 4 + l) * 2 + dir) * 4 + h) * 128 * 256 + vs * 128;
#pragma unroll
        for (int jt = 0; jt < 8; ++jt)
#pragma unroll
            for (int r = 0; r < 4; ++r) S[jt][r] = sp[(size_t)(wid * 16 + 4 * fq + r) * 256 + jt * 16 + fr]; }
    else {
#pragma unroll
        for (int jt = 0; jt < 8; ++jt) S[jt] = (f32x4){0.f, 0.f, 0.f, 0.f}; }
    bf16_t* obuf = dir ? OB : AM + 1024; const int ldo = dir ? 1024 : 2048;
    const int nch = T / 64;
    u32x4 pv0, pv1; f32x4 plr = {0.f, 0.f, 0.f, 0.f}; bf16_t pq[16], pk[16];
#define GLA_TOK(pos) (seq0 + (dir ? T - 1 - (pos) : (pos)))
#define GLA_ISSUE(n_) do { const int pos0_ = (n_) * 64; \
        { const int li_ = tid >> 3, seg_ = tid & 7; const bf16_t* vp_ = Z + (size_t)GLA_TOK(pos0_ + li_) * ZLD + ZVV + h * 256 + vs * 128 + seg_ * 16; pv0 = *(const u32x4*)vp_; pv1 = *(const u32x4*)(vp_ + 8); } \
        if (tid < 256) { const int li_ = tid >> 2, part_ = tid & 3; plr = *(const f32x4*)(LR + (size_t)GLA_TOK(pos0_ + li_) * 32 + dir * 16 + part_ * 4); } \
        _Pragma("unroll") for (int i_ = 0; i_ < 16; ++i_) { const bf16_t* zr_ = Z + (size_t)GLA_TOK(pos0_ + lg * 16 + i_) * ZLD + h * 128 + kc; pq[i_] = zr_[ZQ]; pk[i_] = zr_[ZK]; } } while (0)
    GLA_ISSUE(0);
    for (int n = 0; n < nch; ++n) {
        const int pos0 = n * 64;
#pragma unroll
        for (int jt = 0; jt < 8; ++jt) { u32x2 w; w.x = cvt_pk_bf16(S[jt][0], S[jt][1]); w.y = cvt_pk_bf16(S[jt][2], S[jt][3]);
            *(LAS u32x2*)(ST + (jt * 16 + fr) * 136 + wid * 16 + 4 * fq) = w; }
        { const int li = tid >> 3, seg = tid & 7; LAS bf16_t* q = VT + (seg * 16) * 72 + li;
          q[0] = (bf16_t)(pv0.x & 0xffffu); q[72] = (bf16_t)(pv0.x >> 16); q[144] = (bf16_t)(pv0.y & 0xffffu); q[216] = (bf16_t)(pv0.y >> 16);
          q[288] = (bf16_t)(pv0.z & 0xffffu); q[360] = (bf16_t)(pv0.z >> 16); q[432] = (bf16_t)(pv0.w & 0xffffu); q[504] = (bf16_t)(pv0.w >> 16);
          q += 8 * 72;
          q[0] = (bf16_t)(pv1.x & 0xffffu); q[72] = (bf16_t)(pv1.x >> 16); q[144] = (bf16_t)(pv1.y & 0xffffu); q[216] = (bf16_t)(pv1.y >> 16);
          q[288] = (bf16_t)(pv1.z & 0xffffu); q[360] = (bf16_t)(pv1.z >> 16); q[432] = (bf16_t)(pv1.w & 0xffffu); q[504] = (bf16_t)(pv1.w >> 16); }
        if (tid < 256) *(LAS f32x4*)(LRS + (tid >> 2) * 16 + (tid & 3) * 4) = plr;
        float qv[16], kv[16];
#pragma unroll
        for (int i = 0; i < 16; ++i) { qv[i] = bf2f(pq[i]); kv[i] = bf2f(pk[i]); }
        __syncthreads();
        float Gl[16]; float run = 0.f;
#pragma unroll
        for (int i = 0; i < 16; ++i) { const LAS float* lr = LRS + (lg * 16 + i) * 16; float z = gbias;
            const f32x4 l0 = *(const LAS f32x4*)lr, l1 = *(const LAS f32x4*)(lr + 4), l2 = *(const LAS f32x4*)(lr + 8), l3 = *(const LAS f32x4*)(lr + 12);
#pragma unroll
            for (int r = 0; r < 4; ++r) { z += l0[r] * w2r[r]; z += l1[r] * w2r[4 + r]; z += l2[r] * w2r[8 + r]; z += l3[r] * w2r[12 + r]; }
            const float ls = fminf(z, 0.f) - __logf(1.0f + __expf(-fabsf(z)));
            run += ls * (1.0f / 16.0f); Gl[i] = run; }
        GT[lg * 128 + kc] = run;
        __syncthreads();
        float pre = 0.f, tot = 0.f;
#pragma unroll
        for (int g4 = 0; g4 < 4; ++g4) { const float t = GT[g4 * 128 + kc]; tot += t; if (g4 < lg) pre += t; }
        if (lg == 0) GLAST[kc] = tot;
        { float kd[16]; const float etot = __expf(tot);
#pragma unroll
          for (int i = 0; i < 16; ++i) { const float G = pre + Gl[i]; const int li = lg * 16 + i; const float eg = __expf(G), ieg = __expf(-G);
              QG[li * 136 + kc] = f2bf(qv[i] * eg); const float kgv = kv[i] * ieg; KG[li * 136 + kc] = f2bf(kgv); kd[i] = kgv * etot; }
          float k0[8], k1[8];
#pragma unroll
          for (int j = 0; j < 8; ++j) { k0[j] = kd[j]; k1[j] = kd[8 + j]; }
          *(LAS u32x4*)(KDT + kc * 72 + lg * 16) = pack8(k0); *(LAS u32x4*)(KDT + kc * 72 + lg * 16 + 8) = pack8(k1); }
        __syncthreads();
        if (n + 1 < nch) GLA_ISSUE(n + 1);
        { const int jt = wid >> 1, it0 = (wid & 1) * 2;
#pragma unroll
          for (int t = 0; t < 2; ++t) { const int it = it0 + t; f32x4 acc = {0.f, 0.f, 0.f, 0.f};
              if (it <= jt) {
#pragma unroll
                  for (int kk = 0; kk < 4; ++kk) { const bf16x8 X = *(const LAS bf16x8*)(KG + (it * 16 + fr) * 136 + kk * 32 + 8 * fq), Y = *(const LAS bf16x8*)(QG + (jt * 16 + fr) * 136 + kk * 32 + 8 * fq);
                      acc = __builtin_amdgcn_mfma_f32_16x16x32_bf16(X, Y, acc, 0, 0, 0); } }
              const int li = jt * 16 + fr, m0 = it * 16 + 4 * fq;
              u32x2 w; w.x = cvt_pk_bf16(m0 <= li ? acc[0] : 0.f, m0 + 1 <= li ? acc[1] : 0.f); w.y = cvt_pk_bf16(m0 + 2 <= li ? acc[2] : 0.f, m0 + 3 <= li ? acc[3] : 0.f);
              *(LAS u32x2*)(AB + li * 72 + m0) = w; } }
        __syncthreads();
        { const int jt = wid >> 1, it0 = (wid & 1) * 4; const int li = jt * 16 + fr; const int tok = GLA_TOK(pos0 + li);
          bf16x8 Ya[2], Yq[4];
#pragma unroll
          for (int kk = 0; kk < 2; ++kk) Ya[kk] = *(const LAS bf16x8*)(AB + (jt * 16 + fr) * 72 + kk * 32 + 8 * fq);
#pragma unroll
          for (int kk = 0; kk < 4; ++kk) Yq[kk] = *(const LAS bf16x8*)(QG + (jt * 16 + fr) * 136 + kk * 32 + 8 * fq);
#pragma unroll
          for (int t = 0; t < 4; ++t) { const int it = it0 + t; f32x4 acc = {0.f, 0.f, 0.f, 0.f};
#pragma unroll
              for (int kk = 0; kk < 2; ++kk) { const bf16x8 X = *(const LAS bf16x8*)(VT + (it * 16 + fr) * 72 + kk * 32 + 8 * fq);
                  acc = __builtin_amdgcn_mfma_f32_16x16x32_bf16(X, Ya[kk], acc, 0, 0, 0); }
#pragma unroll
              for (int kk = 0; kk < 4; ++kk) { const bf16x8 X = *(const LAS bf16x8*)(ST + (it * 16 + fr) * 136 + kk * 32 + 8 * fq);
                  acc = __builtin_amdgcn_mfma_f32_16x16x32_bf16(X, Yq[kk], acc, 0, 0, 0); }
              u32x2 w; w.x = cvt_pk_bf16(acc[0], acc[1]); w.y = cvt_pk_bf16(acc[2], acc[3]);
              *(u32x2*)(obuf + (size_t)tok * ldo + h * 256 + vs * 128 + it * 16 + 4 * fq) = w; } }
        { float dec[4];
#pragma unroll
          for (int r = 0; r < 4; ++r) dec[r] = __expf(GLAST[wid * 16 + 4 * fq + r]);
          bf16x8 Xk[2];
#pragma unroll
          for (int kk = 0; kk < 2; ++kk) Xk[kk] = *(const LAS bf16x8*)(KDT + (wid * 16 + fr) * 72 + kk * 32 + 8 * fq);
#pragma unroll
          for (int jt = 0; jt < 8; ++jt) { f32x4 acc;
#pragma unroll
              for (int r = 0; r < 4; ++r) acc[r] = S[jt][r] * dec[r];
#pragma unroll
              for (int kk = 0; kk < 2; ++kk) { const bf16x8 Y = *(const LAS bf16x8*)(VT + (jt * 16 + fr) * 72 + kk * 32 + 8 * fq);
                  acc = __builtin_amdgcn_mfma_f32_16x16x32_bf16(Xk[kk], Y, acc, 0, 0, 0); }
              S[jt] = acc; } }
        __syncthreads();
    }
#undef GLA_ISSUE
#undef GLA_TOK
    if (!lat) { float* sp = p.out + (size_t)NTOK * 1024 + ((size_t)((b * 4 + l) * 2 + dir) * 4 + h) * 128 * 256 + vs * 128;
#pragma unroll
        for (int jt = 0; jt < 8; ++jt)
#pragma unroll
            for (int r = 0; r < 4; ++r) sp[(size_t)(wid * 16 + 4 * fq + r) * 256 + jt * 16 + fr] = S[jt][r]; }
}


#define XB_TMO      128
#define XB_XCNT(j)  (256  + 64 * (j))
#define XB_XSUB(j)  (1280 + 64 * (j))
#define XB_XGEN(j)  (2304 + 64 * (j))
#define XB_TOP      3328
#define XB_TOPGEN   3392
#define XCD_BAR_WORDS 3456
#define XB_SPIN_CAP (1u << 18)
__device__ __forceinline__ unsigned xb_ld(unsigned* p)              { return __hip_atomic_load(p, __ATOMIC_RELAXED, __HIP_MEMORY_SCOPE_AGENT); }
__device__ __forceinline__ unsigned xb_add(unsigned* p, unsigned v) { return __hip_atomic_fetch_add(p, v, __ATOMIC_RELAXED, __HIP_MEMORY_SCOPE_AGENT); }
__device__ __forceinline__ unsigned xb_xcc_id() { return (unsigned)__builtin_amdgcn_s_getreg((3 << 11) | 20) & 0xFu; }
#define XB_SPIN(cond, bar) do { unsigned _sp = 0; while (cond) { __builtin_amdgcn_s_sleep(1); \
    if ((++_sp & 255u) == 0u) { if (xb_ld(&(bar)[XB_TMO])) break; if (_sp > XB_SPIN_CAP) { atomicAdd(&(bar)[XB_TMO], 1u); break; } } } } while (0)
struct XcdBarrier { unsigned* bar; unsigned x; volatile LAS unsigned* st; };
__device__ __forceinline__ XcdBarrier xcd_barrier_post(unsigned* bar, volatile LAS unsigned* st) {
    XcdBarrier b; b.bar = bar; b.x = xb_xcc_id(); b.st = st;
    if (threadIdx.x == 0) (void)xb_add(&bar[XB_XCNT(b.x)], 1u);
    return b;
}
__device__ __forceinline__ void xcd_barrier_complete(unsigned* bar, unsigned x, unsigned& nloc, unsigned& nx) {
    const unsigned G = gridDim.x * gridDim.y * gridDim.z;
    unsigned sum, cnt, mine, sp = 0u;
    for (;;) {
        sum = 0u; cnt = 0u; mine = 0u;
#pragma unroll
        for (unsigned j = 0; j < 16; ++j) { const unsigned c = xb_ld(&bar[XB_XCNT(j)]); sum += c; cnt += (c > 0u) ? 1u : 0u; mine = (j == x) ? c : mine; }
        if (sum == G) break;
        __builtin_amdgcn_s_sleep(1);
        if ((++sp & 255u) == 0u) { if (xb_ld(&bar[XB_TMO])) break; if (sp > XB_SPIN_CAP) { atomicAdd(&bar[XB_TMO], 1u); break; } }
    }
    nloc = mine > 0u ? mine : 1u; nx = cnt > 0u ? cnt : 1u;
}
__device__ __forceinline__ void xcd_barrier(const XcdBarrier& b) {
    asm volatile("s_waitcnt vmcnt(0)" ::: "memory");
    __syncthreads();
    if (threadIdx.x == 0) {
        unsigned* bar = b.bar;
        __builtin_amdgcn_s_waitcnt(0);
        unsigned nloc = b.st[0], nx = b.st[1];
        if (nloc == 0u) { xcd_barrier_complete(bar, b.x, nloc, nx); b.st[0] = nloc; b.st[1] = nx; }
        const unsigned old = xb_add(&bar[XB_XSUB(b.x)], 1u);
        const unsigned gen = old / nloc;
        if (old + 1u == (gen + 1u) * nloc) {
            __builtin_amdgcn_fence(__ATOMIC_RELEASE, "agent");
            asm volatile("s_waitcnt vmcnt(0)" ::: "memory");
            const unsigned og = xb_add(&bar[XB_TOP], 1u);
            const unsigned tg = og / nx;
            if (og + 1u == (tg + 1u) * nx) xb_add(&bar[XB_TOPGEN], 1u);
            else XB_SPIN(xb_ld(&bar[XB_TOPGEN]) == tg, bar);
            __builtin_amdgcn_fence(__ATOMIC_ACQUIRE, "agent");
            xb_add(&bar[XB_XGEN(b.x)], 1u);
            asm volatile("s_waitcnt vmcnt(0)" ::: "memory");
        } else {
            XB_SPIN(xb_ld(&bar[XB_XGEN(b.x)]) == gen, bar);
            __builtin_amdgcn_fence(__ATOMIC_ACQUIRE, "agent");
            asm volatile("s_waitcnt vmcnt(0)" ::: "memory");
        }
    }
    __syncthreads();
}

template <int PH>
__device__ __forceinline__ void run_phase(const P& p, int l, unsigned char* shm) {
    LAS unsigned char* lds = (LAS unsigned char*)shm;
    const int wg = lwg(), nwg = lnwg();
    size_t wso = 0; asm volatile("" : "+s"(wso)); unsigned char* wsb = p.ws + wso;
    float* MOD = (float*)(wsb + WS_MOD);
    bf16_t* DLAT = (bf16_t*)(wsb + WS_DLAT); bf16_t* DCTX = (bf16_t*)(wsb + WS_DCTX);
    bf16_t* W1T = (bf16_t*)(wsb + WS_W1T); bf16_t* WMT = (bf16_t*)(wsb + WS_WMT); bf16_t* WOT = (bf16_t*)(wsb + WS_WOT);
    bf16_t* WUPT = (bf16_t*)(wsb + WS_WUPT); bf16_t* WDNT = (bf16_t*)(wsb + WS_WDNT);
    bf16_t* H = (bf16_t*)(wsb + WS_H); bf16_t* XTc = (bf16_t*)(wsb + WS_XT); bf16_t* XTl = (bf16_t*)(wsb + WS_XTL); bf16_t* Mb = (bf16_t*)(wsb + WS_XT);
    bf16_t* Z = (bf16_t*)(wsb + WS_Z); float* LR = (float*)(wsb + WS_LR); bf16_t* AM = (bf16_t*)(wsb + WS_AM);
    bf16_t* AG = (bf16_t*)(wsb + WS_AG); bf16_t* FF = (bf16_t*)(wsb + WS_FF);
    float* X = p.out;
    const float* modl = MOD + (size_t)l * 9 * 6144;
    if constexpr (PH == 0) {
        mods_phase(p, MOD, (float*)shm);
        dft_phase(DLAT, DCTX);
        wconv_phase(p, 0, 0, (float*)shm);
        wconv_phase(p, 1, 0, (float*)shm);
    } else if constexpr (PH == 1) {
        ln_phase(p.in[0], p.in[1], nullptr, nullptr, nullptr, false, true, MOD, 1, 0, H);
    } else if constexpr (PH == 2) {
        SchedStd S{H, W1T, 1024, 1024, 1024, 80, 33, nwg, wg}; EpiIn E{Z, XTc, XTl, LR, p.in[6] + l * 3072}; gemm_phase(lds, S, E);
    } else if constexpr (PH == 3) {
        if (wg < NFFT_WG) {
            { SchedFftL S{DLAT, XTl, 4096, 4096, 4096, NFFT_WG, wg}; EpiBf16 E{AM, 2048}; gemm_phase(lds, S, E); }
            { SchedFftC S{DCTX, XTc, 512, 512, 512, NFFT_WG, wg}; EpiBf16 E{AM, 2048}; gemm_phase(lds, S, E); }
            if (wg >= 32) for (int it = wg - 32; it < 160; it += NFFT_WG - 32) sgu_item(it, l, p, Z, AM, lds);
        }
    } else if constexpr (PH == 4) {
        if (wg >= NFFT_WG) {
            const int gi = wg - NFFT_WG, gn = nwg - NFFT_WG;
            for (int it = gi; it < 384; it += gn) gla_item(it, l, p, Z, LR, AM, H, lds);
        }
    } else if constexpr (PH == 5) {
        glapost_phase(AM, H, Z, p.in[14] + l * 256);
        wconv_phase(p, 2, l, (float*)shm);
    } else if constexpr (PH == 6) {
        SchedMerge S{AM, WMT, 2048, 2048, 512, nwg, wg}; EpiMerge E{Mb, Z}; gemm_phase(lds, S, E);
    } else if constexpr (PH == 7) {
        const float* xc = l == 0 ? p.in[0] : X; const float* xl = l == 0 ? p.in[1] : X + (size_t)NCTX * 1024;
        SchedStd S{Mb, WOT, 1024, 1024, 1024, 80, 4, nwg, wg}; EpiResid E{xc, xl, X, modl + 2 * 1024}; gemm_phase(lds, S, E);
    } else if constexpr (PH == 8) {
        ln_phase(X, X + (size_t)NCTX * 1024, X, p.in[17] + l * 1024, p.in[18] + l * 1024, true, true, modl, 4, 3, H);
    } else if constexpr (PH == 9) {
        SchedStd S{H, WUPT, 1024, 1024, 1024, 80, 22, nwg, wg}; EpiBf16 E{AG, 5632}; gemm_phase(lds, S, E);
    } else if constexpr (PH == 10) {
        conv_phase(AG, FF, p.in[22] + (size_t)l * 9 * DFF, p.in[23] + l * DFF);
        if (l + 1 < DEPTH) wconv_phase(p, 1, l + 1, (float*)shm);
    } else if constexpr (PH == 11) {
        SchedStd S{FF, WDNT, DFF, DFF, DFF, 80, 4, nwg, wg}; EpiResid E{X, X + (size_t)NCTX * 1024, X, modl + 5 * 1024}; gemm_phase(lds, S, E);
    } else if constexpr (PH == 12) {
        ln_phase(X, X + (size_t)NCTX * 1024, X, p.in[25] + l * 1024, p.in[26] + l * 1024, true, l + 1 < DEPTH, modl + 9 * 6144, 1, 0, H);
        if (l + 1 < DEPTH) wconv_phase(p, 0, l + 1, (float*)shm);
    }
}

#ifndef MULTI
#define MULTI 0
#endif

#if MULTI
template <int PH> __global__ void __launch_bounds__(512) k_phase(P p, int l) {
    extern __shared__ __attribute__((aligned(16))) unsigned char shm[];
    run_phase<PH>(p, l, shm);
}
template <int PH> static void launch_phase(const P& p, int l, int grid, hipStream_t stream) {
    static bool attr = false;
    if (!attr) { (void)hipFuncSetAttribute((const void*)k_phase<PH>, hipFuncAttributeMaxDynamicSharedMemorySize, LDS_BYTES); attr = true; }
    hipLaunchKernelGGL((k_phase<PH>), dim3(grid), dim3(512), LDS_BYTES, stream, p, l);
}
#else
#ifndef REPEAT_PH
#define REPEAT_PH 0
#endif
#ifndef STOP_PH
#define STOP_PH 99
#endif
__device__ __forceinline__ void dump_phase(const P& p, int which) {
    size_t wso = 0; asm volatile("" : "+s"(wso)); unsigned char* wsb = p.ws + wso;
    const size_t gt = (size_t)lwg() * 512 + ltid(), gn = (size_t)lnwg() * 512;
    const bf16_t* AM = (const bf16_t*)(wsb + WS_AM); const bf16_t* Z = (const bf16_t*)(wsb + WS_Z); const bf16_t* Mb = (const bf16_t*)(wsb + WS_XT);
    const bf16_t* H = (const bf16_t*)(wsb + WS_H); const float* LR = (const float*)(wsb + WS_LR);
    for (size_t i = gt; i < (size_t)NTOK * 1024; i += gn) { const size_t row = i >> 10, c = i & 1023; float v = 0.f;
        if (which == 0) v = bf2f(AM[row * 2048 + c]) + bf2f(AM[row * 2048 + 1024 + c]);
        else if (which == 1) { for (int j = 0; j < 7; ++j) v += bf2f(Z[row * ZLD + j * 1024 + c]); v += LR[row * 32 + (c & 31)] + bf2f(Mb[i]); }
        else if (which == 2) v = bf2f(Mb[i]);
        else if (which == 3) v = bf2f(H[i]);
        else if (which == 4) { const bf16_t* AG = (const bf16_t*)(wsb + WS_AG); for (int j = 0; j < 5; ++j) v += bf2f(AG[row * 5632 + j * 1024 + c]); }
        else if (which == 5) { const bf16_t* FF = (const bf16_t*)(wsb + WS_FF); v = bf2f(FF[row * DFF + c]) + bf2f(FF[row * DFF + 1024 + c]); }
        p.out[i] = v; }
}
__global__ void __launch_bounds__(512) fwd_megakernel(P p) {
    extern __shared__ __attribute__((aligned(16))) unsigned char shm[];
    cg::grid_group grid = cg::this_grid();
    volatile LAS unsigned* stw = (volatile LAS unsigned*)((LAS unsigned char*)shm + 131072 + 1024);
    if (threadIdx.x == 0) { stw[0] = 0u; stw[1] = 0u; }
    __syncthreads();
    const XcdBarrier xb = xcd_barrier_post((unsigned*)(p.ws + WS_BAR), stw);
    run_phase<0>(p, 0, shm); grid.sync();
    run_phase<1>(p, 0, shm); xcd_barrier(xb);
#pragma unroll 1
    for (int l = 0; l < DEPTH; ++l) {
        run_phase<2>(p, l, shm); xcd_barrier(xb);
        if (STOP_PH == 2) { dump_phase(p, 1); return; }
#if REPEAT_PH == 2
        run_phase<2>(p, l, shm); xcd_barrier(xb);
#endif
        run_phase<3>(p, l, shm);
        run_phase<4>(p, l, shm); xcd_barrier(xb);
#if REPEAT_PH == 34
        run_phase<3>(p, l, shm);
        run_phase<4>(p, l, shm); xcd_barrier(xb);
#endif
        run_phase<5>(p, l, shm); xcd_barrier(xb);
        if (STOP_PH == 5) { dump_phase(p, 0); return; }
        run_phase<6>(p, l, shm); xcd_barrier(xb);
        if (STOP_PH == 6) { dump_phase(p, 2); return; }
        run_phase<7>(p, l, shm); xcd_barrier(xb);
        if (STOP_PH == 7) return;
        run_phase<8>(p, l, shm); xcd_barrier(xb);
        if (STOP_PH == 8) { xcd_barrier(xb); dump_phase(p, 3); return; }
        run_phase<9>(p, l, shm); xcd_barrier(xb);
        if (STOP_PH == 9) { dump_phase(p, 4); return; }
        run_phase<10>(p, l, shm); xcd_barrier(xb);
        if (STOP_PH == 10) { dump_phase(p, 5); return; }
        run_phase<11>(p, l, shm); xcd_barrier(xb);
        if (STOP_PH == 11) return;
        run_phase<12>(p, l, shm); xcd_barrier(xb);
        if (STOP_PH == 12) return;
    }
}
#endif

extern "C" void kernel_launch(void* const* d_in, const int* in_sizes, int n_in, void* d_out, int out_size, void* d_ws, size_t ws_size, hipStream_t stream) {
    P p{};
    for (int i = 0; i < 27; ++i) p.in[i] = (const float*)d_in[i];
    p.out = (float*)d_out; p.ws = (unsigned char*)d_ws;
    if (ws_size < WS_END) { fprintf(stderr, "kernel_launch: workspace too small: %zu < %zu\n", ws_size, (size_t)WS_END); }
#if MULTI
    const int grid = 256;
    launch_phase<0>(p, 0, grid, stream);
    launch_phase<1>(p, 0, grid, stream);
    for (int l = 0; l < DEPTH; ++l) {
        launch_phase<2>(p, l, grid, stream);
        launch_phase<3>(p, l, grid, stream);
        launch_phase<4>(p, l, grid, stream);
        launch_phase<5>(p, l, grid, stream);
        launch_phase<6>(p, l, grid, stream);
        launch_phase<7>(p, l, grid, stream);
        launch_phase<8>(p, l, grid, stream);
        launch_phase<9>(p, l, grid, stream);
        launch_phase<10>(p, l, grid, stream);
        launch_phase<11>(p, l, grid, stream);
        launch_phase<12>(p, l, grid, stream);
    }
#else
    static int grid_blocks = 0;
    if (!grid_blocks) {
        int dev = 0, cus = 0, per_cu = 0;
        (void)hipGetDevice(&dev);
        (void)hipDeviceGetAttribute(&cus, hipDeviceAttributeMultiprocessorCount, dev);
        (void)hipFuncSetAttribute((const void*)fwd_megakernel, hipFuncAttributeMaxDynamicSharedMemorySize, LDS_BYTES);
        (void)hipOccupancyMaxActiveBlocksPerMultiprocessor(&per_cu, (const void*)fwd_megakernel, 512, LDS_BYTES);
        if (per_cu < 1) per_cu = 1;
        grid_blocks = cus * per_cu;
    }
    (void)hipMemsetAsync((char*)d_ws + WS_BAR, 0, XCD_BAR_WORDS * 4, stream);
    void* args[] = {&p};
    hipError_t e = hipLaunchCooperativeKernel((const void*)fwd_megakernel, dim3(grid_blocks), dim3(512), args, LDS_BYTES, stream);
    if (e != hipSuccess) fprintf(stderr, "cooperative launch failed: %s (grid %d)\n", hipGetErrorString(e), grid_blocks);
#endif
}
```

```cpp
#include <hip/hip_runtime.h>
#include <hip/hip_cooperative_groups.h>
#include <cstdio>
namespace cg = cooperative_groups;

#define LAS __attribute__((address_space(3)))
typedef unsigned short bf16_t;
typedef short bf16x8 __attribute__((ext_vector_type(8)));
typedef float f32x4 __attribute__((ext_vector_type(4)));
typedef float f32x2 __attribute__((ext_vector_type(2)));
typedef unsigned u32x4 __attribute__((ext_vector_type(4)));
typedef unsigned u32x2 __attribute__((ext_vector_type(2)));

constexpr int D = 1024, NTOK = 20480, NCTX = 4096, DEPTH = 4;
constexpr int ZLD = 7168;
constexpr int ZU = 0, ZV = 512, ZQ = 1024, ZK = 1536, ZVV = 2048, ZR = 3072, ZG = 4096;
constexpr int N1 = 8448;
constexpr int DFF = 2816;
constexpr int NFFT_WG = 128;

constexpr size_t WS_MOD  = 0;
constexpr size_t WS_DLAT = WS_MOD + 4ull * 9 * 6144 * 4;
constexpr size_t WS_DCTX = WS_DLAT + 2048ull * 2048 * 2;
constexpr size_t WS_W1T  = WS_DCTX + 256ull * 512 * 2;
constexpr size_t WS_WMT  = WS_W1T + (size_t)N1 * 1024 * 2;
constexpr size_t WS_WOT  = WS_WMT + 1024ull * 2048 * 2;
constexpr size_t WS_H    = WS_WOT + 1024ull * 1024 * 2;
constexpr size_t WS_XT   = WS_H + (size_t)NTOK * 1024 * 2;
constexpr size_t WS_XTL  = WS_XT + 16ull * 512 * 512 * 2;
constexpr size_t WS_Z    = WS_XT + (size_t)NTOK * 1024 * 2;
constexpr size_t WS_LR   = WS_Z + (size_t)NTOK * ZLD * 2;
constexpr size_t WS_AM   = WS_LR + (size_t)NTOK * 32 * 4;
constexpr size_t WS_BAR  = WS_AM + (size_t)NTOK * 2048 * 2;
constexpr size_t WS_ETOT = WS_BAR + 16384;
constexpr size_t WS_WUPT = WS_ETOT + 1280ull * 2 * 128 * 4;
constexpr size_t WS_WDNT = WS_WUPT + 5632ull * 1024 * 2;
constexpr size_t WS_XF   = WS_WDNT + 1024ull * 2816 * 2;
constexpr size_t WS_END  = WS_XF + 8ull * 512 * 2048 * 2;
constexpr size_t WS_AG   = WS_Z;
constexpr size_t WS_FF   = WS_Z + (size_t)NTOK * 5632 * 2;
static_assert(WS_FF + (size_t)NTOK * DFF * 2 <= WS_END, "ffn alias");

constexpr int LDS_BYTES = 151552;
#ifndef STAGGER_US
#define STAGGER_US 0
#endif

struct P {
    const float* in[27];
    float* out;
    unsigned char* ws;
};

#define LDS_BARRIER() do { asm volatile("s_waitcnt lgkmcnt(0)" ::: "memory"); __builtin_amdgcn_s_barrier(); asm volatile("" ::: "memory"); } while (0)
__device__ __forceinline__ int ltid() { int t = threadIdx.x; asm volatile("" : "+v"(t)); return t; }
__device__ __forceinline__ int lwg() { int b = blockIdx.x; asm volatile("" : "+s"(b)); return b; }
__device__ __forceinline__ int lnwg() { int b = gridDim.x; asm volatile("" : "+s"(b)); return b; }

__device__ __forceinline__ float bf2f(unsigned v) { return __uint_as_float(v << 16); }
typedef __bf16 bf2_t __attribute__((ext_vector_type(2)));
__device__ __forceinline__ unsigned cvt_pk_bf16(float lo, float hi) { const f32x2 v = {lo, hi}; const bf2_t b = __builtin_convertvector(v, bf2_t); return __builtin_bit_cast(unsigned, b); }
__device__ __forceinline__ bf16_t f2bf(float f) { return (bf16_t)(cvt_pk_bf16(f, 0.f) & 0xffffu); }
__device__ __forceinline__ float sigmoidf_(float x) { return __builtin_amdgcn_rcpf(1.0f + __expf(-x)); }
__device__ __forceinline__ float siluf_(float x) { return x * __builtin_amdgcn_rcpf(1.0f + __expf(-x)); }
__device__ __forceinline__ float geluf_(float x) { const float y = 1.5957691216057308f * (x + 0.044715f * x * x * x); return x * __builtin_amdgcn_rcpf(1.0f + __expf(-y)); }
__device__ __forceinline__ float wave_sum(float v) {
#pragma unroll
    for (int o = 32; o >= 1; o >>= 1) v += __shfl_xor(v, o);
    return v;
}
__device__ __forceinline__ void unpack8(const u32x4 w, float (&f)[8]) {
    f[0] = bf2f(w.x & 0xffffu); f[1] = bf2f(w.x >> 16); f[2] = bf2f(w.y & 0xffffu); f[3] = bf2f(w.y >> 16);
    f[4] = bf2f(w.z & 0xffffu); f[5] = bf2f(w.z >> 16); f[6] = bf2f(w.w & 0xffffu); f[7] = bf2f(w.w >> 16);
}
__device__ __forceinline__ void unpack8u(const u32x2 w, float (&f)[8]) {
    f[0] = (float)(w.x & 0xffu); f[1] = (float)((w.x >> 8) & 0xffu); f[2] = (float)((w.x >> 16) & 0xffu); f[3] = (float)(w.x >> 24);
    f[4] = (float)(w.y & 0xffu); f[5] = (float)((w.y >> 8) & 0xffu); f[6] = (float)((w.y >> 16) & 0xffu); f[7] = (float)(w.y >> 24);
}
__device__ __forceinline__ u32x4 pack8(const float (&f)[8]) {
    u32x4 w; w.x = cvt_pk_bf16(f[0], f[1]); w.y = cvt_pk_bf16(f[2], f[3]); w.z = cvt_pk_bf16(f[4], f[5]); w.w = cvt_pk_bf16(f[6], f[7]); return w;
}

constexpr int BM = 256, BK = 64, HALF = 128, HTB = HALF * BK * 2;
__device__ __forceinline__ int lds_byte(int r, int c) { const int st = (r >> 4) * 2 + (c >> 5), rr = r & 15, cc = c & 31, ob = rr * 64 + cc * 2; return st * 1024 + (ob ^ (((ob >> 9) & 1) << 5)); }
__device__ __forceinline__ void stage_rc(int b, int& R, int& C) { const int st = b / 1024, sb = b % 1024, swz = sb ^ (((sb >> 9) & 1) << 5); R = (st >> 1) * 16 + swz / 64; C = (st & 1) * 32 + (swz % 64) / 2; }
__device__ __forceinline__ int perm32(int rho) { const int n = rho >> 4, i = rho & 15; return 8 * (i >> 2) + 4 * n + (i & 3); }

struct Unit { int pm, pn, aux; };

__device__ __forceinline__ void tile_map(int L, int nM, int nN, int& pm, int& pn) {
    const int nwg = nM * nN; int wgid = L;
    { const int q = nwg / 8, r = nwg % 8, xcd = wgid % 8, off = wgid / 8; wgid = (xcd < r ? xcd * (q + 1) : r * (q + 1) + (xcd - r) * q) + off; }
    const int nig = 8 * nN, gid = wgid / nig, fm = gid * 8, gsz = (nM - fm) < 8 ? (nM - fm) : 8;
    pm = fm + ((wgid % nig) % gsz); pn = (wgid % nig) / gsz;
}

struct SchedStd {
    const bf16_t* A; const bf16_t* Bt; int lda, ldb, K, nM, nN, G, c;
    __device__ __forceinline__ bool next(int i, Unit& u) const { const int L = i * G + c; if (L >= nM * nN) return false; tile_map(L, nM, nN, u.pm, u.pn); u.aux = 0; return true; }
    __device__ __forceinline__ const char* a_ptr(const Unit& u) const { return (const char*)A + (size_t)u.pm * 256 * lda * 2; }
    __device__ __forceinline__ const char* b_ptr(const Unit& u) const { return (const char*)Bt + (size_t)u.pn * 256 * ldb * 2; }
};
struct SchedMerge {
    const bf16_t* A; const bf16_t* Bt; int lda, ldb, K, G, c;
    __device__ __forceinline__ bool next(int i, Unit& u) const { const int L = (i >> 2) * G + c; if (L >= 320) return false; tile_map(L, 80, 4, u.pm, u.pn); u.aux = i & 3; return true; }
    __device__ __forceinline__ const char* a_ptr(const Unit& u) const { return (const char*)A + ((size_t)u.pm * 256 * lda + u.aux * 512) * 2; }
    __device__ __forceinline__ const char* b_ptr(const Unit& u) const { return (const char*)Bt + ((size_t)u.pn * 256 * ldb + u.aux * 512) * 2; }
};
struct SchedLim {
    const bf16_t* A; const bf16_t* Bt; int lda, ldb, K, nM, nN, G, c, limit;
    __device__ __forceinline__ bool next(int i, Unit& u) const { const int L = i * G + c; if (L >= limit) return false; tile_map(L, nM, nN, u.pm, u.pn); u.aux = 0; return true; }
    __device__ __forceinline__ const char* a_ptr(const Unit& u) const { return (const char*)A + (size_t)u.pm * 256 * lda * 2; }
    __device__ __forceinline__ const char* b_ptr(const Unit& u) const { return (const char*)Bt + (size_t)u.pn * 256 * ldb * 2; }
};
struct SchedRestM {
    const bf16_t* A; const bf16_t* Bt; int lda, ldb, K, nM, nN, G, c, first;
    __device__ __forceinline__ bool next(int i, Unit& u) const { const int q = i * G + c; const int L = first + (q >> 1); if (L >= nM * nN) return false; tile_map(L, nM, nN, u.pm, u.pn); u.aux = q & 1; return true; }
    __device__ __forceinline__ const char* a_ptr(const Unit& u) const { return (const char*)A + ((size_t)u.pm * 256 + (size_t)u.aux * 128) * lda * 2; }
    __device__ __forceinline__ const char* b_ptr(const Unit& u) const { return (const char*)Bt + (size_t)u.pn * 256 * ldb * 2; }
};
struct SchedTailM {
    const bf16_t* A; const bf16_t* Bt; int lda, ldb, K, G, c;
    __device__ __forceinline__ bool next(int i, Unit& u) const { const int L = i * G + c; if (L >= 128) return false; const int tt = L >> 1; u.pm = 64 + (tt >> 2); u.pn = tt & 3; u.aux = L & 1; return true; }
    __device__ __forceinline__ const char* a_ptr(const Unit& u) const { return (const char*)A + ((size_t)u.pm * 256 + (size_t)u.aux * 128) * lda * 2; }
    __device__ __forceinline__ const char* b_ptr(const Unit& u) const { return (const char*)Bt + (size_t)u.pn * 256 * ldb * 2; }
};
struct SchedFftL {
    const bf16_t* A; const bf16_t* Bt; int lda, ldb, K, G, c;
    __device__ __forceinline__ bool next(int i, Unit& u) const { const int L = i * G + c; if (L >= 128) return false; const int b = L >> 4, rem = L & 15; u.pm = 16 + b * 8 + (rem >> 1); u.pn = rem & 1; u.aux = b; return true; }
    __device__ __forceinline__ const char* a_ptr(const Unit& u) const { return (const char*)A + (size_t)((u.pm - 16) & 7) * 256 * 2048 * 2; }
    __device__ __forceinline__ const char* b_ptr(const Unit& u) const { return (const char*)Bt + ((size_t)u.aux * 512 + u.pn * 256) * 2048 * 2; }
};
struct SchedFftC {
    const bf16_t* A; const bf16_t* Bt; int lda, ldb, K, G, c;
    __device__ __forceinline__ bool next(int i, Unit& u) const { const int L = i * G + c; if (L >= 32) return false; u.pm = L >> 1; u.pn = L & 1; u.aux = 0; return true; }
    __device__ __forceinline__ const char* a_ptr(const Unit&) const { return (const char*)A; }
    __device__ __forceinline__ const char* b_ptr(const Unit& u) const { return (const char*)Bt + ((size_t)u.pm * 512 + u.pn * 256) * 512 * 2; }
};

template <bool HM> struct EpiInT {
    static constexpr bool PERM = true, HAS_MID = false, HALFM = HM;
    bf16_t* Z; bf16_t* XTc; bf16_t* XTl; float* LR; const float* bmerge;
    __device__ __forceinline__ void operator()(const f32x4 (&acc)[2][2][4][2], const Unit& u, int wr, int wc, int fr, int fq) const {
        const int pn = u.pn, cl = wc * 64 + 8 * fq;
        if (pn < 4) {
            bf16_t* base; int ldk, t0; const int cs = pn >> 1;
            if (u.pm < 16) { base = XTc + (size_t)u.pm * 512 * 512; ldk = 512; t0 = cs * 256; }
            else { const int b = (u.pm - 16) >> 3; base = XTl + (size_t)b * 512 * 4096; ldk = 4096; t0 = cs * 2048 + ((u.pm - 16) & 7) * 256; }
            t0 += (HM ? u.aux * 128 : 0) + wr * 64 + fr;
#pragma unroll
            for (int ai = 0; ai < (HM ? 1 : 2); ++ai)
#pragma unroll
                for (int m = 0; m < 4; ++m) { const int t = t0 + ai * 128 + m * 16;
#pragma unroll
                    for (int bj = 0; bj < 2; ++bj)
#pragma unroll
                        for (int n = 0; n < 2; ++n) { const int c = (pn & 1) * 256 + bj * 32 + cl + n * 4; const f32x4 v = acc[ai][bj][m][n];
                            const unsigned p0 = cvt_pk_bf16(v[0], v[1]), p1 = cvt_pk_bf16(v[2], v[3]);
                            bf16_t* q = base + (size_t)c * ldk + t;
                            q[0] = (bf16_t)(p0 & 0xffffu); q[ldk] = (bf16_t)(p0 >> 16); q[2 * ldk] = (bf16_t)(p1 & 0xffffu); q[3 * ldk] = (bf16_t)(p1 >> 16); } }
        } else if (pn < 32) {
            const int zc0 = (pn - 4) * 256 + cl;
            const int mode = pn < 8 ? 1 : (pn < 16 ? 0 : (pn < 20 ? 2 : 3));
            f32x4 bv[2][2];
#pragma unroll
            for (int bj = 0; bj < 2; ++bj)
#pragma unroll
                for (int n = 0; n < 2; ++n) bv[bj][n] = (mode == 3) ? *(const f32x4*)(bmerge + (zc0 - ZG) + bj * 32 + n * 4) : (f32x4){0.f, 0.f, 0.f, 0.f};
            const int row0 = u.pm * 256 + (HM ? u.aux * 128 : 0) + wr * 64 + fr;
#pragma unroll
            for (int ai = 0; ai < (HM ? 1 : 2); ++ai)
#pragma unroll
                for (int m = 0; m < 4; ++m) { bf16_t* rowp = Z + (size_t)(row0 + ai * 128 + m * 16) * ZLD + zc0;
#pragma unroll
                    for (int bj = 0; bj < 2; ++bj) { float f[8];
#pragma unroll
                        for (int j = 0; j < 4; ++j) { f[j] = acc[ai][bj][m][0][j] + bv[bj][0][j]; f[4 + j] = acc[ai][bj][m][1][j] + bv[bj][1][j]; }
                        if (mode == 1) {
#pragma unroll
                            for (int j = 0; j < 8; ++j) f[j] = geluf_(f[j]); }
                        else if (mode == 2) {
#pragma unroll
                            for (int j = 0; j < 8; ++j) f[j] = siluf_(f[j]); }
                        if (mode == 3) {
                            unsigned w0 = 0u, w1 = 0u;
#pragma unroll
                            for (int j = 0; j < 4; ++j) { w0 = __builtin_amdgcn_cvt_pk_u8_f32(fminf(fmaxf(256.0f * sigmoidf_(f[j]), 1.0f), 255.0f), j, w0);
                                w1 = __builtin_amdgcn_cvt_pk_u8_f32(fminf(fmaxf(256.0f * sigmoidf_(f[4 + j]), 1.0f), 255.0f), j, w1); }
                            u32x2 w; w.x = w0; w.y = w1;
                            *(u32x2*)((unsigned char*)(rowp - zc0 + ZG) + (zc0 - ZG) + bj * 32) = w; }
                        else *(u32x4*)(rowp + bj * 32) = pack8(f); } }
        } else {
            if (wc == 0) { const int row0 = u.pm * 256 + (HM ? u.aux * 128 : 0) + wr * 64 + fr;
#pragma unroll
                for (int ai = 0; ai < (HM ? 1 : 2); ++ai)
#pragma unroll
                    for (int m = 0; m < 4; ++m) { float* q = LR + (size_t)(row0 + ai * 128 + m * 16) * 32 + 8 * fq;
                        *(f32x4*)q = acc[ai][0][m][0]; *(f32x4*)(q + 4) = acc[ai][0][m][1]; } }
        }
    }
};
typedef EpiInT<false> EpiIn;
struct EpiBf16 {
    static constexpr bool PERM = true, HAS_MID = false, HALFM = false;
    bf16_t* O; int ldc;
    __device__ __forceinline__ void operator()(const f32x4 (&acc)[2][2][4][2], const Unit& u, int wr, int wc, int fr, int fq) const {
        const int row0 = u.pm * 256 + wr * 64 + fr, col0 = u.pn * 256 + wc * 64 + 8 * fq;
#pragma unroll
        for (int ai = 0; ai < 2; ++ai)
#pragma unroll
            for (int m = 0; m < 4; ++m) { bf16_t* rowp = O + (size_t)(row0 + ai * 128 + m * 16) * ldc + col0;
#pragma unroll
                for (int bj = 0; bj < 2; ++bj) { const f32x4 v0 = acc[ai][bj][m][0], v1 = acc[ai][bj][m][1];
                    u32x4 w; w.x = cvt_pk_bf16(v0[0], v0[1]); w.y = cvt_pk_bf16(v0[2], v0[3]); w.z = cvt_pk_bf16(v1[0], v1[1]); w.w = cvt_pk_bf16(v1[2], v1[3]);
                    *(u32x4*)(rowp + bj * 32) = w; } }
    }
};
template <bool HM> struct EpiMergeT {
    static constexpr bool PERM = true, HAS_MID = true, HALFM = HM;
    bf16_t* Mo; const bf16_t* Z;
    __device__ __forceinline__ void mid(f32x4 (&acc)[2][2][4][2], const Unit& u, int seg, int wr, int wc, int fr, int fq) const {
        asm volatile("" : "+v"(fr), "+v"(fq));
        const int row0 = u.pm * 256 + (HM ? u.aux * 128 : 0) + wr * 64 + fr, col0 = u.pn * 256 + wc * 64 + 8 * fq;
#pragma unroll
        for (int ai = 0; ai < (HM ? 1 : 2); ++ai)
#pragma unroll
            for (int m = 0; m < 4; ++m) { const unsigned char* rp = (const unsigned char*)(Z + (size_t)(row0 + ai * 128 + m * 16) * ZLD + ZG) + (seg - 1) * 1024 + col0;
#pragma unroll
                for (int bj = 0; bj < 2; ++bj) { float gp[8], gn[8]; unpack8u(*(const u32x2*)(rp + bj * 32), gp); unpack8u(*(const u32x2*)(rp + 1024 + bj * 32), gn);
#pragma unroll
                    for (int j = 0; j < 4; ++j) { acc[ai][bj][m][0][j] *= gp[j] * __builtin_amdgcn_rcpf(gn[j]);
                        acc[ai][bj][m][1][j] *= gp[4 + j] * __builtin_amdgcn_rcpf(gn[4 + j]); } }
                if (m & 1) asm volatile("" ::: "memory"); }
    }
    __device__ __forceinline__ void operator()(const f32x4 (&acc)[2][2][4][2], const Unit& u, int wr, int wc, int fr, int fq) const {
        const int row0 = u.pm * 256 + (HM ? u.aux * 128 : 0) + wr * 64 + fr, col0 = u.pn * 256 + wc * 64 + 8 * fq;
#pragma unroll
        for (int ai = 0; ai < (HM ? 1 : 2); ++ai)
#pragma unroll
            for (int m = 0; m < 4; ++m) { const size_t row = (size_t)(row0 + ai * 128 + m * 16);
#pragma unroll
                for (int bj = 0; bj < 2; ++bj) {
                    float g[8], f[8]; unpack8u(*(const u32x2*)((const unsigned char*)(Z + row * ZLD + ZG) + 2048 + col0 + bj * 32), g);
#pragma unroll
                    for (int j = 0; j < 4; ++j) { f[j] = acc[ai][bj][m][0][j] * (g[j] * (1.0f / 256.0f)); f[4 + j] = acc[ai][bj][m][1][j] * (g[4 + j] * (1.0f / 256.0f)); }
                    *(u32x4*)(Mo + row * 1024 + col0 + bj * 32) = pack8(f); } }
    }
};
typedef EpiMergeT<false> EpiMerge;
template <bool HM> struct EpiResidT {
    static constexpr bool PERM = true, HAS_MID = false, HALFM = HM;
    const float* xin_ctx; const float* xin_lat; bf16_t* tout; const float* gate;
    __device__ __forceinline__ void operator()(const f32x4 (&acc)[2][2][4][2], const Unit& u, int wr, int wc, int fr, int fq) const {
        const float alpha = 1.681792830507429f;
        const int cond = u.pm < 16 ? 0 : 1 + ((u.pm - 16) >> 3);
        const int col0 = u.pn * 256 + wc * 64 + 8 * fq, row0 = u.pm * 256 + (HM ? u.aux * 128 : 0) + wr * 64 + fr;
        const float* gp = gate + (size_t)cond * 6144 + col0;
        f32x4 gv[2][2];
#pragma unroll
        for (int bj = 0; bj < 2; ++bj)
#pragma unroll
            for (int n = 0; n < 2; ++n) gv[bj][n] = *(const f32x4*)(gp + bj * 32 + n * 4);
        const float* xin = u.pm < 16 ? xin_ctx : xin_lat - (size_t)NCTX * 1024;
#pragma unroll
        for (int ai = 0; ai < (HM ? 1 : 2); ++ai)
#pragma unroll
            for (int m = 0; m < 4; ++m) { const size_t off = (size_t)(row0 + ai * 128 + m * 16) * 1024 + col0;
#pragma unroll
                for (int bj = 0; bj < 2; ++bj) { const f32x4 x0 = *(const f32x4*)(xin + off + bj * 32), x1 = *(const f32x4*)(xin + off + bj * 32 + 4);
                    const f32x4 t0 = alpha * x0 + gv[bj][0] * acc[ai][bj][m][0], t1 = alpha * x1 + gv[bj][1] * acc[ai][bj][m][1];
                    u32x4 w; w.x = cvt_pk_bf16(t0[0], t0[1]); w.y = cvt_pk_bf16(t0[2], t0[3]); w.z = cvt_pk_bf16(t1[0], t1[1]); w.w = cvt_pk_bf16(t1[2], t1[3]);
                    *(u32x4*)(tout + off + bj * 32) = w; } }
    }
};
typedef EpiResidT<false> EpiResid;

template <class Epi, class Sched>
__device__ __forceinline__ void gemm_phase(LAS unsigned char* lds, const Sched& S, const Epi& E) {
    const int tid = ltid(), wid = __builtin_amdgcn_readfirstlane(tid >> 6), lane = tid & 63, wr = wid >> 2, wc = wid & 3, fr = lane & 15, fq = lane >> 4;
    const int K = S.K, nt = K / BK, lda = S.lda, ldb = S.ldb;
    unsigned voffA[2], voffB[2];
#pragma unroll
    for (int i = 0; i < 2; ++i) { int R, C; stage_rc(tid * 16 + i * 8192, R, C); const int Rb = Epi::PERM ? ((R >> 5) * 64 + perm32(R & 31)) : R;
        voffA[i] = (unsigned)(R * lda + C) * 2u; voffB[i] = (unsigned)(Rb * ldb + C) * 2u; }
    const size_t kstep = (size_t)(BK * 2);
    const size_t hstepA = (size_t)HALF * lda * 2, hstepB = (size_t)(Epi::PERM ? 32 : HALF) * ldb * 2;
    const unsigned ldsw = (unsigned)wid * 1024u;
    const int aoff = lds_byte(wr * 64 + fr, fq * 8), boff = lds_byte(wc * 32 + fr, fq * 8);
#define PG8_SA(b, h) (((b) * 2 + (h)) * HTB)
#define PG8_SB(b, h) ((4 + (b) * 2 + (h)) * HTB)
#define PG8_STAGE(bufoff, gbase, voff) do { _Pragma("unroll") for (int _i = 0; _i < 2; ++_i) \
        __builtin_amdgcn_global_load_lds((const unsigned*)((const char*)(gbase) + (voff)[_i]), (LAS unsigned*)(lds + (bufoff) + ldsw + _i * 8192), 16, 0, 0); } while (0)
#define PG8_LDA(dst, b, h) do { _Pragma("unroll") for (int m = 0; m < 4; ++m) _Pragma("unroll") for (int k = 0; k < 2; ++k) dst[m][k] = *(const LAS bf16x8*)(lds + PG8_SA(b, h) + aoff + m * 2048 + k * 1024); } while (0)
#define PG8_LDB(dst, b, h) do { _Pragma("unroll") for (int n = 0; n < 2; ++n) _Pragma("unroll") for (int k = 0; k < 2; ++k) dst[n][k] = *(const LAS bf16x8*)(lds + PG8_SB(b, h) + boff + n * 2048 + k * 1024); } while (0)
#define PG8_MMA(ai, bj, At, Bt) do { __builtin_amdgcn_s_setprio(1); _Pragma("unroll") for (int m = 0; m < 4; ++m) _Pragma("unroll") for (int n = 0; n < 2; ++n) _Pragma("unroll") for (int k = 0; k < 2; ++k) \
        acc[ai][bj][m][n] = __builtin_amdgcn_mfma_f32_16x16x32_bf16(Bt[n][k], At[m][k], acc[ai][bj][m][n], 0, 0, 0); __builtin_amdgcn_s_setprio(0); } while (0)
#define PG8_WAIT_V(n) asm volatile("s_waitcnt vmcnt(" #n ")" ::: "memory")
#define PG8_WAIT_L(n) asm volatile("s_waitcnt lgkmcnt(" #n ")" ::: "memory")
#define PG8_BAR __builtin_amdgcn_s_barrier()
#define PG8_SCHED __builtin_amdgcn_sched_barrier(0)
    Unit cur, nxt; int ui = 0;
    if (!S.next(0, cur)) return;
    if (STAGGER_US > 0) {
        const unsigned grp = ((unsigned)lwg() >> 3) & 1u;
        if (grp) { const unsigned long long t0 = __builtin_amdgcn_s_memrealtime(); while (__builtin_amdgcn_s_memrealtime() - t0 < (unsigned long long)(STAGGER_US * 100)) __builtin_amdgcn_s_sleep(4); }
    }
    f32x4 acc[2][2][4][2];
#pragma unroll
    for (int a = 0; a < 2; ++a)
#pragma unroll
        for (int b = 0; b < 2; ++b)
#pragma unroll
            for (int m = 0; m < 4; ++m)
#pragma unroll
                for (int n = 0; n < 2; ++n) acc[a][b][m][n] = (f32x4){0.f, 0.f, 0.f, 0.f};
    bf16x8 At[4][2], B0[2][2], B1[2][2];
    const char* cA = S.a_ptr(cur); const char* cB = S.b_ptr(cur);
    PG8_STAGE(PG8_SB(0, 0), cB, voffB); PG8_STAGE(PG8_SA(0, 0), cA, voffA); PG8_STAGE(PG8_SB(0, 1), cB + hstepB, voffB); PG8_STAGE(PG8_SA(0, 1), cA + hstepA, voffA);
    if (wr == 1) PG8_BAR;
    PG8_WAIT_V(4); PG8_BAR;
    PG8_STAGE(PG8_SB(1, 0), cB + kstep, voffB); PG8_STAGE(PG8_SA(1, 0), cA + kstep, voffA); PG8_STAGE(PG8_SB(1, 1), cB + hstepB + kstep, voffB);
    PG8_WAIT_V(6); PG8_BAR;
    for (;;) {
        const bool has_next = S.next(ui + 1, nxt);
        const char* nA = has_next ? S.a_ptr(nxt) : cA; const char* nB = has_next ? S.b_ptr(nxt) : cB;
        for (int t = 0; t < nt; t += 2) {
            if constexpr (Epi::HAS_MID) { if (t == 8 || t == 16) E.mid(acc, cur, t >> 3, wr, wc, fr, fq); }
            const bool last = (t == nt - 2);
            const char* a1 = cA + (size_t)(t + 1) * kstep;
            const char* a2 = last ? nA : cA + (size_t)(t + 2) * kstep; const char* b2 = last ? nB : cB + (size_t)(t + 2) * kstep;
            const char* a3 = a2 + kstep; const char* b3 = b2 + kstep;
            PG8_LDB(B0, 0, 0); PG8_SCHED; PG8_LDA(At, 0, 0); PG8_STAGE(PG8_SA(1, 1), a1 + hstepA, voffA);
            PG8_WAIT_L(8); PG8_BAR; PG8_WAIT_L(0); PG8_MMA(0, 0, At, B0); PG8_BAR; PG8_SCHED;
            PG8_LDB(B1, 0, 1); PG8_STAGE(PG8_SB(0, 0), b2, voffB);
            PG8_BAR; PG8_WAIT_L(0); PG8_MMA(0, 1, At, B1); PG8_BAR;
            if constexpr (!Epi::HALFM) { PG8_LDA(At, 0, 1); } PG8_STAGE(PG8_SA(0, 0), a2, voffA);
            PG8_BAR; PG8_WAIT_L(0); if constexpr (!Epi::HALFM) { PG8_MMA(1, 0, At, B0); } PG8_BAR; PG8_SCHED;
            PG8_STAGE(PG8_SB(0, 1), b2 + hstepB, voffB);
            PG8_WAIT_V(6); PG8_BAR; if constexpr (!Epi::HALFM) { PG8_MMA(1, 1, At, B1); } PG8_BAR;
            PG8_LDB(B0, 1, 0); PG8_SCHED; PG8_LDA(At, 1, 0); PG8_STAGE(PG8_SA(0, 1), a2 + hstepA, voffA);
            PG8_WAIT_L(8); PG8_BAR; PG8_WAIT_L(0); PG8_MMA(0, 0, At, B0); PG8_BAR; PG8_SCHED;
            PG8_LDB(B1, 1, 1); PG8_STAGE(PG8_SB(1, 0), b3, voffB);
            PG8_BAR; PG8_WAIT_L(0); PG8_MMA(0, 1, At, B1); PG8_BAR;
            if constexpr (!Epi::HALFM) { PG8_LDA(At, 1, 1); } PG8_STAGE(PG8_SA(1, 0), a3, voffA);
            PG8_BAR; PG8_WAIT_L(0); if constexpr (!Epi::HALFM) { PG8_MMA(1, 0, At, B0); } PG8_BAR; PG8_SCHED;
            PG8_STAGE(PG8_SB(1, 1), b3 + hstepB, voffB);
            PG8_WAIT_V(6); PG8_BAR; if constexpr (!Epi::HALFM) { PG8_MMA(1, 1, At, B1); } PG8_BAR;
        }
        E(acc, cur, wr, wc, fr, fq);
        if (!has_next) break;
#pragma unroll
        for (int a = 0; a < 2; ++a)
#pragma unroll
            for (int b = 0; b < 2; ++b)
#pragma unroll
                for (int m = 0; m < 4; ++m)
#pragma unroll
                    for (int n = 0; n < 2; ++n) acc[a][b][m][n] = (f32x4){0.f, 0.f, 0.f, 0.f};
        cur = nxt; cA = nA; cB = nB; ++ui;
    }
    PG8_WAIT_V(0);
    if (wr == 0) PG8_BAR;
    PG8_BAR;
#undef PG8_SA
#undef PG8_SB
#undef PG8_STAGE
#undef PG8_LDA
#undef PG8_LDB
#undef PG8_MMA
#undef PG8_WAIT_V
#undef PG8_WAIT_L
#undef PG8_BAR
#undef PG8_SCHED
}

__device__ __forceinline__ void mods_phase(const P& p, float* MOD, float* ldsf) {
    const int tid = ltid(), wid = tid >> 6, lane = tid & 63;
    float* sc = ldsf;
    float* red = ldsf + 9 * 1024;
    for (int i = tid; i < 9 * 1024; i += 512) { const int j = i >> 10, k = i & 1023; const float v = j == 0 ? p.in[4][k] : p.in[3][(j - 1) * 1024 + k]; sc[i] = siluf_(v); }
    __syncthreads();
    for (int item = lwg(); item < 384; item += lnwg()) {
        const int l = item / 96, col0 = (item % 96) * 64;
        const float* w = p.in[19] + (size_t)l * 1024 * 6144 + col0 + lane;
        float a[9];
#pragma unroll
        for (int j = 0; j < 9; ++j) a[j] = 0.f;
        const int kb = wid * 128;
#pragma unroll 8
        for (int k = 0; k < 128; ++k) { const float wv = w[(size_t)(kb + k) * 6144];
#pragma unroll
            for (int j = 0; j < 9; ++j) a[j] += sc[j * 1024 + kb + k] * wv; }
#pragma unroll
        for (int j = 0; j < 9; ++j) red[(wid * 9 + j) * 64 + lane] = a[j];
        __syncthreads();
        for (int i = tid; i < 576; i += 512) { const int j = i >> 6, ln = i & 63; float s = p.in[20][l * 6144 + col0 + ln];
#pragma unroll
            for (int w8 = 0; w8 < 8; ++w8) s += red[(w8 * 9 + j) * 64 + ln];
            MOD[(size_t)(l * 9 + j) * 6144 + col0 + ln] = s; }
        __syncthreads();
    }
}

__device__ __forceinline__ void dft_phase(bf16_t* DL, bf16_t* DC) {
    const size_t gt = (size_t)lwg() * 512 + ltid(), gn = (size_t)lnwg() * 512;
    for (size_t i = gt; i < 2048ull * 2048 / 8; i += gn) { const int k = (int)(i / 256), kk0 = (int)(i % 256) * 8; float f[8];
#pragma unroll
        for (int j = 0; j < 8; ++j) { const int kk = kk0 + j; const bool cs = kk <= 1024; const int t = cs ? kk : kk - 1024; const int m = (k * t) & 2047; const float x = (float)m * (1.0f / 1024.0f);
            f[j] = (cs ? cospif(x) : -sinpif(x)) * (1.0f / 512.0f); }
        *(u32x4*)(DL + i * 8) = pack8(f); }
    for (size_t i = gt; i < 256ull * 512 / 8; i += gn) { const int k = (int)(i / 64), t0 = (int)(i % 64) * 8; float f[8];
#pragma unroll
        for (int j = 0; j < 8; ++j) { const int tt = t0 + j, t = tt & 255; const int m = (k * t) & 255; const float x = (float)m * (1.0f / 128.0f);
            f[j] = (tt < 256 ? cospif(x) : -sinpif(x)) * 0.005524271728019903f; }
        *(u32x4*)(DC + i * 8) = pack8(f); }
}

__device__ __forceinline__ void tconv_tile(const float* src, int ld_src, bf16_t* dst, int ld_dst, int k0, int n0, float scale, float* tl) {
    const int tid = ltid();
    f32x4 v[8];
#pragma unroll
    for (int ps = 0; ps < 8; ++ps) v[ps] = *(const f32x4*)(src + (size_t)(k0 + ps * 16 + (tid >> 5)) * ld_src + n0 + (tid & 31) * 4);
#pragma unroll
    for (int ps = 0; ps < 8; ++ps) { float* q = tl + (ps * 16 + (tid >> 5)) * 129 + (tid & 31) * 4; q[0] = v[ps][0]; q[1] = v[ps][1]; q[2] = v[ps][2]; q[3] = v[ps][3]; }
    __syncthreads();
    { const int n = tid >> 2, kq = tid & 3; bf16_t* q = dst + (size_t)(n0 + n) * ld_dst + k0 + kq * 32;
#pragma unroll
      for (int c = 0; c < 4; ++c) { float f[8];
#pragma unroll
          for (int j = 0; j < 8; ++j) f[j] = tl[(kq * 32 + c * 8 + j) * 129 + n] * scale;
          *(u32x4*)(q + c * 8) = pack8(f); } }
    __syncthreads();
}

__device__ __forceinline__ void wfft_item(int item, const float* win, bf16_t* W1T, float* tl) {
    const int tid = ltid(), kb = item >> 2, g = item & 3;
    float* xin = tl;
    float* ct = tl + 2048;
    { const int r = tid >> 5, c4 = (tid & 31) * 4; const f32x4 v = *(const f32x4*)(win + (size_t)(kb * 16 + r) * 7712 + g * 128 + c4); *(f32x4*)(xin + r * 128 + c4) = v; }
    if (tid < 128) { ct[tid] = cospif((float)tid * (1.0f / 64.0f)); ct[128 + tid] = sinpif((float)tid * (1.0f / 64.0f)); }
    __syncthreads();
    { const int jj = tid & 255, cs = jj >> 7, j = jj & 127, half = tid >> 8; float a[8];
#pragma unroll
      for (int r = 0; r < 8; ++r) a[r] = 0.f;
      const float* tb = ct + cs * 128; const float* xr = xin + half * 8 * 128;
      for (int c = 0; c < 128; ++c) { const float w = tb[(j * c) & 127];
#pragma unroll
          for (int r = 0; r < 8; ++r) a[r] += xr[r * 128 + c] * w; }
      *(u32x4*)(W1T + (size_t)(cs * 512 + g * 128 + j) * 1024 + kb * 16 + half * 8) = pack8(a); }
    __syncthreads();
}

__device__ __forceinline__ void wconv_phase(const P& p, int set, int l, float* tl, int wi, int nw, int lo = 0, int hi = 1 << 30) {
    bf16_t* W1T = (bf16_t*)(p.ws + WS_W1T); bf16_t* WMT = (bf16_t*)(p.ws + WS_WMT); bf16_t* WOT = (bf16_t*)(p.ws + WS_WOT);
    bf16_t* WUPT = (bf16_t*)(p.ws + WS_WUPT); bf16_t* WDNT = (bf16_t*)(p.ws + WS_WDNT);
    const float* win = p.in[5] + (size_t)l * 1024 * 7712;
    if (set == 0) {
        for (int it = lo + wi; it < (hi < 705 ? hi : 705); it += nw) {
            if (it < 256) wfft_item(it, win, W1T, tl);
            else if (it < 512) { const int j = it - 256, tk = j & 7, tn = j >> 3; const int n0 = tn * 128;
                tconv_tile(win + 512, 7712, W1T + (size_t)1024 * 1024, 1024, tk * 128, n0, (n0 >= 1024 && n0 < 1536) ? 0.08838834764831845f : 1.0f, tl); }
            else if (it < 704) { const int j = it - 512, tk = j & 7, tn = j >> 3;
                tconv_tile(win + 4640, 7712, W1T + (size_t)5120 * 1024, 1024, tk * 128, tn * 128, 1.0f, tl); }
            else { for (int i = ltid(); i < 256 * 1024; i += 512) { const int n = i >> 10, k = i & 1023;
                    W1T[(size_t)(8192 + n) * 1024 + k] = n < 32 ? f2bf(win[(size_t)k * 7712 + 4608 + n]) : (bf16_t)0; } }
        }
    } else if (set == 1) {
        for (int it = lo + wi; it < (hi < 192 ? hi : 192); it += nw) {
            if (it < 32) { const int tk = it & 3, tn = it >> 2; tconv_tile(p.in[7] + (size_t)l * 512 * 1024, 1024, WMT, 2048, tk * 128, tn * 128, 1.0f, tl); }
            else if (it < 64) { const int j = it - 32, tk = j & 3, tn = j >> 2; tconv_tile(p.in[11] + (size_t)l * 512 * 1024, 1024, WMT + 512, 2048, tk * 128, tn * 128, 1.0f, tl); }
            else if (it < 128) { const int j = it - 64, tk = j & 7, tn = j >> 3; tconv_tile(p.in[15] + (size_t)l * 1024 * 1024, 1024, WMT + 1024, 2048, tk * 128, tn * 128, 1.0f, tl); }
            else { const int j = it - 128, tk = j & 7, tn = j >> 3; tconv_tile(p.in[16] + (size_t)l * 1024 * 1024, 1024, WOT, 1024, tk * 128, tn * 128, 1.0f, tl); }
        }
    } else {
        for (int it = lo + wi; it < (hi < 528 ? hi : 528); it += nw) {
            if (it < 352) { const int tk = it & 7, tn = it >> 3; tconv_tile(p.in[21] + (size_t)l * 1024 * 5632, 5632, WUPT, 1024, tk * 128, tn * 128, 1.0f, tl); }
            else { const int j = it - 352, tn = j & 7, tk = j >> 3; tconv_tile(p.in[24] + (size_t)l * DFF * 1024, 1024, WDNT, DFF, tk * 128, tn * 128, 1.0f, tl); }
        }
    }
}

__device__ __forceinline__ void ln_phase(const float* src_ctx, const float* src_lat, float* xout, const float* g, const float* b, bool doLN,
                                         bool doH, const float* modl, int sci, int shi, bf16_t* H, const bf16_t* tsrc = nullptr) {
    const int lane = ltid() & 63, gw = lwg() * 8 + (ltid() >> 6), nw = lnwg() * 8;
    const int per = (NTOK + nw - 1) / nw, rbeg = gw * per, rend = (rbeg + per < NTOK) ? rbeg + per : NTOK;
    f32x4 gg[4], bb[4], scv[4], shv[4]; int cur = -1;
#pragma unroll
    for (int i = 0; i < 4; ++i) { gg[i] = doLN ? *(const f32x4*)(g + i * 256 + lane * 4) : (f32x4){1.f, 1.f, 1.f, 1.f}; bb[i] = doLN ? *(const f32x4*)(b + i * 256 + lane * 4) : (f32x4){0.f, 0.f, 0.f, 0.f};
        scv[i] = (f32x4){0.f, 0.f, 0.f, 0.f}; shv[i] = (f32x4){0.f, 0.f, 0.f, 0.f}; }
    auto body = [&](int row, f32x4 (&v)[4]) {
        if (doLN) {
            float s = 0.f;
#pragma unroll
            for (int i = 0; i < 4; ++i) s += (v[i][0] + v[i][1]) + (v[i][2] + v[i][3]);
            const float mean = wave_sum(s) * (1.0f / 1024.0f); float q = 0.f;
#pragma unroll
            for (int i = 0; i < 4; ++i) { const f32x4 d = v[i] - mean; q += (d[0] * d[0] + d[1] * d[1]) + (d[2] * d[2] + d[3] * d[3]); }
            const float rstd = rsqrtf(wave_sum(q) * (1.0f / 1024.0f) + 1e-5f);
#pragma unroll
            for (int i = 0; i < 4; ++i) { v[i] = (v[i] - mean) * rstd * gg[i] + bb[i]; *(f32x4*)(xout + (size_t)row * 1024 + i * 256 + lane * 4) = v[i]; }
        }
        if (doH) {
            const int cond = row < NCTX ? 0 : 1 + ((row - NCTX) >> 11);
            if (cond != cur) { cur = cond; const float* mp = modl + (size_t)cond * 6144;
#pragma unroll
                for (int i = 0; i < 4; ++i) { scv[i] = *(const f32x4*)(mp + sci * 1024 + i * 256 + lane * 4); shv[i] = *(const f32x4*)(mp + shi * 1024 + i * 256 + lane * 4); } }
            float s = 0.f;
#pragma unroll
            for (int i = 0; i < 4; ++i) s += (v[i][0] + v[i][1]) + (v[i][2] + v[i][3]);
            const float mean = wave_sum(s) * (1.0f / 1024.0f); float q = 0.f;
#pragma unroll
            for (int i = 0; i < 4; ++i) { const f32x4 d = v[i] - mean; q += (d[0] * d[0] + d[1] * d[1]) + (d[2] * d[2] + d[3] * d[3]); }
            const float rstd = rsqrtf(wave_sum(q) * (1.0f / 1024.0f) + 1e-5f);
#pragma unroll
            for (int i = 0; i < 4; ++i) { const f32x4 h = (v[i] - mean) * rstd * (1.0f + scv[i]) + shv[i];
                u32x2 w; w.x = cvt_pk_bf16(h[0], h[1]); w.y = cvt_pk_bf16(h[2], h[3]);
                *(u32x2*)(H + (size_t)row * 1024 + i * 256 + lane * 4) = w; }
        }
    };
    for (int row = rbeg; row < rend; row += 2) {
        const int row2 = row + 1; const bool has2 = row2 < rend;
        const int r2 = has2 ? row2 : row;
        f32x4 v[4], u[4];
        if (tsrc != nullptr) {
            u32x2 a[4], c[4];
#pragma unroll
            for (int i = 0; i < 4; ++i) { a[i] = *(const u32x2*)(tsrc + (size_t)row * 1024 + i * 256 + lane * 4); c[i] = *(const u32x2*)(tsrc + (size_t)r2 * 1024 + i * 256 + lane * 4); }
#pragma unroll
            for (int i = 0; i < 4; ++i) { v[i] = (f32x4){bf2f(a[i].x & 0xffffu), bf2f(a[i].x >> 16), bf2f(a[i].y & 0xffffu), bf2f(a[i].y >> 16)};
                u[i] = (f32x4){bf2f(c[i].x & 0xffffu), bf2f(c[i].x >> 16), bf2f(c[i].y & 0xffffu), bf2f(c[i].y >> 16)}; }
        } else {
            const float* src = row < NCTX ? src_ctx + (size_t)row * 1024 : src_lat + (size_t)(row - NCTX) * 1024;
            const float* src2 = r2 < NCTX ? src_ctx + (size_t)r2 * 1024 : src_lat + (size_t)(r2 - NCTX) * 1024;
#pragma unroll
            for (int i = 0; i < 4; ++i) { v[i] = *(const f32x4*)(src + i * 256 + lane * 4); u[i] = *(const f32x4*)(src2 + i * 256 + lane * 4); } }
        body(row, v);
        if (has2) body(row2, u);
    }
}

__device__ __forceinline__ void glapost_phase(bf16_t* AM, const bf16_t* OB, const bf16_t* Z, const float* ng) {
    const int lane = ltid() & 63, gw = lwg() * 8 + (ltid() >> 6), nw = lnwg() * 8;
    float gn[16];
#pragma unroll
    for (int j = 0; j < 16; ++j) gn[j] = ng[(lane & 15) * 16 + j];
    for (int row = gw; row < NTOK; row += nw) {
        bf16_t* op = AM + (size_t)row * 2048 + 1024 + lane * 16;
        const bf16_t* bp = OB + (size_t)row * 1024 + lane * 16;
        const bf16_t* rp = Z + (size_t)row * ZLD + ZR + lane * 16;
        float a[16], bq[16], r[16];
        { float t[8]; unpack8(*(const u32x4*)op, t);
#pragma unroll
          for (int j = 0; j < 8; ++j) a[j] = t[j];
          unpack8(*(const u32x4*)(op + 8), t);
#pragma unroll
          for (int j = 0; j < 8; ++j) a[8 + j] = t[j];
          unpack8(*(const u32x4*)bp, t);
#pragma unroll
          for (int j = 0; j < 8; ++j) bq[j] = t[j];
          unpack8(*(const u32x4*)(bp + 8), t);
#pragma unroll
          for (int j = 0; j < 8; ++j) bq[8 + j] = t[j];
          unpack8(*(const u32x4*)rp, t);
#pragma unroll
          for (int j = 0; j < 8; ++j) r[j] = t[j];
          unpack8(*(const u32x4*)(rp + 8), t);
#pragma unroll
          for (int j = 0; j < 8; ++j) r[8 + j] = t[j]; }
        float ss = 0.f;
#pragma unroll
        for (int j = 0; j < 16; ++j) { a[j] += bq[j]; ss += a[j] * a[j]; }
        ss += __shfl_xor(ss, 1); ss += __shfl_xor(ss, 2); ss += __shfl_xor(ss, 4); ss += __shfl_xor(ss, 8);
        const float rs = rsqrtf(ss * (1.0f / 256.0f) + 1e-5f);
        float o0[8], o1[8];
#pragma unroll
        for (int j = 0; j < 8; ++j) { o0[j] = a[j] * rs * gn[j] * r[j]; o1[j] = a[8 + j] * rs * gn[8 + j] * r[8 + j]; }
        *(u32x4*)op = pack8(o0); *(u32x4*)(op + 8) = pack8(o1);
    }
}

__device__ __forceinline__ void conv_phase(const bf16_t* AG, bf16_t* FF, const float* wdw, const float* bdw) {
    for (int wi = lwg(); wi < 220; wi += lnwg()) {
        const int rg = wi / 11, cg = wi - rg * 11;
        const int run = rg * 16 + (ltid() >> 5), cb = cg * 32 + (ltid() & 31), ch = cb * 8;
        const bool lat = run >= 64;
        const int tok0 = lat ? NCTX + (run - 64) * 64 : run * 64;
        const int gy = (run - 64) & 31;
        const bool up = lat && gy > 0, dn = lat && gy < 31;
        const int xlo = lat ? 0 : -(tok0 & 255), xhi = lat ? 63 : 255 - (tok0 & 255);
        f32x2 w[9][4], bias[4];
#pragma unroll
        for (int t = 0; t < 9; ++t) { const f32x4 a = *(const f32x4*)(wdw + t * DFF + ch), b = *(const f32x4*)(wdw + t * DFF + ch + 4);
            w[t][0] = (f32x2){a[0], a[1]}; w[t][1] = (f32x2){a[2], a[3]}; w[t][2] = (f32x2){b[0], b[1]}; w[t][3] = (f32x2){b[2], b[3]}; }
        { const f32x4 a = *(const f32x4*)(bdw + ch), b = *(const f32x4*)(bdw + ch + 4);
          bias[0] = (f32x2){a[0], a[1]}; bias[1] = (f32x2){a[2], a[3]}; bias[2] = (f32x2){b[0], b[1]}; bias[3] = (f32x2){b[2], b[3]}; }
        const bf16_t* base = AG + (size_t)tok0 * 5632 + ch;
        const u32x4 zero4 = {0u, 0u, 0u, 0u};
        f32x2 cA[3][4], cB[3][4], cC[3][4]; u32x4 nx[3];
#define CONV_LOADCOL(dst, x) do { const bool okx = (x) >= xlo && (x) <= xhi; const bf16_t* q_ = base + (ptrdiff_t)(x) * 5632; \
            dst[0] = (okx && up) ? *(const u32x4*)(q_ - 64 * 5632) : zero4; dst[1] = okx ? *(const u32x4*)q_ : zero4; dst[2] = (okx && dn) ? *(const u32x4*)(q_ + 64 * 5632) : zero4; } while (0)
#define CONV_UNPACK(dst, src) do { _Pragma("unroll") for (int dy_ = 0; dy_ < 3; ++dy_) { const u32x4 s_ = src[dy_]; \
            dst[dy_][0] = (f32x2){bf2f(s_.x & 0xffffu), bf2f(s_.x >> 16)}; dst[dy_][1] = (f32x2){bf2f(s_.y & 0xffffu), bf2f(s_.y >> 16)}; \
            dst[dy_][2] = (f32x2){bf2f(s_.z & 0xffffu), bf2f(s_.z >> 16)}; dst[dy_][3] = (f32x2){bf2f(s_.w & 0xffffu), bf2f(s_.w >> 16)}; } } while (0)
#define CONV_STEP(c0, c1, c2, x) do { \
            const u32x4 gw_ = *(const u32x4*)(base + (size_t)(x) * 5632 + DFF); \
            f32x2 acc_[4]; _Pragma("unroll") for (int j_ = 0; j_ < 4; ++j_) acc_[j_] = bias[j_]; \
            _Pragma("unroll") for (int dy_ = 0; dy_ < 3; ++dy_) _Pragma("unroll") for (int j_ = 0; j_ < 4; ++j_) { \
                acc_[j_] += c0[dy_][j_] * w[dy_ * 3 + 0][j_]; acc_[j_] += c1[dy_][j_] * w[dy_ * 3 + 1][j_]; acc_[j_] += c2[dy_][j_] * w[dy_ * 3 + 2][j_]; } \
            float g_[8], o_[8]; unpack8(gw_, g_); \
            _Pragma("unroll") for (int j_ = 0; j_ < 4; ++j_) { o_[2 * j_] = geluf_(acc_[j_][0]) * g_[2 * j_]; o_[2 * j_ + 1] = geluf_(acc_[j_][1]) * g_[2 * j_ + 1]; } \
            *(u32x4*)(FF + (size_t)(tok0 + (x)) * DFF + ch) = pack8(o_); \
            CONV_UNPACK(c0, nx); CONV_LOADCOL(nx, (x) + 3); } while (0)
        CONV_LOADCOL(nx, -1); CONV_UNPACK(cA, nx); CONV_LOADCOL(nx, 0); CONV_UNPACK(cB, nx); CONV_LOADCOL(nx, 1); CONV_UNPACK(cC, nx); CONV_LOADCOL(nx, 2);
#pragma unroll 1
        for (int x = 0; x < 63; x += 3) { CONV_STEP(cA, cB, cC, x); CONV_STEP(cB, cC, cA, x + 1); CONV_STEP(cC, cA, cB, x + 2); }
        CONV_STEP(cA, cB, cC, 63);
#undef CONV_STEP
#undef CONV_UNPACK
#undef CONV_LOADCOL
    }
}

__device__ __forceinline__ void sgu_item(int item, int l, const P& p, const bf16_t* Z, bf16_t* AM, LAS unsigned char* lds) {
    const int tid = ltid(), wid = tid >> 6, lane = tid & 63, fr = lane & 15, fq = lane >> 4;
    LAS float* STAT = (LAS float*)lds;
    LAS bf16_t* VT = (LAS bf16_t*)(lds + 1024);
    const int row0 = item * 128;
    u32x4 vrow[16];
#pragma unroll
    for (int i = 0; i < 16; ++i) vrow[i] = *(const u32x4*)(Z + (size_t)(row0 + wid * 16 + i) * ZLD + ZV + lane * 8);
#pragma unroll
    for (int i = 0; i < 16; ++i) { const int q = wid * 16 + i; float f[8]; unpack8(vrow[i], f);
        float s = 0.f;
#pragma unroll
        for (int j = 0; j < 8; ++j) s += f[j];
        const float mean = wave_sum(s) * (1.0f / 512.0f); float qq = 0.f;
#pragma unroll
        for (int j = 0; j < 8; ++j) { const float d = f[j] - mean; qq += d * d; }
        const float rstd = rsqrtf(wave_sum(qq) * (1.0f / 512.0f) + 1e-5f);
        if (lane == 0) { STAT[q * 2] = mean; STAT[q * 2 + 1] = rstd; } }
    LDS_BARRIER();
    for (int g = 0; g < 4; ++g) {
        { const int q = tid >> 2, seg = tid & 3; const float mean = STAT[q * 2], rstd = STAT[q * 2 + 1];
#pragma unroll
          for (int j4 = 0; j4 < 4; ++j4) { const int c0 = seg * 32 + j4 * 8; float f[8]; unpack8(*(const u32x4*)(Z + (size_t)(row0 + q) * ZLD + ZV + g * 128 + c0), f);
              const float* sg = p.in[8] + l * 512 + g * 128 + c0;
#pragma unroll
              for (int j = 0; j < 8; ++j) VT[(c0 + j) * 136 + q] = f2bf((f[j] - mean) * rstd * sg[j]); } }
        LDS_BARRIER();
        bf16x8 Yf[4];
        { const float* wp = p.in[9] + ((size_t)(l * 4 + g) * 128 + wid * 16 + fr) * 128 + 8 * fq;
#pragma unroll
          for (int kk = 0; kk < 4; ++kk) { const f32x4 a = *(const f32x4*)(wp + kk * 32), b = *(const f32x4*)(wp + kk * 32 + 4);
              u32x4 w; w.x = cvt_pk_bf16(a[0], a[1]); w.y = cvt_pk_bf16(a[2], a[3]); w.z = cvt_pk_bf16(b[0], b[1]); w.w = cvt_pk_bf16(b[2], b[3]);
              Yf[kk] = __builtin_bit_cast(bf16x8, w); } }
        const int pp = wid * 16 + fr; const size_t tok = (size_t)(row0 + pp);
        const float bias = p.in[10][(l * 4 + g) * 128 + pp];
#pragma unroll
        for (int ct = 0; ct < 8; ++ct) { f32x4 acc = {0.f, 0.f, 0.f, 0.f};
#pragma unroll
            for (int kk = 0; kk < 4; ++kk) { const bf16x8 X = *(const LAS bf16x8*)(VT + (ct * 16 + fr) * 136 + kk * 32 + 8 * fq);
                acc = __builtin_amdgcn_mfma_f32_16x16x32_bf16(X, Yf[kk], acc, 0, 0, 0); }
            const int c = ct * 16 + 4 * fq;
            const u32x2 uw = *(const u32x2*)(Z + tok * ZLD + ZU + g * 128 + c);
            const float u0 = bf2f(uw.x & 0xffffu), u1 = bf2f(uw.x >> 16), u2 = bf2f(uw.y & 0xffffu), u3 = bf2f(uw.y >> 16);
            u32x2 ow; ow.x = cvt_pk_bf16(u0 * (acc[0] + bias), u1 * (acc[1] + bias)); ow.y = cvt_pk_bf16(u2 * (acc[2] + bias), u3 * (acc[3] + bias));
            *(u32x2*)(AM + tok * 2048 + 512 + g * 128 + c) = ow; }
        LDS_BARRIER();
    }
}

__device__ __forceinline__ void glapre_item(int item, int l, const P& p, const bf16_t* Z, const float* LR, bf16_t* AM, bf16_t* HB, float* ETOT, LAS unsigned char* lds) {
    const int tid = ltid();
    LAS float* LRS = (LAS float*)lds;
    LAS float* GT = (LAS float*)(lds + 8192);
    const int c = item >> 2, h = item & 3, row0 = c * 64;
    const int kc = tid & 127, lg = tid >> 7;
    { const int li = tid >> 3, part = tid & 7; *(LAS f32x4*)(LRS + li * 32 + part * 4) = *(const f32x4*)(LR + (size_t)(row0 + li) * 32 + part * 4); }
    float w0[16], w1[16];
#pragma unroll
    for (int r = 0; r < 16; ++r) { w0[r] = p.in[12][((size_t)(l * 2 + 0) * 16 + r) * 512 + h * 128 + kc]; w1[r] = p.in[12][((size_t)(l * 2 + 1) * 16 + r) * 512 + h * 128 + kc]; }
    const float b0 = p.in[13][(l * 2 + 0) * 512 + h * 128 + kc], b1 = p.in[13][(l * 2 + 1) * 512 + h * 128 + kc];
    float qv[16], kv[16];
#pragma unroll
    for (int i = 0; i < 16; ++i) { const bf16_t* zr = Z + (size_t)(row0 + lg * 16 + i) * ZLD + h * 128 + kc; qv[i] = bf2f(zr[ZQ]); kv[i] = bf2f(zr[ZK]); }
    __syncthreads();
    float G0[16], G1[16];
#pragma unroll
    for (int i = 0; i < 16; ++i) { const LAS float* lr = LRS + (lg * 16 + i) * 32; float z0 = b0, z1 = b1;
#pragma unroll
        for (int r4 = 0; r4 < 4; ++r4) { const f32x4 a = *(const LAS f32x4*)(lr + r4 * 4), b = *(const LAS f32x4*)(lr + 16 + r4 * 4);
#pragma unroll
            for (int r = 0; r < 4; ++r) { z0 += a[r] * w0[r4 * 4 + r]; z1 += b[r] * w1[r4 * 4 + r]; } }
        G0[i] = (fminf(z0, 0.f) - __logf(1.0f + __expf(-fabsf(z0)))) * (1.0f / 16.0f);
        G1[i] = (fminf(z1, 0.f) - __logf(1.0f + __expf(-fabsf(z1)))) * (1.0f / 16.0f); }
#pragma unroll
    for (int i = 1; i < 16; ++i) G0[i] += G0[i - 1];
#pragma unroll
    for (int i = 14; i >= 0; --i) G1[i] += G1[i + 1];
    GT[lg * 128 + kc] = G0[15]; GT[512 + lg * 128 + kc] = G1[0];
    LDS_BARRIER();
    float pre0 = 0.f, pre1 = 0.f, tot0 = 0.f, tot1 = 0.f;
#pragma unroll
    for (int g4 = 0; g4 < 4; ++g4) { const float t0 = GT[g4 * 128 + kc], t1 = GT[512 + g4 * 128 + kc]; tot0 += t0; tot1 += t1; if (g4 < lg) pre0 += t0; if (g4 > lg) pre1 += t1; }
    if (lg == 0) { ETOT[((size_t)item * 2 + 0) * 128 + kc] = __expf(tot0); ETOT[((size_t)item * 2 + 1) * 128 + kc] = __expf(tot1); }
#pragma unroll
    for (int i = 0; i < 16; ++i) { const size_t row = (size_t)(row0 + lg * 16 + i);
        const float e0 = __expf(pre0 + G0[i]), e1 = __expf(pre1 + G1[i]);
        bf16_t* a = AM + row * 2048 + 1024 + h * 256 + kc; bf16_t* b = HB + row * 1024 + h * 256 + kc;
        a[0] = f2bf(qv[i] * e0); a[128] = f2bf(kv[i] * __builtin_amdgcn_rcpf(e0));
        b[0] = f2bf(qv[i] * e1); b[128] = f2bf(kv[i] * __builtin_amdgcn_rcpf(e1)); }
    LDS_BARRIER();
}

typedef float f32x16 __attribute__((ext_vector_type(16)));
__device__ __forceinline__ int crow32(int reg, int h) { return (reg & 3) + 8 * (reg >> 2) + 4 * h; }
__device__ __forceinline__ void gla_item(int item, int l, const P& p, const bf16_t* Z, const float* ETOT, bf16_t* AM, bf16_t* HB, LAS unsigned char* lds) {
    const int tid = ltid(), wid = tid >> 6, lane = tid & 63, r32 = lane & 31, hh = lane >> 5;
    LAS bf16_t* QG  = (LAS bf16_t*)lds;
    LAS bf16_t* KG  = (LAS bf16_t*)(lds + 17408);
    LAS bf16_t* KGT = (LAS bf16_t*)(lds + 34816);
    LAS bf16_t* VT  = (LAS bf16_t*)(lds + 53248);
    LAS bf16_t* AB  = (LAS bf16_t*)(lds + 90112);
    LAS float*  ET  = (LAS float*)(lds + 99328);
    LAS bf16_t* OST = (LAS bf16_t*)(lds + 99840);
    int b, h, dir, T, seq0; const bool lat = item < 64;
    { const int idx = lat ? item : item - 64; dir = idx & 1; h = (idx >> 1) & 3; b = idx >> 3; }
    if (lat) { T = 2048; seq0 = NCTX + b * 2048; } else { T = 256; seq0 = b * 256; }
    f32x16 S[4];
    if (lat) { const float* sp = p.in[2] + ((size_t)((b * 4 + l) * 2 + dir) * 4 + h) * 128 * 256 + 32 * wid + r32;
#pragma unroll
        for (int kt = 0; kt < 4; ++kt)
#pragma unroll
            for (int reg = 0; reg < 16; ++reg) S[kt][reg] = sp[(size_t)(32 * kt + crow32(reg, hh)) * 256]; }
    else {
#pragma unroll
        for (int kt = 0; kt < 4; ++kt)
#pragma unroll
            for (int reg = 0; reg < 16; ++reg) S[kt][reg] = 0.f; }
    bf16_t* gbuf = dir ? HB : AM + 1024; const int ldg = dir ? 1024 : 2048;
    const int nch = T / 64;
    u32x4 pg[4], pv[4]; f32x4 pe = {0.f, 0.f, 0.f, 0.f};
#define GLA_TOK(pos) (seq0 + (dir ? T - 1 - (pos) : (pos)))
#define GLA_ISSUE(n_) do { const int pos0_ = (n_) * 64; const int li_ = tid >> 3, seg_ = tid & 7; const int tok_ = GLA_TOK(pos0_ + li_); \
        const bf16_t* gp_ = gbuf + (size_t)tok_ * ldg + h * 256 + seg_ * 32; const bf16_t* vp_ = Z + (size_t)tok_ * ZLD + ZVV + h * 256 + seg_ * 32; \
        _Pragma("unroll") for (int j_ = 0; j_ < 4; ++j_) { pg[j_] = *(const u32x4*)(gp_ + j_ * 8); pv[j_] = *(const u32x4*)(vp_ + j_ * 8); } \
        if (tid < 32) { const int ck_ = GLA_TOK(pos0_) >> 6; pe = *(const f32x4*)(ETOT + ((size_t)(ck_ * 4 + h) * 2 + dir) * 128 + tid * 4); } } while (0)
#define MFMA32(a_, b_, c_) __builtin_amdgcn_mfma_f32_32x32x16_bf16((a_), (b_), (c_), 0, 0, 0)
#define GLA_FLUSH(n_) do { const int li_ = tid >> 3, seg_ = tid & 7; bf16_t* op_ = gbuf + (size_t)GLA_TOK((n_) * 64 + li_) * ldg + h * 256 + seg_ * 32; \
        const LAS bf16_t* sp_ = OST + li_ * 264 + seg_ * 32; _Pragma("unroll") for (int j_ = 0; j_ < 4; ++j_) *(u32x4*)(op_ + j_ * 8) = *(const LAS u32x4*)(sp_ + j_ * 8); } while (0)
    GLA_ISSUE(0);
    for (int n = 0; n < nch; ++n) {
        const int pos0 = n * 64;
        if (n > 0) GLA_FLUSH(n - 1);
        { const int li = tid >> 3, seg = tid & 7;
          LAS bf16_t* gq = (seg < 4 ? QG : KG) + li * 136 + (seg & 3) * 32;
#pragma unroll
          for (int j = 0; j < 4; ++j) *(LAS u32x4*)(gq + j * 8) = pg[j];
          if (seg >= 4) { LAS bf16_t* q = KGT + ((seg - 4) * 32) * 72 + ((li + 8 * (seg - 4)) & 63);
#pragma unroll
              for (int j = 0; j < 4; ++j) { const u32x4 w = pg[j]; LAS bf16_t* qq = q + j * 8 * 72;
                  qq[0] = (bf16_t)(w.x & 0xffffu); qq[72] = (bf16_t)(w.x >> 16); qq[144] = (bf16_t)(w.y & 0xffffu); qq[216] = (bf16_t)(w.y >> 16);
                  qq[288] = (bf16_t)(w.z & 0xffffu); qq[360] = (bf16_t)(w.z >> 16); qq[432] = (bf16_t)(w.w & 0xffffu); qq[504] = (bf16_t)(w.w >> 16); } }
          LAS bf16_t* q = VT + (seg * 32) * 72 + ((li + 8 * seg) & 63);
#pragma unroll
          for (int j = 0; j < 4; ++j) { const u32x4 w = pv[j]; LAS bf16_t* qq = q + j * 8 * 72;
              qq[0] = (bf16_t)(w.x & 0xffffu); qq[72] = (bf16_t)(w.x >> 16); qq[144] = (bf16_t)(w.y & 0xffffu); qq[216] = (bf16_t)(w.y >> 16);
              qq[288] = (bf16_t)(w.z & 0xffffu); qq[360] = (bf16_t)(w.z >> 16); qq[432] = (bf16_t)(w.w & 0xffffu); qq[504] = (bf16_t)(w.w >> 16); } }
        if (tid < 32) *(LAS f32x4*)(ET + tid * 4) = pe;
        LDS_BARRIER();
        if (n + 1 < nch) GLA_ISSUE(n + 1);
        if (wid < 4) { const int lt = (wid == 1 || wid == 2) ? 1 : 0, mt = (wid == 2 || wid == 3) ? 1 : 0;
            f32x16 acc;
#pragma unroll
            for (int reg = 0; reg < 16; ++reg) acc[reg] = 0.f;
            if (wid < 3) {
#pragma unroll
                for (int s = 0; s < 8; ++s) { const bf16x8 A = *(const LAS bf16x8*)(KG + (32 * mt + r32) * 136 + 16 * s + 8 * hh), B = *(const LAS bf16x8*)(QG + (32 * lt + r32) * 136 + 16 * s + 8 * hh);
                    acc = MFMA32(A, B, acc); } }
            const int li = 32 * lt + r32;
#pragma unroll
            for (int g = 0; g < 4; ++g) { const int m0 = 32 * mt + 8 * g + 4 * hh;
                u32x2 w; w.x = cvt_pk_bf16(m0 <= li ? acc[4 * g] : 0.f, m0 + 1 <= li ? acc[4 * g + 1] : 0.f); w.y = cvt_pk_bf16(m0 + 2 <= li ? acc[4 * g + 2] : 0.f, m0 + 3 <= li ? acc[4 * g + 3] : 0.f);
                *(LAS u32x2*)(AB + li * 72 + m0) = w; } }
        LDS_BARRIER();
        bf16x8 VTf[4];
#pragma unroll
        for (int s = 0; s < 4; ++s) VTf[s] = *(const LAS bf16x8*)(VT + (32 * wid + r32) * 72 + ((16 * s + 8 * hh + 8 * wid) & 63));
#pragma unroll
        for (int lt = 0; lt < 2; ++lt) { f32x16 acc;
#pragma unroll
            for (int reg = 0; reg < 16; ++reg) acc[reg] = 0.f;
#pragma unroll
            for (int s = 0; s < 4; ++s) { const bf16x8 B = *(const LAS bf16x8*)(AB + (32 * lt + r32) * 72 + 16 * s + 8 * hh); acc = MFMA32(VTf[s], B, acc); }
#pragma unroll
            for (int kt = 0; kt < 4; ++kt)
#pragma unroll
                for (int s = 0; s < 2; ++s) {
                    u32x4 pa; pa.x = cvt_pk_bf16(S[kt][8 * s], S[kt][8 * s + 1]); pa.y = cvt_pk_bf16(S[kt][8 * s + 2], S[kt][8 * s + 3]);
                    pa.z = cvt_pk_bf16(S[kt][8 * s + 4], S[kt][8 * s + 5]); pa.w = cvt_pk_bf16(S[kt][8 * s + 6], S[kt][8 * s + 7]);
                    const LAS bf16_t* qp = QG + (32 * lt + r32) * 136 + 32 * kt + 16 * s + 4 * hh;
                    const u32x2 lo = *(const LAS u32x2*)qp, hi = *(const LAS u32x2*)(qp + 8);
                    u32x4 pb; pb.x = lo.x; pb.y = lo.y; pb.z = hi.x; pb.w = hi.y;
                    acc = MFMA32(__builtin_bit_cast(bf16x8, pa), __builtin_bit_cast(bf16x8, pb), acc); }
            LAS bf16_t* orow = OST + (32 * lt + r32) * 264 + 32 * wid + 4 * hh;
#pragma unroll
            for (int g = 0; g < 4; ++g) { u32x2 w; w.x = cvt_pk_bf16(acc[4 * g], acc[4 * g + 1]); w.y = cvt_pk_bf16(acc[4 * g + 2], acc[4 * g + 3]);
                *(LAS u32x2*)(orow + 8 * g) = w; } }
#pragma unroll
        for (int kt = 0; kt < 4; ++kt) { f32x16 acc = S[kt];
#pragma unroll
            for (int s = 0; s < 4; ++s) { const bf16x8 A = *(const LAS bf16x8*)(KGT + (32 * kt + r32) * 72 + ((16 * s + 8 * hh + 8 * kt) & 63)); acc = MFMA32(A, VTf[s], acc); }
#pragma unroll
            for (int g = 0; g < 4; ++g) { const f32x4 e4 = *(const LAS f32x4*)(ET + 32 * kt + 8 * g + 4 * hh);
#pragma unroll
                for (int q = 0; q < 4; ++q) acc[4 * g + q] *= e4[q]; }
            S[kt] = acc; }
        LDS_BARRIER();
    }
    GLA_FLUSH(nch - 1);
    LDS_BARRIER();
#undef GLA_FLUSH
#undef MFMA32
#undef GLA_ISSUE
#undef GLA_TOK
    if (!lat) { float* sp = p.out + (size_t)NTOK * 1024 + ((size_t)((b * 4 + l) * 2 + dir) * 4 + h) * 128 * 256 + 32 * wid + r32;
#pragma unroll
        for (int kt = 0; kt < 4; ++kt)
#pragma unroll
            for (int reg = 0; reg < 16; ++reg) sp[(size_t)(32 * kt + crow32(reg, hh)) * 256] = S[kt][reg]; }
}


__device__ __forceinline__ void fold_item(int item, const bf16_t* XTl, bf16_t* XF, LAS unsigned char* lds) {
    const int tid = ltid(); LAS bf16_t* R = (LAS bf16_t*)lds;
    const size_t r0 = (size_t)item * 4;
#pragma unroll
    for (int rr = 0; rr < 4; ++rr) *(LAS u32x4*)(R + rr * 4096 + tid * 8) = *(const u32x4*)(XTl + (r0 + rr) * 4096 + tid * 8);
    LDS_BARRIER();
#pragma unroll
    for (int rr = 0; rr < 4; ++rr) { const LAS bf16_t* row = R + rr * 4096; float f[4];
#pragma unroll
        for (int i = 0; i < 4; ++i) { const int kk = tid * 4 + i;
            if (kk <= 1024) { f[i] = bf2f(row[kk]); if (kk >= 1 && kk <= 1023) f[i] += bf2f(row[2048 - kk]); }
            else { const int t = kk - 1024; f[i] = bf2f(row[2048 + t]) - bf2f(row[4096 - t]); } }
        u32x2 w; w.x = cvt_pk_bf16(f[0], f[1]); w.y = cvt_pk_bf16(f[2], f[3]);
        *(u32x2*)(XF + (r0 + rr) * 2048 + tid * 4) = w; }
    LDS_BARRIER();
}

#define XB_TMO      128
#define XB_XCNT(j)  (256  + 64 * (j))
#define XB_XSUB(j)  (1280 + 64 * (j))
#define XB_XGEN(j)  (2304 + 64 * (j))
#define XB_TOP      3328
#define XB_TOPGEN   3392
#define XCD_BAR_WORDS 3456
#define XB_SPIN_CAP (1u << 18)
__device__ __forceinline__ unsigned xb_ld(unsigned* p)              { return __hip_atomic_load(p, __ATOMIC_RELAXED, __HIP_MEMORY_SCOPE_AGENT); }
__device__ __forceinline__ unsigned xb_add(unsigned* p, unsigned v) { return __hip_atomic_fetch_add(p, v, __ATOMIC_RELAXED, __HIP_MEMORY_SCOPE_AGENT); }
__device__ __forceinline__ unsigned xb_xcc_id() { return (unsigned)__builtin_amdgcn_s_getreg((3 << 11) | 20) & 0xFu; }
#define XB_SPIN(cond, bar) do { unsigned _sp = 0; while (cond) { __builtin_amdgcn_s_sleep(1); \
    if ((++_sp & 255u) == 0u) { if (xb_ld(&(bar)[XB_TMO])) break; if (_sp > XB_SPIN_CAP) { atomicAdd(&(bar)[XB_TMO], 1u); break; } } } } while (0)
struct XcdBarrier { unsigned* bar; unsigned x; volatile LAS unsigned* st; };
__device__ __forceinline__ XcdBarrier xcd_barrier_post(unsigned* bar, volatile LAS unsigned* st) {
    XcdBarrier b; b.bar = bar; b.x = xb_xcc_id(); b.st = st;
    if (threadIdx.x == 0) (void)xb_add(&bar[XB_XCNT(b.x)], 1u);
    return b;
}
__device__ __forceinline__ void xcd_barrier_complete(unsigned* bar, unsigned x, unsigned& nloc, unsigned& nx) {
    const unsigned G = gridDim.x * gridDim.y * gridDim.z;
    unsigned sum, cnt, mine, sp = 0u;
    for (;;) {
        sum = 0u; cnt = 0u; mine = 0u;
#pragma unroll
        for (unsigned j = 0; j < 16; ++j) { const unsigned c = xb_ld(&bar[XB_XCNT(j)]); sum += c; cnt += (c > 0u) ? 1u : 0u; mine = (j == x) ? c : mine; }
        if (sum == G) break;
        __builtin_amdgcn_s_sleep(1);
        if ((++sp & 255u) == 0u) { if (xb_ld(&bar[XB_TMO])) break; if (sp > XB_SPIN_CAP) { atomicAdd(&bar[XB_TMO], 1u); break; } }
    }
    nloc = mine > 0u ? mine : 1u; nx = cnt > 0u ? cnt : 1u;
}
__device__ __forceinline__ void xcd_barrier(const XcdBarrier& b) {
    asm volatile("s_waitcnt vmcnt(0)" ::: "memory");
    __syncthreads();
    if (threadIdx.x == 0) {
        unsigned* bar = b.bar;
        __builtin_amdgcn_s_waitcnt(0);
        unsigned nloc = b.st[0], nx = b.st[1];
        if (nloc == 0u) { xcd_barrier_complete(bar, b.x, nloc, nx); b.st[0] = nloc; b.st[1] = nx; }
        const unsigned old = xb_add(&bar[XB_XSUB(b.x)], 1u);
        const unsigned gen = old / nloc;
        if (old + 1u == (gen + 1u) * nloc) {
            __builtin_amdgcn_fence(__ATOMIC_RELEASE, "agent");
            asm volatile("s_waitcnt vmcnt(0)" ::: "memory");
            const unsigned og = xb_add(&bar[XB_TOP], 1u);
            const unsigned tg = og / nx;
            if (og + 1u == (tg + 1u) * nx) xb_add(&bar[XB_TOPGEN], 1u);
            else XB_SPIN(xb_ld(&bar[XB_TOPGEN]) == tg, bar);
            __builtin_amdgcn_fence(__ATOMIC_ACQUIRE, "agent");
            xb_add(&bar[XB_XGEN(b.x)], 1u);
            asm volatile("s_waitcnt vmcnt(0)" ::: "memory");
        } else {
            XB_SPIN(xb_ld(&bar[XB_XGEN(b.x)]) == gen, bar);
            __builtin_amdgcn_fence(__ATOMIC_ACQUIRE, "agent");
            asm volatile("s_waitcnt vmcnt(0)" ::: "memory");
        }
    }
    __syncthreads();
}

template <int PH>
__device__ __forceinline__ void run_phase(const P& p, int l, unsigned char* shm) {
    LAS unsigned char* lds = (LAS unsigned char*)shm;
    const int wg = lwg(), nwg = lnwg();
    size_t wso = 0; asm volatile("" : "+s"(wso)); unsigned char* wsb = p.ws + wso;
    float* MOD = (float*)(wsb + WS_MOD);
    bf16_t* DLAT = (bf16_t*)(wsb + WS_DLAT); bf16_t* DCTX = (bf16_t*)(wsb + WS_DCTX);
    bf16_t* W1T = (bf16_t*)(wsb + WS_W1T); bf16_t* WMT = (bf16_t*)(wsb + WS_WMT); bf16_t* WOT = (bf16_t*)(wsb + WS_WOT);
    bf16_t* WUPT = (bf16_t*)(wsb + WS_WUPT); bf16_t* WDNT = (bf16_t*)(wsb + WS_WDNT);
    bf16_t* H = (bf16_t*)(wsb + WS_H); bf16_t* XTc = (bf16_t*)(wsb + WS_XT); bf16_t* XTl = (bf16_t*)(wsb + WS_XTL); bf16_t* Mb = (bf16_t*)(wsb + WS_XT);
    bf16_t* Z = (bf16_t*)(wsb + WS_Z); float* LR = (float*)(wsb + WS_LR); bf16_t* AM = (bf16_t*)(wsb + WS_AM); float* ETOT = (float*)(wsb + WS_ETOT); bf16_t* XF = (bf16_t*)(wsb + WS_XF);
    bf16_t* AG = (bf16_t*)(wsb + WS_AG); bf16_t* FF = (bf16_t*)(wsb + WS_FF);
    float* X = p.out;
    const float* modl = MOD + (size_t)l * 9 * 6144;
    if constexpr (PH == 0) {
        mods_phase(p, MOD, (float*)shm);
        dft_phase(DLAT, DCTX);
        wconv_phase(p, 0, 0, (float*)shm, wg, nwg);
        wconv_phase(p, 1, 0, (float*)shm, wg, nwg);
    } else if constexpr (PH == 1) {
        ln_phase(p.in[0], p.in[1], nullptr, nullptr, nullptr, false, true, MOD, 1, 0, H);
    } else if constexpr (PH == 2) {
        const int full = (80 * 33 / nwg) * nwg;
        { SchedLim S{H, W1T, 1024, 1024, 1024, 80, 33, nwg, wg, full}; EpiIn E{Z, XTc, XTl, LR, p.in[6] + l * 3072}; gemm_phase(lds, S, E); }
        { SchedRestM S{H, W1T, 1024, 1024, 1024, 80, 33, nwg, wg, full}; EpiInT<true> E{Z, XTc, XTl, LR, p.in[6] + l * 3072}; gemm_phase(lds, S, E); }
    } else if constexpr (PH == 3) {
        for (int it = wg; it < 1280; it += nwg) glapre_item(it, l, p, Z, LR, AM, H, ETOT, lds);
        for (int it = wg; it < 1024; it += nwg) fold_item(it, XTl, XF, lds);
    } else if constexpr (PH == 4) {
        if (wg < NFFT_WG) { SchedFftL S{DLAT, XF, 2048, 2048, 2048, NFFT_WG, wg}; EpiBf16 E{AM, 2048}; gemm_phase(lds, S, E); }
        else if (wg < NFFT_WG + 64) gla_item(wg - NFFT_WG, l, p, Z, ETOT, AM, H, lds);
        unsigned* qhead = (unsigned*)(wsb + WS_BAR) + 3584 + 64 * l;
        volatile LAS unsigned* qw = (volatile LAS unsigned*)(lds + 151040 + 16);
        for (;;) {
            __syncthreads();
            if (ltid() == 0) qw[0] = __hip_atomic_fetch_add(qhead, 1u, __ATOMIC_RELAXED, __HIP_MEMORY_SCOPE_AGENT);
            __syncthreads();
            const int qi = __builtin_amdgcn_readfirstlane((int)qw[0]);
            if (qi >= 320) break;
            if (qi < 32) { SchedFftC S{DCTX, XTc, 512, 512, 512, 1 << 20, qi}; EpiBf16 E{AM, 2048}; gemm_phase(lds, S, E); }
            else if (qi < 160) gla_item(64 + (qi - 32), l, p, Z, ETOT, AM, H, lds);
            else sgu_item(qi - 160, l, p, Z, AM, lds);
        }
    } else if constexpr (PH == 5) {
        glapost_phase(AM, H, Z, p.in[14] + l * 256);
    } else if constexpr (PH == 6) {
        { SchedStd S{AM, WMT, 2048, 2048, 2048, 64, 4, nwg, wg}; EpiMerge E{Mb, Z}; gemm_phase(lds, S, E); }
        { SchedTailM S{AM, WMT, 2048, 2048, 2048, nwg, wg}; EpiMergeT<true> E{Mb, Z}; gemm_phase(lds, S, E); }
        if (wg >= 128) wconv_phase(p, 2, l, (float*)shm, wg - 128, nwg - 128);
    } else if constexpr (PH == 7) {
        const float* xc = l == 0 ? p.in[0] : X; const float* xl = l == 0 ? p.in[1] : X + (size_t)NCTX * 1024;
        { SchedStd S{Mb, WOT, 1024, 1024, 1024, 64, 4, nwg, wg}; EpiResid E{xc, xl, (bf16_t*)(wsb + WS_Z), modl + 2 * 1024}; gemm_phase(lds, S, E); }
        { SchedTailM S{Mb, WOT, 1024, 1024, 1024, nwg, wg}; EpiResidT<true> E{xc, xl, (bf16_t*)(wsb + WS_Z), modl + 2 * 1024}; gemm_phase(lds, S, E); }
        if (wg >= 128 && l + 1 < DEPTH) wconv_phase(p, 1, l + 1, (float*)shm, wg - 128, nwg - 128, 0, 128);
    } else if constexpr (PH == 8) {
        ln_phase(X, X + (size_t)NCTX * 1024, X, p.in[17] + l * 1024, p.in[18] + l * 1024, true, true, modl, 4, 3, H, (const bf16_t*)(wsb + WS_Z));
    } else if constexpr (PH == 9) {
        SchedStd S{H, WUPT, 1024, 1024, 1024, 80, 22, nwg, wg}; EpiBf16 E{AG, 5632}; gemm_phase(lds, S, E);
    } else if constexpr (PH == 10) {
        conv_phase(AG, FF, p.in[22] + (size_t)l * 9 * DFF, p.in[23] + l * DFF);
    } else if constexpr (PH == 11) {
        { SchedStd S{FF, WDNT, DFF, DFF, DFF, 64, 4, nwg, wg}; EpiResid E{X, X + (size_t)NCTX * 1024, (bf16_t*)(wsb + WS_Z), modl + 5 * 1024}; gemm_phase(lds, S, E); }
        { SchedTailM S{FF, WDNT, DFF, DFF, DFF, nwg, wg}; EpiResidT<true> E{X, X + (size_t)NCTX * 1024, (bf16_t*)(wsb + WS_Z), modl + 5 * 1024}; gemm_phase(lds, S, E); }
        if (wg >= 128 && l + 1 < DEPTH) { wconv_phase(p, 1, l + 1, (float*)shm, wg - 128, nwg - 128, 128, 192); wconv_phase(p, 0, l + 1, (float*)shm, wg - 128, nwg - 128); }
    } else if constexpr (PH == 12) {
        ln_phase(X, X + (size_t)NCTX * 1024, X, p.in[25] + l * 1024, p.in[26] + l * 1024, true, l + 1 < DEPTH, modl + 9 * 6144, 1, 0, H, (const bf16_t*)(wsb + WS_Z));
    }
}

#ifndef MULTI
#define MULTI 0
#endif

#if MULTI
template <int PH> __global__ void __launch_bounds__(512) k_phase(P p, int l) {
    extern __shared__ __attribute__((aligned(16))) unsigned char shm[];
    run_phase<PH>(p, l, shm);
}
template <int PH> static void launch_phase(const P& p, int l, int grid, hipStream_t stream) {
    static bool attr = false;
    if (!attr) { (void)hipFuncSetAttribute((const void*)k_phase<PH>, hipFuncAttributeMaxDynamicSharedMemorySize, LDS_BYTES); attr = true; }
    hipLaunchKernelGGL((k_phase<PH>), dim3(grid), dim3(512), LDS_BYTES, stream, p, l);
}
#else
#ifndef REPEAT_PH
#define REPEAT_PH 0
#endif
#ifndef STOP_PH
#define STOP_PH 99
#endif
__device__ __forceinline__ void dump_phase(const P& p, int which) {
    size_t wso = 0; asm volatile("" : "+s"(wso)); unsigned char* wsb = p.ws + wso;
    const size_t gt = (size_t)lwg() * 512 + ltid(), gn = (size_t)lnwg() * 512;
    const bf16_t* AM = (const bf16_t*)(wsb + WS_AM); const bf16_t* Z = (const bf16_t*)(wsb + WS_Z); const bf16_t* Mb = (const bf16_t*)(wsb + WS_XT);
    const bf16_t* H = (const bf16_t*)(wsb + WS_H); const float* LR = (const float*)(wsb + WS_LR);
    for (size_t i = gt; i < (size_t)NTOK * 1024; i += gn) { const size_t row = i >> 10, c = i & 1023; float v = 0.f;
        if (which == 0) v = bf2f(AM[row * 2048 + c]) + bf2f(AM[row * 2048 + 1024 + c]);
        else if (which == 1) { for (int j = 0; j < 7; ++j) v += bf2f(Z[row * ZLD + j * 1024 + c]); v += LR[row * 32 + (c & 31)] + bf2f(Mb[i]); }
        else if (which == 2) v = bf2f(Mb[i]);
        else if (which == 3) v = bf2f(H[i]);
        else if (which == 4) { const bf16_t* AG = (const bf16_t*)(wsb + WS_AG); for (int j = 0; j < 5; ++j) v += bf2f(AG[row * 5632 + j * 1024 + c]); }
        else if (which == 5) { const bf16_t* FF = (const bf16_t*)(wsb + WS_FF); v = bf2f(FF[row * DFF + c]) + bf2f(FF[row * DFF + 1024 + c]); }
        p.out[i] = v; }
}
__global__ void __launch_bounds__(512) fwd_megakernel(P p) {
    extern __shared__ __attribute__((aligned(16))) unsigned char shm[];
    cg::grid_group grid = cg::this_grid();
    volatile LAS unsigned* stw = (volatile LAS unsigned*)((LAS unsigned char*)shm + 151040);
    if (threadIdx.x == 0) { stw[0] = 0u; stw[1] = 0u; }
    __syncthreads();
    const XcdBarrier xb = xcd_barrier_post((unsigned*)(p.ws + WS_BAR), stw);
    run_phase<0>(p, 0, shm); grid.sync();
    run_phase<1>(p, 0, shm); xcd_barrier(xb);
#pragma unroll 1
    for (int l = 0; l < DEPTH; ++l) {
        run_phase<2>(p, l, shm); xcd_barrier(xb);
        if (STOP_PH == 2) { dump_phase(p, 1); return; }
#if REPEAT_PH == 2
        run_phase<2>(p, l, shm); xcd_barrier(xb);
#endif
        run_phase<3>(p, l, shm); xcd_barrier(xb);
        run_phase<4>(p, l, shm); xcd_barrier(xb);
#if REPEAT_PH == 34
        run_phase<3>(p, l, shm); xcd_barrier(xb);
        run_phase<4>(p, l, shm); xcd_barrier(xb);
#elif REPEAT_PH == 3
        run_phase<3>(p, l, shm); xcd_barrier(xb);
#elif REPEAT_PH == 4
        run_phase<4>(p, l, shm); xcd_barrier(xb);
#endif
        run_phase<5>(p, l, shm); xcd_barrier(xb);
        if (STOP_PH == 5) { dump_phase(p, 0); return; }
        run_phase<6>(p, l, shm); xcd_barrier(xb);
#if REPEAT_PH == 6
        run_phase<6>(p, l, shm); xcd_barrier(xb);
#endif
        if (STOP_PH == 6) { dump_phase(p, 2); return; }
        run_phase<7>(p, l, shm); xcd_barrier(xb);
        if (STOP_PH == 7) return;
        run_phase<8>(p, l, shm); xcd_barrier(xb);
        if (STOP_PH == 8) { xcd_barrier(xb); dump_phase(p, 3); return; }
        run_phase<9>(p, l, shm); xcd_barrier(xb);
        if (STOP_PH == 9) { dump_phase(p, 4); return; }
        run_phase<10>(p, l, shm); xcd_barrier(xb);
#if REPEAT_PH == 910
        run_phase<9>(p, l, shm); xcd_barrier(xb);
        run_phase<10>(p, l, shm); xcd_barrier(xb);
#elif REPEAT_PH == 10
        run_phase<10>(p, l, shm); xcd_barrier(xb);
#endif
        if (STOP_PH == 10) { dump_phase(p, 5); return; }
        run_phase<11>(p, l, shm); xcd_barrier(xb);
        if (STOP_PH == 11) return;
        run_phase<12>(p, l, shm); xcd_barrier(xb);
        if (STOP_PH == 12) return;
    }
}
#endif

extern "C" void kernel_launch(void* const* d_in, const int* in_sizes, int n_in, void* d_out, int out_size, void* d_ws, size_t ws_size, hipStream_t stream) {
    P p{};
    for (int i = 0; i < 27; ++i) p.in[i] = (const float*)d_in[i];
    p.out = (float*)d_out; p.ws = (unsigned char*)d_ws;
    if (ws_size < WS_END) { fprintf(stderr, "kernel_launch: workspace too small: %zu < %zu\n", ws_size, (size_t)WS_END); }
#if MULTI
    const int grid = 256;
    launch_phase<0>(p, 0, grid, stream);
    launch_phase<1>(p, 0, grid, stream);
    for (int l = 0; l < DEPTH; ++l) {
        launch_phase<2>(p, l, grid, stream);
        launch_phase<3>(p, l, grid, stream);
        launch_phase<4>(p, l, grid, stream);
        launch_phase<5>(p, l, grid, stream);
        launch_phase<6>(p, l, grid, stream);
        launch_phase<7>(p, l, grid, stream);
        launch_phase<8>(p, l, grid, stream);
        launch_phase<9>(p, l, grid, stream);
        launch_phase<10>(p, l, grid, stream);
        launch_phase<11>(p, l, grid, stream);
        launch_phase<12>(p, l, grid, stream);
    }
#else
    static int grid_blocks = 0;
    if (!grid_blocks) {
        int dev = 0, cus = 0, per_cu = 0;
        (void)hipGetDevice(&dev);
        (void)hipDeviceGetAttribute(&cus, hipDeviceAttributeMultiprocessorCount, dev);
        (void)hipFuncSetAttribute((const void*)fwd_megakernel, hipFuncAttributeMaxDynamicSharedMemorySize, LDS_BYTES);
        (void)hipOccupancyMaxActiveBlocksPerMultiprocessor(&per_cu, (const void*)fwd_megakernel, 512, LDS_BYTES);
        if (per_cu < 1) per_cu = 1;
        grid_blocks = cus * per_cu;
    }
    (void)hipMemsetAsync((char*)d_ws + WS_BAR, 0, 16384, stream);
    void* args[] = {&p};
    hipError_t e = hipLaunchCooperativeKernel((const void*)fwd_megakernel, dim3(grid_blocks), dim3(512), args, LDS_BYTES, stream);
    if (e != hipSuccess) fprintf(stderr, "cooperative launch failed: %s (grid %d)\n", hipGetErrorString(e), grid_blocks);
#endif
}
```

```cpp
#include <hip/hip_runtime.h>
#include <hip/hip_cooperative_groups.h>
#include <cstdio>
namespace cg = cooperative_groups;

#define LAS __attribute__((address_space(3)))
typedef unsigned short bf16_t;
typedef short bf16x8 __attribute__((ext_vector_type(8)));
typedef float f32x4 __attribute__((ext_vector_type(4)));
typedef float f32x2 __attribute__((ext_vector_type(2)));
typedef unsigned u32x4 __attribute__((ext_vector_type(4)));
typedef unsigned u32x2 __attribute__((ext_vector_type(2)));

constexpr int D = 1024, NTOK = 20480, NCTX = 4096, DEPTH = 4;
constexpr int ZLD = 7168;
constexpr int ZU = 0, ZV = 512, ZQ = 1024, ZK = 1536, ZVV = 2048, ZR = 3072, ZG = 4096;
constexpr int N1 = 8448;
constexpr int DFF = 2816;
constexpr int NFFT_WG = 128;

constexpr size_t WS_MOD  = 0;
constexpr size_t WS_DLAT = WS_MOD + 4ull * 9 * 6144 * 4;
constexpr size_t WS_DCTX = WS_DLAT + 2048ull * 2048 * 2;
constexpr size_t WS_W1T  = WS_DCTX + 256ull * 512 * 2;
constexpr size_t WS_WMT  = WS_W1T + (size_t)N1 * 1024 * 2;
constexpr size_t WS_WOT  = WS_WMT + 1024ull * 2048 * 2;
constexpr size_t WS_H    = WS_WOT + 1024ull * 1024 * 2;
constexpr size_t WS_XT   = WS_H + (size_t)NTOK * 1024 * 2;
constexpr size_t WS_XTL  = WS_XT + 16ull * 512 * 512 * 2;
constexpr size_t WS_Z    = WS_XT + (size_t)NTOK * 1024 * 2;
constexpr size_t WS_LR   = WS_Z + (size_t)NTOK * ZLD * 2;
constexpr size_t WS_AM   = WS_LR + (size_t)NTOK * 32 * 4;
constexpr size_t WS_BAR  = WS_AM + (size_t)NTOK * 2048 * 2;
constexpr size_t WS_ETOT = WS_BAR + 16384;
constexpr size_t WS_WUPT = WS_ETOT + 1280ull * 2 * 128 * 4;
constexpr size_t WS_WDNT = WS_WUPT + 5632ull * 1024 * 2;
constexpr size_t WS_XF   = WS_WDNT + 1024ull * 2816 * 2;
constexpr size_t WS_END  = WS_XF + 8ull * 512 * 2048 * 2;
constexpr size_t WS_AG   = WS_Z;
constexpr size_t WS_FF   = WS_Z + (size_t)NTOK * 5632 * 2;
static_assert(WS_FF + (size_t)NTOK * DFF * 2 <= WS_END, "ffn alias");

constexpr int LDS_BYTES = 151552;
#ifndef STAGGER_US
#define STAGGER_US 0
#endif

struct P {
    const float* in[27];
    float* out;
    unsigned char* ws;
};

#define LDS_BARRIER() do { asm volatile("s_waitcnt lgkmcnt(0)" ::: "memory"); __builtin_amdgcn_s_barrier(); asm volatile("" ::: "memory"); } while (0)
__device__ __forceinline__ int ltid() { int t = threadIdx.x; asm volatile("" : "+v"(t)); return t; }
__device__ __forceinline__ int lwg() { int b = blockIdx.x; asm volatile("" : "+s"(b)); return b; }
__device__ __forceinline__ int lnwg() { int b = gridDim.x; asm volatile("" : "+s"(b)); return b; }

__device__ __forceinline__ float bf2f(unsigned v) { return __uint_as_float(v << 16); }
typedef __bf16 bf2_t __attribute__((ext_vector_type(2)));
__device__ __forceinline__ unsigned cvt_pk_bf16(float lo, float hi) { const f32x2 v = {lo, hi}; const bf2_t b = __builtin_convertvector(v, bf2_t); return __builtin_bit_cast(unsigned, b); }
__device__ __forceinline__ bf16_t f2bf(float f) { return (bf16_t)(cvt_pk_bf16(f, 0.f) & 0xffffu); }
__device__ __forceinline__ float sigmoidf_(float x) { return __builtin_amdgcn_rcpf(1.0f + __expf(-x)); }
__device__ __forceinline__ float siluf_(float x) { return x * __builtin_amdgcn_rcpf(1.0f + __expf(-x)); }
__device__ __forceinline__ float geluf_(float x) { const float y = 1.5957691216057308f * (x + 0.044715f * x * x * x); return x * __builtin_amdgcn_rcpf(1.0f + __expf(-y)); }
__device__ __forceinline__ float wave_sum(float v) {
#pragma unroll
    for (int o = 32; o >= 1; o >>= 1) v += __shfl_xor(v, o);
    return v;
}
__device__ __forceinline__ void unpack8(const u32x4 w, float (&f)[8]) {
    f[0] = bf2f(w.x & 0xffffu); f[1] = bf2f(w.x >> 16); f[2] = bf2f(w.y & 0xffffu); f[3] = bf2f(w.y >> 16);
    f[4] = bf2f(w.z & 0xffffu); f[5] = bf2f(w.z >> 16); f[6] = bf2f(w.w & 0xffffu); f[7] = bf2f(w.w >> 16);
}
__device__ __forceinline__ u32x4 pack8(const float (&f)[8]) {
    u32x4 w; w.x = cvt_pk_bf16(f[0], f[1]); w.y = cvt_pk_bf16(f[2], f[3]); w.z = cvt_pk_bf16(f[4], f[5]); w.w = cvt_pk_bf16(f[6], f[7]); return w;
}

constexpr int BM = 256, BK = 64, HALF = 128, HTB = HALF * BK * 2;
__device__ __forceinline__ int lds_byte(int r, int c) { const int st = (r >> 4) * 2 + (c >> 5), rr = r & 15, cc = c & 31, ob = rr * 64 + cc * 2; return st * 1024 + (ob ^ (((ob >> 9) & 1) << 5)); }
__device__ __forceinline__ void stage_rc(int b, int& R, int& C) { const int st = b / 1024, sb = b % 1024, swz = sb ^ (((sb >> 9) & 1) << 5); R = (st >> 1) * 16 + swz / 64; C = (st & 1) * 32 + (swz % 64) / 2; }
__device__ __forceinline__ int perm32(int rho) { const int n = rho >> 4, i = rho & 15; return 8 * (i >> 2) + 4 * n + (i & 3); }

struct Unit { int pm, pn, aux; };

__device__ __forceinline__ void tile_map(int L, int nM, int nN, int& pm, int& pn) {
    const int nwg = nM * nN; int wgid = L;
    { const int q = nwg / 8, r = nwg % 8, xcd = wgid % 8, off = wgid / 8; wgid = (xcd < r ? xcd * (q + 1) : r * (q + 1) + (xcd - r) * q) + off; }
    const int nig = 8 * nN, gid = wgid / nig, fm = gid * 8, gsz = (nM - fm) < 8 ? (nM - fm) : 8;
    pm = fm + ((wgid % nig) % gsz); pn = (wgid % nig) / gsz;
}

struct SchedStd {
    const bf16_t* A; const bf16_t* Bt; int lda, ldb, K, nM, nN, G, c;
    __device__ __forceinline__ bool next(int i, Unit& u) const { const int L = i * G + c; if (L >= nM * nN) return false; tile_map(L, nM, nN, u.pm, u.pn); u.aux = 0; return true; }
    __device__ __forceinline__ const char* a_ptr(const Unit& u) const { return (const char*)A + (size_t)u.pm * 256 * lda * 2; }
    __device__ __forceinline__ const char* b_ptr(const Unit& u) const { return (const char*)Bt + (size_t)u.pn * 256 * ldb * 2; }
};
struct SchedMerge {
    const bf16_t* A; const bf16_t* Bt; int lda, ldb, K, G, c;
    __device__ __forceinline__ bool next(int i, Unit& u) const { const int L = (i >> 2) * G + c; if (L >= 320) return false; tile_map(L, 80, 4, u.pm, u.pn); u.aux = i & 3; return true; }
    __device__ __forceinline__ const char* a_ptr(const Unit& u) const { return (const char*)A + ((size_t)u.pm * 256 * lda + u.aux * 512) * 2; }
    __device__ __forceinline__ const char* b_ptr(const Unit& u) const { return (const char*)Bt + ((size_t)u.pn * 256 * ldb + u.aux * 512) * 2; }
};
struct SchedLim {
    const bf16_t* A; const bf16_t* Bt; int lda, ldb, K, nM, nN, G, c, limit;
    __device__ __forceinline__ bool next(int i, Unit& u) const { const int L = i * G + c; if (L >= limit) return false; tile_map(L, nM, nN, u.pm, u.pn); u.aux = 0; return true; }
    __device__ __forceinline__ const char* a_ptr(const Unit& u) const { return (const char*)A + (size_t)u.pm * 256 * lda * 2; }
    __device__ __forceinline__ const char* b_ptr(const Unit& u) const { return (const char*)Bt + (size_t)u.pn * 256 * ldb * 2; }
};
struct SchedRestM {
    const bf16_t* A; const bf16_t* Bt; int lda, ldb, K, nM, nN, G, c, first;
    __device__ __forceinline__ bool next(int i, Unit& u) const { const int q = i * G + c; const int L = first + (q >> 1); if (L >= nM * nN) return false; tile_map(L, nM, nN, u.pm, u.pn); u.aux = q & 1; return true; }
    __device__ __forceinline__ const char* a_ptr(const Unit& u) const { return (const char*)A + ((size_t)u.pm * 256 + (size_t)u.aux * 128) * lda * 2; }
    __device__ __forceinline__ const char* b_ptr(const Unit& u) const { return (const char*)Bt + (size_t)u.pn * 256 * ldb * 2; }
};
struct SchedTailM {
    const bf16_t* A; const bf16_t* Bt; int lda, ldb, K, G, c;
    __device__ __forceinline__ bool next(int i, Unit& u) const { const int L = i * G + c; if (L >= 128) return false; const int tt = L >> 1; u.pm = 64 + (tt >> 2); u.pn = tt & 3; u.aux = L & 1; return true; }
    __device__ __forceinline__ const char* a_ptr(const Unit& u) const { return (const char*)A + ((size_t)u.pm * 256 + (size_t)u.aux * 128) * lda * 2; }
    __device__ __forceinline__ const char* b_ptr(const Unit& u) const { return (const char*)Bt + (size_t)u.pn * 256 * ldb * 2; }
};
struct SchedFftL {
    const bf16_t* A; const bf16_t* Bt; int lda, ldb, K, G, c;
    __device__ __forceinline__ bool next(int i, Unit& u) const { const int L = i * G + c; if (L >= 128) return false; const int b = L >> 4, rem = L & 15; u.pm = 16 + b * 8 + (rem >> 1); u.pn = rem & 1; u.aux = b; return true; }
    __device__ __forceinline__ const char* a_ptr(const Unit& u) const { return (const char*)A + (size_t)((u.pm - 16) & 7) * 256 * 2048 * 2; }
    __device__ __forceinline__ const char* b_ptr(const Unit& u) const { return (const char*)Bt + ((size_t)u.aux * 512 + u.pn * 256) * 2048 * 2; }
};
struct SchedFftC {
    const bf16_t* A; const bf16_t* Bt; int lda, ldb, K, G, c;
    __device__ __forceinline__ bool next(int i, Unit& u) const { const int L = i * G + c; if (L >= 32) return false; u.pm = L >> 1; u.pn = L & 1; u.aux = 0; return true; }
    __device__ __forceinline__ const char* a_ptr(const Unit&) const { return (const char*)A; }
    __device__ __forceinline__ const char* b_ptr(const Unit& u) const { return (const char*)Bt + ((size_t)u.pm * 512 + u.pn * 256) * 512 * 2; }
};

template <bool HM> struct EpiInT {
    static constexpr bool PERM = true, HAS_MID = false, HALFM = HM;
    bf16_t* Z; bf16_t* XTc; bf16_t* XTl; float* LR; const float* bmerge;
    __device__ __forceinline__ void operator()(const f32x4 (&acc)[2][2][4][2], const Unit& u, int wr, int wc, int fr, int fq) const {
        const int pn = u.pn, cl = wc * 64 + 8 * fq;
        if (pn < 4) {
            bf16_t* base; int ldk, t0; const int cs = pn >> 1;
            if (u.pm < 16) { base = XTc + (size_t)u.pm * 512 * 512; ldk = 512; t0 = cs * 256; }
            else { const int b = (u.pm - 16) >> 3; base = XTl + (size_t)b * 512 * 4096; ldk = 4096; t0 = cs * 2048 + ((u.pm - 16) & 7) * 256; }
            t0 += (HM ? u.aux * 128 : 0) + wr * 64 + fr;
#pragma unroll
            for (int ai = 0; ai < (HM ? 1 : 2); ++ai)
#pragma unroll
                for (int m = 0; m < 4; ++m) { const int t = t0 + ai * 128 + m * 16;
#pragma unroll
                    for (int bj = 0; bj < 2; ++bj)
#pragma unroll
                        for (int n = 0; n < 2; ++n) { const int c = (pn & 1) * 256 + bj * 32 + cl + n * 4; const f32x4 v = acc[ai][bj][m][n];
                            const unsigned p0 = cvt_pk_bf16(v[0], v[1]), p1 = cvt_pk_bf16(v[2], v[3]);
                            bf16_t* q = base + (size_t)c * ldk + t;
                            q[0] = (bf16_t)(p0 & 0xffffu); q[ldk] = (bf16_t)(p0 >> 16); q[2 * ldk] = (bf16_t)(p1 & 0xffffu); q[3 * ldk] = (bf16_t)(p1 >> 16); } }
        } else if (pn < 32) {
            const int zc0 = (pn - 4) * 256 + cl;
            const int mode = pn < 8 ? 1 : (pn < 16 ? 0 : (pn < 20 ? 2 : 3));
            f32x4 bv[2][2];
#pragma unroll
            for (int bj = 0; bj < 2; ++bj)
#pragma unroll
                for (int n = 0; n < 2; ++n) bv[bj][n] = (mode == 3) ? *(const f32x4*)(bmerge + (zc0 - ZG) + bj * 32 + n * 4) : (f32x4){0.f, 0.f, 0.f, 0.f};
            const int row0 = u.pm * 256 + (HM ? u.aux * 128 : 0) + wr * 64 + fr;
#pragma unroll
            for (int ai = 0; ai < (HM ? 1 : 2); ++ai)
#pragma unroll
                for (int m = 0; m < 4; ++m) { bf16_t* rowp = Z + (size_t)(row0 + ai * 128 + m * 16) * ZLD + zc0;
#pragma unroll
                    for (int bj = 0; bj < 2; ++bj) { float f[8];
#pragma unroll
                        for (int j = 0; j < 4; ++j) { f[j] = acc[ai][bj][m][0][j] + bv[bj][0][j]; f[4 + j] = acc[ai][bj][m][1][j] + bv[bj][1][j]; }
                        if (mode == 1) {
#pragma unroll
                            for (int j = 0; j < 8; ++j) f[j] = geluf_(f[j]); }
                        else if (mode == 2) {
#pragma unroll
                            for (int j = 0; j < 8; ++j) f[j] = siluf_(f[j]); }
                        else if (mode == 3) {
#pragma unroll
                            for (int j = 0; j < 8; ++j) f[j] = sigmoidf_(f[j]); }
                        *(u32x4*)(rowp + bj * 32) = pack8(f); } }
        } else {
            if (wc == 0) { const int row0 = u.pm * 256 + (HM ? u.aux * 128 : 0) + wr * 64 + fr;
#pragma unroll
                for (int ai = 0; ai < (HM ? 1 : 2); ++ai)
#pragma unroll
                    for (int m = 0; m < 4; ++m) { float* q = LR + (size_t)(row0 + ai * 128 + m * 16) * 32 + 8 * fq;
                        *(f32x4*)q = acc[ai][0][m][0]; *(f32x4*)(q + 4) = acc[ai][0][m][1]; } }
        }
    }
};
typedef EpiInT<false> EpiIn;
struct EpiBf16 {
    static constexpr bool PERM = true, HAS_MID = false, HALFM = false;
    bf16_t* O; int ldc;
    __device__ __forceinline__ void operator()(const f32x4 (&acc)[2][2][4][2], const Unit& u, int wr, int wc, int fr, int fq) const {
        const int row0 = u.pm * 256 + wr * 64 + fr, col0 = u.pn * 256 + wc * 64 + 8 * fq;
#pragma unroll
        for (int ai = 0; ai < 2; ++ai)
#pragma unroll
            for (int m = 0; m < 4; ++m) { bf16_t* rowp = O + (size_t)(row0 + ai * 128 + m * 16) * ldc + col0;
#pragma unroll
                for (int bj = 0; bj < 2; ++bj) { const f32x4 v0 = acc[ai][bj][m][0], v1 = acc[ai][bj][m][1];
                    u32x4 w; w.x = cvt_pk_bf16(v0[0], v0[1]); w.y = cvt_pk_bf16(v0[2], v0[3]); w.z = cvt_pk_bf16(v1[0], v1[1]); w.w = cvt_pk_bf16(v1[2], v1[3]);
                    *(u32x4*)(rowp + bj * 32) = w; } }
    }
};
template <bool HM> struct EpiMergeT {
    static constexpr bool PERM = true, HAS_MID = true, HALFM = HM;
    bf16_t* Mo; const bf16_t* Z;
    __device__ __forceinline__ void mid(f32x4 (&acc)[2][2][4][2], const Unit& u, int seg, int wr, int wc, int fr, int fq) const {
        asm volatile("" : "+v"(fr), "+v"(fq));
        const int row0 = u.pm * 256 + (HM ? u.aux * 128 : 0) + wr * 64 + fr, col0 = u.pn * 256 + wc * 64 + 8 * fq;
        const bf16_t* zp = Z + ZG + (seg - 1) * 1024 + col0;
#pragma unroll
        for (int ai = 0; ai < (HM ? 1 : 2); ++ai)
#pragma unroll
            for (int m = 0; m < 4; ++m) { const bf16_t* rp = zp + (size_t)(row0 + ai * 128 + m * 16) * ZLD;
#pragma unroll
                for (int bj = 0; bj < 2; ++bj) { float gp[8], gn[8]; unpack8(*(const u32x4*)(rp + bj * 32), gp); unpack8(*(const u32x4*)(rp + 1024 + bj * 32), gn);
#pragma unroll
                    for (int j = 0; j < 4; ++j) { acc[ai][bj][m][0][j] *= fmaxf(gp[j], 1e-8f) * __builtin_amdgcn_rcpf(fmaxf(gn[j], 1e-8f));
                        acc[ai][bj][m][1][j] *= fmaxf(gp[4 + j], 1e-8f) * __builtin_amdgcn_rcpf(fmaxf(gn[4 + j], 1e-8f)); } }
                if (m & 1) asm volatile("" ::: "memory"); }
    }
    __device__ __forceinline__ void operator()(const f32x4 (&acc)[2][2][4][2], const Unit& u, int wr, int wc, int fr, int fq) const {
        const int row0 = u.pm * 256 + (HM ? u.aux * 128 : 0) + wr * 64 + fr, col0 = u.pn * 256 + wc * 64 + 8 * fq;
#pragma unroll
        for (int ai = 0; ai < (HM ? 1 : 2); ++ai)
#pragma unroll
            for (int m = 0; m < 4; ++m) { const size_t row = (size_t)(row0 + ai * 128 + m * 16);
#pragma unroll
                for (int bj = 0; bj < 2; ++bj) {
                    float g[8], f[8]; unpack8(*(const u32x4*)(Z + row * ZLD + ZG + 2048 + col0 + bj * 32), g);
#pragma unroll
                    for (int j = 0; j < 4; ++j) { f[j] = acc[ai][bj][m][0][j] * fmaxf(g[j], 1e-8f); f[4 + j] = acc[ai][bj][m][1][j] * fmaxf(g[4 + j], 1e-8f); }
                    *(u32x4*)(Mo + row * 1024 + col0 + bj * 32) = pack8(f); } }
    }
};
typedef EpiMergeT<false> EpiMerge;
template <bool HM> struct EpiResidT {
    static constexpr bool PERM = true, HAS_MID = false, HALFM = HM;
    const float* xin_ctx; const float* xin_lat; bf16_t* tout; const float* gate;
    __device__ __forceinline__ void operator()(const f32x4 (&acc)[2][2][4][2], const Unit& u, int wr, int wc, int fr, int fq) const {
        const float alpha = 1.681792830507429f;
        const int cond = u.pm < 16 ? 0 : 1 + ((u.pm - 16) >> 3);
        const int col0 = u.pn * 256 + wc * 64 + 8 * fq, row0 = u.pm * 256 + (HM ? u.aux * 128 : 0) + wr * 64 + fr;
        const float* gp = gate + (size_t)cond * 6144 + col0;
        f32x4 gv[2][2];
#pragma unroll
        for (int bj = 0; bj < 2; ++bj)
#pragma unroll
            for (int n = 0; n < 2; ++n) gv[bj][n] = *(const f32x4*)(gp + bj * 32 + n * 4);
        const float* xin = u.pm < 16 ? xin_ctx : xin_lat - (size_t)NCTX * 1024;
#pragma unroll
        for (int ai = 0; ai < (HM ? 1 : 2); ++ai)
#pragma unroll
            for (int m = 0; m < 4; ++m) { const size_t off = (size_t)(row0 + ai * 128 + m * 16) * 1024 + col0;
#pragma unroll
                for (int bj = 0; bj < 2; ++bj) { const f32x4 x0 = *(const f32x4*)(xin + off + bj * 32), x1 = *(const f32x4*)(xin + off + bj * 32 + 4);
                    const f32x4 t0 = alpha * x0 + gv[bj][0] * acc[ai][bj][m][0], t1 = alpha * x1 + gv[bj][1] * acc[ai][bj][m][1];
                    u32x4 w; w.x = cvt_pk_bf16(t0[0], t0[1]); w.y = cvt_pk_bf16(t0[2], t0[3]); w.z = cvt_pk_bf16(t1[0], t1[1]); w.w = cvt_pk_bf16(t1[2], t1[3]);
                    *(u32x4*)(tout + off + bj * 32) = w; } }
    }
};
typedef EpiResidT<false> EpiResid;

template <class Epi, class Sched>
__device__ __forceinline__ void gemm_phase(LAS unsigned char* lds, const Sched& S, const Epi& E) {
    const int tid = ltid(), wid = __builtin_amdgcn_readfirstlane(tid >> 6), lane = tid & 63, wr = wid >> 2, wc = wid & 3, fr = lane & 15, fq = lane >> 4;
    const int K = S.K, nt = K / BK, lda = S.lda, ldb = S.ldb;
    unsigned voffA[2], voffB[2];
#pragma unroll
    for (int i = 0; i < 2; ++i) { int R, C; stage_rc(tid * 16 + i * 8192, R, C); const int Rb = Epi::PERM ? ((R >> 5) * 64 + perm32(R & 31)) : R;
        voffA[i] = (unsigned)(R * lda + C) * 2u; voffB[i] = (unsigned)(Rb * ldb + C) * 2u; }
    const size_t kstep = (size_t)(BK * 2);
    const size_t hstepA = (size_t)HALF * lda * 2, hstepB = (size_t)(Epi::PERM ? 32 : HALF) * ldb * 2;
    const unsigned ldsw = (unsigned)wid * 1024u;
    const int aoff = lds_byte(wr * 64 + fr, fq * 8), boff = lds_byte(wc * 32 + fr, fq * 8);
#define PG8_SA(b, h) (((b) * 2 + (h)) * HTB)
#define PG8_SB(b, h) ((4 + (b) * 2 + (h)) * HTB)
#define PG8_STAGE(bufoff, gbase, voff) do { _Pragma("unroll") for (int _i = 0; _i < 2; ++_i) \
        __builtin_amdgcn_global_load_lds((const unsigned*)((const char*)(gbase) + (voff)[_i]), (LAS unsigned*)(lds + (bufoff) + ldsw + _i * 8192), 16, 0, 0); } while (0)
#define PG8_LDA(dst, b, h) do { _Pragma("unroll") for (int m = 0; m < 4; ++m) _Pragma("unroll") for (int k = 0; k < 2; ++k) dst[m][k] = *(const LAS bf16x8*)(lds + PG8_SA(b, h) + aoff + m * 2048 + k * 1024); } while (0)
#define PG8_LDB(dst, b, h) do { _Pragma("unroll") for (int n = 0; n < 2; ++n) _Pragma("unroll") for (int k = 0; k < 2; ++k) dst[n][k] = *(const LAS bf16x8*)(lds + PG8_SB(b, h) + boff + n * 2048 + k * 1024); } while (0)
#define PG8_MMA(ai, bj, At, Bt) do { __builtin_amdgcn_s_setprio(1); _Pragma("unroll") for (int m = 0; m < 4; ++m) _Pragma("unroll") for (int n = 0; n < 2; ++n) _Pragma("unroll") for (int k = 0; k < 2; ++k) \
        acc[ai][bj][m][n] = __builtin_amdgcn_mfma_f32_16x16x32_bf16(Bt[n][k], At[m][k], acc[ai][bj][m][n], 0, 0, 0); __builtin_amdgcn_s_setprio(0); } while (0)
#define PG8_WAIT_V(n) asm volatile("s_waitcnt vmcnt(" #n ")" ::: "memory")
#define PG8_WAIT_L(n) asm volatile("s_waitcnt lgkmcnt(" #n ")" ::: "memory")
#define PG8_BAR __builtin_amdgcn_s_barrier()
#define PG8_SCHED __builtin_amdgcn_sched_barrier(0)
    Unit cur, nxt; int ui = 0;
    if (!S.next(0, cur)) return;
    if (STAGGER_US > 0) {
        const unsigned grp = ((unsigned)lwg() >> 3) & 1u;
        if (grp) { const unsigned long long t0 = __builtin_amdgcn_s_memrealtime(); while (__builtin_amdgcn_s_memrealtime() - t0 < (unsigned long long)(STAGGER_US * 100)) __builtin_amdgcn_s_sleep(4); }
    }
    f32x4 acc[2][2][4][2];
#pragma unroll
    for (int a = 0; a < 2; ++a)
#pragma unroll
        for (int b = 0; b < 2; ++b)
#pragma unroll
            for (int m = 0; m < 4; ++m)
#pragma unroll
                for (int n = 0; n < 2; ++n) acc[a][b][m][n] = (f32x4){0.f, 0.f, 0.f, 0.f};
    bf16x8 At[4][2], B0[2][2], B1[2][2];
    const char* cA = S.a_ptr(cur); const char* cB = S.b_ptr(cur);
    PG8_STAGE(PG8_SB(0, 0), cB, voffB); PG8_STAGE(PG8_SA(0, 0), cA, voffA); PG8_STAGE(PG8_SB(0, 1), cB + hstepB, voffB); PG8_STAGE(PG8_SA(0, 1), cA + hstepA, voffA);
    if (wr == 1) PG8_BAR;
    PG8_WAIT_V(4); PG8_BAR;
    PG8_STAGE(PG8_SB(1, 0), cB + kstep, voffB); PG8_STAGE(PG8_SA(1, 0), cA + kstep, voffA); PG8_STAGE(PG8_SB(1, 1), cB + hstepB + kstep, voffB);
    PG8_WAIT_V(6); PG8_BAR;
    for (;;) {
        const bool has_next = S.next(ui + 1, nxt);
        const char* nA = has_next ? S.a_ptr(nxt) : cA; const char* nB = has_next ? S.b_ptr(nxt) : cB;
        for (int t = 0; t < nt; t += 2) {
            if constexpr (Epi::HAS_MID) { if (t == 8 || t == 16) E.mid(acc, cur, t >> 3, wr, wc, fr, fq); }
            const bool last = (t == nt - 2);
            const char* a1 = cA + (size_t)(t + 1) * kstep;
            const char* a2 = last ? nA : cA + (size_t)(t + 2) * kstep; const char* b2 = last ? nB : cB + (size_t)(t + 2) * kstep;
            const char* a3 = a2 + kstep; const char* b3 = b2 + kstep;
            PG8_LDB(B0, 0, 0); PG8_SCHED; PG8_LDA(At, 0, 0); PG8_STAGE(PG8_SA(1, 1), a1 + hstepA, voffA);
            PG8_WAIT_L(8); PG8_BAR; PG8_WAIT_L(0); PG8_MMA(0, 0, At, B0); PG8_BAR; PG8_SCHED;
            PG8_LDB(B1, 0, 1); PG8_STAGE(PG8_SB(0, 0), b2, voffB);
            PG8_BAR; PG8_WAIT_L(0); PG8_MMA(0, 1, At, B1); PG8_BAR;
            if constexpr (!Epi::HALFM) { PG8_LDA(At, 0, 1); } PG8_STAGE(PG8_SA(0, 0), a2, voffA);
            PG8_BAR; PG8_WAIT_L(0); if constexpr (!Epi::HALFM) { PG8_MMA(1, 0, At, B0); } PG8_BAR; PG8_SCHED;
            PG8_STAGE(PG8_SB(0, 1), b2 + hstepB, voffB);
            PG8_WAIT_V(6); PG8_BAR; if constexpr (!Epi::HALFM) { PG8_MMA(1, 1, At, B1); } PG8_BAR;
            PG8_LDB(B0, 1, 0); PG8_SCHED; PG8_LDA(At, 1, 0); PG8_STAGE(PG8_SA(0, 1), a2 + hstepA, voffA);
            PG8_WAIT_L(8); PG8_BAR; PG8_WAIT_L(0); PG8_MMA(0, 0, At, B0); PG8_BAR; PG8_SCHED;
            PG8_LDB(B1, 1, 1); PG8_STAGE(PG8_SB(1, 0), b3, voffB);
            PG8_BAR; PG8_WAIT_L(0); PG8_MMA(0, 1, At, B1); PG8_BAR;
            if constexpr (!Epi::HALFM) { PG8_LDA(At, 1, 1); } PG8_STAGE(PG8_SA(1, 0), a3, voffA);
            PG8_BAR; PG8_WAIT_L(0); if constexpr (!Epi::HALFM) { PG8_MMA(1, 0, At, B0); } PG8_BAR; PG8_SCHED;
            PG8_STAGE(PG8_SB(1, 1), b3 + hstepB, voffB);
            PG8_WAIT_V(6); PG8_BAR; if constexpr (!Epi::HALFM) { PG8_MMA(1, 1, At, B1); } PG8_BAR;
        }
        E(acc, cur, wr, wc, fr, fq);
        if (!has_next) break;
#pragma unroll
        for (int a = 0; a < 2; ++a)
#pragma unroll
            for (int b = 0; b < 2; ++b)
#pragma unroll
                for (int m = 0; m < 4; ++m)
#pragma unroll
                    for (int n = 0; n < 2; ++n) acc[a][b][m][n] = (f32x4){0.f, 0.f, 0.f, 0.f};
        cur = nxt; cA = nA; cB = nB; ++ui;
    }
    PG8_WAIT_V(0);
    if (wr == 0) PG8_BAR;
    PG8_BAR;
#undef PG8_SA
#undef PG8_SB
#undef PG8_STAGE
#undef PG8_LDA
#undef PG8_LDB
#undef PG8_MMA
#undef PG8_WAIT_V
#undef PG8_WAIT_L
#undef PG8_BAR
#undef PG8_SCHED
}

__device__ __forceinline__ void mods_phase(const P& p, float* MOD, float* ldsf) {
    const int tid = ltid(), wid = tid >> 6, lane = tid & 63;
    float* sc = ldsf;
    float* red = ldsf + 9 * 1024;
    for (int i = tid; i < 9 * 1024; i += 512) { const int j = i >> 10, k = i & 1023; const float v = j == 0 ? p.in[4][k] : p.in[3][(j - 1) * 1024 + k]; sc[i] = siluf_(v); }
    __syncthreads();
    for (int item = lwg(); item < 384; item += lnwg()) {
        const int l = item / 96, col0 = (item % 96) * 64;
        const float* w = p.in[19] + (size_t)l * 1024 * 6144 + col0 + lane;
        float a[9];
#pragma unroll
        for (int j = 0; j < 9; ++j) a[j] = 0.f;
        const int kb = wid * 128;
#pragma unroll 8
        for (int k = 0; k < 128; ++k) { const float wv = w[(size_t)(kb + k) * 6144];
#pragma unroll
            for (int j = 0; j < 9; ++j) a[j] += sc[j * 1024 + kb + k] * wv; }
#pragma unroll
        for (int j = 0; j < 9; ++j) red[(wid * 9 + j) * 64 + lane] = a[j];
        __syncthreads();
        for (int i = tid; i < 576; i += 512) { const int j = i >> 6, ln = i & 63; float s = p.in[20][l * 6144 + col0 + ln];
#pragma unroll
            for (int w8 = 0; w8 < 8; ++w8) s += red[(w8 * 9 + j) * 64 + ln];
            MOD[(size_t)(l * 9 + j) * 6144 + col0 + ln] = s; }
        __syncthreads();
    }
}

__device__ __forceinline__ void dft_phase(bf16_t* DL, bf16_t* DC) {
    const size_t gt = (size_t)lwg() * 512 + ltid(), gn = (size_t)lnwg() * 512;
    for (size_t i = gt; i < 2048ull * 2048 / 8; i += gn) { const int k = (int)(i / 256), kk0 = (int)(i % 256) * 8; float f[8];
#pragma unroll
        for (int j = 0; j < 8; ++j) { const int kk = kk0 + j; const bool cs = kk <= 1024; const int t = cs ? kk : kk - 1024; const int m = (k * t) & 2047; const float x = (float)m * (1.0f / 1024.0f);
            f[j] = (cs ? cospif(x) : -sinpif(x)) * (1.0f / 512.0f); }
        *(u32x4*)(DL + i * 8) = pack8(f); }
    for (size_t i = gt; i < 256ull * 512 / 8; i += gn) { const int k = (int)(i / 64), t0 = (int)(i % 64) * 8; float f[8];
#pragma unroll
        for (int j = 0; j < 8; ++j) { const int tt = t0 + j, t = tt & 255; const int m = (k * t) & 255; const float x = (float)m * (1.0f / 128.0f);
            f[j] = (tt < 256 ? cospif(x) : -sinpif(x)) * 0.005524271728019903f; }
        *(u32x4*)(DC + i * 8) = pack8(f); }
}

__device__ __forceinline__ void tconv_tile(const float* src, int ld_src, bf16_t* dst, int ld_dst, int k0, int n0, float scale, float* tl) {
    const int tid = ltid();
    f32x4 v[8];
#pragma unroll
    for (int ps = 0; ps < 8; ++ps) v[ps] = *(const f32x4*)(src + (size_t)(k0 + ps * 16 + (tid >> 5)) * ld_src + n0 + (tid & 31) * 4);
#pragma unroll
    for (int ps = 0; ps < 8; ++ps) { float* q = tl + (ps * 16 + (tid >> 5)) * 129 + (tid & 31) * 4; q[0] = v[ps][0]; q[1] = v[ps][1]; q[2] = v[ps][2]; q[3] = v[ps][3]; }
    LDS_BARRIER();
    { const int n = tid >> 2, kq = tid & 3; bf16_t* q = dst + (size_t)(n0 + n) * ld_dst + k0 + kq * 32;
#pragma unroll
      for (int c = 0; c < 4; ++c) { float f[8];
#pragma unroll
          for (int j = 0; j < 8; ++j) f[j] = tl[(kq * 32 + c * 8 + j) * 129 + n] * scale;
          *(u32x4*)(q + c * 8) = pack8(f); } }
    LDS_BARRIER();
}

__device__ __forceinline__ void wfft_item(int item, const float* win, bf16_t* W1T, float* tl) {
    const int tid = ltid(), kb = item >> 2, g = item & 3;
    float* xin = tl;
    float* ct = tl + 2048;
    { const int r = tid >> 5, c4 = (tid & 31) * 4; const f32x4 v = *(const f32x4*)(win + (size_t)(kb * 16 + r) * 7712 + g * 128 + c4); *(f32x4*)(xin + r * 128 + c4) = v; }
    if (tid < 128) { ct[tid] = cospif((float)tid * (1.0f / 64.0f)); ct[128 + tid] = sinpif((float)tid * (1.0f / 64.0f)); }
    LDS_BARRIER();
    { const int jj = tid & 255, cs = jj >> 7, j = jj & 127, half = tid >> 8; float a[8];
#pragma unroll
      for (int r = 0; r < 8; ++r) a[r] = 0.f;
      const float* tb = ct + cs * 128; const float* xr = xin + half * 8 * 128;
      for (int c = 0; c < 128; ++c) { const float w = tb[(j * c) & 127];
#pragma unroll
          for (int r = 0; r < 8; ++r) a[r] += xr[r * 128 + c] * w; }
      *(u32x4*)(W1T + (size_t)(cs * 512 + g * 128 + j) * 1024 + kb * 16 + half * 8) = pack8(a); }
    LDS_BARRIER();
}

__device__ __forceinline__ void wconv_phase(const P& p, int set, int l, float* tl, int wi, int nw, int lo = 0, int hi = 1 << 30) {
    bf16_t* W1T = (bf16_t*)(p.ws + WS_W1T); bf16_t* WMT = (bf16_t*)(p.ws + WS_WMT); bf16_t* WOT = (bf16_t*)(p.ws + WS_WOT);
    bf16_t* WUPT = (bf16_t*)(p.ws + WS_WUPT); bf16_t* WDNT = (bf16_t*)(p.ws + WS_WDNT);
    const float* win = p.in[5] + (size_t)l * 1024 * 7712;
    if (set == 0) {
        for (int it = lo + wi; it < (hi < 705 ? hi : 705); it += nw) {
            if (it < 256) wfft_item(it, win, W1T, tl);
            else if (it < 512) { const int j = it - 256, tk = j & 7, tn = j >> 3; const int n0 = tn * 128;
                tconv_tile(win + 512, 7712, W1T + (size_t)1024 * 1024, 1024, tk * 128, n0, (n0 >= 1024 && n0 < 1536) ? 0.08838834764831845f : 1.0f, tl); }
            else if (it < 704) { const int j = it - 512, tk = j & 7, tn = j >> 3;
                tconv_tile(win + 4640, 7712, W1T + (size_t)5120 * 1024, 1024, tk * 128, tn * 128, 1.0f, tl); }
            else { for (int i = ltid(); i < 256 * 1024; i += 512) { const int n = i >> 10, k = i & 1023;
                    W1T[(size_t)(8192 + n) * 1024 + k] = n < 32 ? f2bf(win[(size_t)k * 7712 + 4608 + n]) : (bf16_t)0; } }
        }
    } else if (set == 1) {
        for (int it = lo + wi; it < (hi < 192 ? hi : 192); it += nw) {
            if (it < 32) { const int tk = it & 3, tn = it >> 2; tconv_tile(p.in[7] + (size_t)l * 512 * 1024, 1024, WMT, 2048, tk * 128, tn * 128, 1.0f, tl); }
            else if (it < 64) { const int j = it - 32, tk = j & 3, tn = j >> 2; tconv_tile(p.in[11] + (size_t)l * 512 * 1024, 1024, WMT + 512, 2048, tk * 128, tn * 128, 1.0f, tl); }
            else if (it < 128) { const int j = it - 64, tk = j & 7, tn = j >> 3; tconv_tile(p.in[15] + (size_t)l * 1024 * 1024, 1024, WMT + 1024, 2048, tk * 128, tn * 128, 1.0f, tl); }
            else { const int j = it - 128, tk = j & 7, tn = j >> 3; tconv_tile(p.in[16] + (size_t)l * 1024 * 1024, 1024, WOT, 1024, tk * 128, tn * 128, 1.0f, tl); }
        }
    } else {
        for (int it = lo + wi; it < (hi < 528 ? hi : 528); it += nw) {
            if (it < 352) { const int tk = it & 7, tn = it >> 3; tconv_tile(p.in[21] + (size_t)l * 1024 * 5632, 5632, WUPT, 1024, tk * 128, tn * 128, 1.0f, tl); }
            else { const int j = it - 352, tn = j & 7, tk = j >> 3; tconv_tile(p.in[24] + (size_t)l * DFF * 1024, 1024, WDNT, DFF, tk * 128, tn * 128, 1.0f, tl); }
        }
    }
}

__device__ __forceinline__ void ln_phase(const float* src_ctx, const float* src_lat, float* xout, const float* g, const float* b, bool doLN,
                                         bool doH, const float* modl, int sci, int shi, bf16_t* H, const bf16_t* tsrc = nullptr) {
    const int lane = ltid() & 63, gw = lwg() * 8 + (ltid() >> 6), nw = lnwg() * 8;
    const int per = (NTOK + nw - 1) / nw, rbeg = gw * per, rend = (rbeg + per < NTOK) ? rbeg + per : NTOK;
    f32x4 gg[4], bb[4], scv[4], shv[4]; int cur = -1;
#pragma unroll
    for (int i = 0; i < 4; ++i) { gg[i] = doLN ? *(const f32x4*)(g + i * 256 + lane * 4) : (f32x4){1.f, 1.f, 1.f, 1.f}; bb[i] = doLN ? *(const f32x4*)(b + i * 256 + lane * 4) : (f32x4){0.f, 0.f, 0.f, 0.f};
        scv[i] = (f32x4){0.f, 0.f, 0.f, 0.f}; shv[i] = (f32x4){0.f, 0.f, 0.f, 0.f}; }
    auto body = [&](int row, f32x4 (&v)[4]) {
        if (doLN) {
            float s = 0.f;
#pragma unroll
            for (int i = 0; i < 4; ++i) s += (v[i][0] + v[i][1]) + (v[i][2] + v[i][3]);
            const float mean = wave_sum(s) * (1.0f / 1024.0f); float q = 0.f;
#pragma unroll
            for (int i = 0; i < 4; ++i) { const f32x4 d = v[i] - mean; q += (d[0] * d[0] + d[1] * d[1]) + (d[2] * d[2] + d[3] * d[3]); }
            const float rstd = rsqrtf(wave_sum(q) * (1.0f / 1024.0f) + 1e-5f);
#pragma unroll
            for (int i = 0; i < 4; ++i) { v[i] = (v[i] - mean) * rstd * gg[i] + bb[i]; *(f32x4*)(xout + (size_t)row * 1024 + i * 256 + lane * 4) = v[i]; }
        }
        if (doH) {
            const int cond = row < NCTX ? 0 : 1 + ((row - NCTX) >> 11);
            if (cond != cur) { cur = cond; const float* mp = modl + (size_t)cond * 6144;
#pragma unroll
                for (int i = 0; i < 4; ++i) { scv[i] = *(const f32x4*)(mp + sci * 1024 + i * 256 + lane * 4); shv[i] = *(const f32x4*)(mp + shi * 1024 + i * 256 + lane * 4); } }
            float s = 0.f;
#pragma unroll
            for (int i = 0; i < 4; ++i) s += (v[i][0] + v[i][1]) + (v[i][2] + v[i][3]);
            const float mean = wave_sum(s) * (1.0f / 1024.0f); float q = 0.f;
#pragma unroll
            for (int i = 0; i < 4; ++i) { const f32x4 d = v[i] - mean; q += (d[0] * d[0] + d[1] * d[1]) + (d[2] * d[2] + d[3] * d[3]); }
            const float rstd = rsqrtf(wave_sum(q) * (1.0f / 1024.0f) + 1e-5f);
#pragma unroll
            for (int i = 0; i < 4; ++i) { const f32x4 h = (v[i] - mean) * rstd * (1.0f + scv[i]) + shv[i];
                u32x2 w; w.x = cvt_pk_bf16(h[0], h[1]); w.y = cvt_pk_bf16(h[2], h[3]);
                *(u32x2*)(H + (size_t)row * 1024 + i * 256 + lane * 4) = w; }
        }
    };
    for (int row = rbeg; row < rend; row += 2) {
        const int row2 = row + 1; const bool has2 = row2 < rend;
        const int r2 = has2 ? row2 : row;
        f32x4 v[4], u[4];
        if (tsrc != nullptr) {
            u32x2 a[4], c[4];
#pragma unroll
            for (int i = 0; i < 4; ++i) { a[i] = *(const u32x2*)(tsrc + (size_t)row * 1024 + i * 256 + lane * 4); c[i] = *(const u32x2*)(tsrc + (size_t)r2 * 1024 + i * 256 + lane * 4); }
#pragma unroll
            for (int i = 0; i < 4; ++i) { v[i] = (f32x4){bf2f(a[i].x & 0xffffu), bf2f(a[i].x >> 16), bf2f(a[i].y & 0xffffu), bf2f(a[i].y >> 16)};
                u[i] = (f32x4){bf2f(c[i].x & 0xffffu), bf2f(c[i].x >> 16), bf2f(c[i].y & 0xffffu), bf2f(c[i].y >> 16)}; }
        } else {
            const float* src = row < NCTX ? src_ctx + (size_t)row * 1024 : src_lat + (size_t)(row - NCTX) * 1024;
            const float* src2 = r2 < NCTX ? src_ctx + (size_t)r2 * 1024 : src_lat + (size_t)(r2 - NCTX) * 1024;
#pragma unroll
            for (int i = 0; i < 4; ++i) { v[i] = *(const f32x4*)(src + i * 256 + lane * 4); u[i] = *(const f32x4*)(src2 + i * 256 + lane * 4); } }
        body(row, v);
        if (has2) body(row2, u);
    }
}

__device__ __forceinline__ void glapost_phase(bf16_t* AM, const bf16_t* OB, const bf16_t* Z, const float* ng) {
    const int lane = ltid() & 63, gw = lwg() * 8 + (ltid() >> 6), nw = lnwg() * 8;
    float gn[16];
#pragma unroll
    for (int j = 0; j < 16; ++j) gn[j] = ng[(lane & 15) * 16 + j];
    for (int row = gw; row < NTOK; row += nw) {
        bf16_t* op = AM + (size_t)row * 2048 + 1024 + lane * 16;
        const bf16_t* bp = OB + (size_t)row * 1024 + lane * 16;
        const bf16_t* rp = Z + (size_t)row * ZLD + ZR + lane * 16;
        float a[16], bq[16], r[16];
        { float t[8]; unpack8(*(const u32x4*)op, t);
#pragma unroll
          for (int j = 0; j < 8; ++j) a[j] = t[j];
          unpack8(*(const u32x4*)(op + 8), t);
#pragma unroll
          for (int j = 0; j < 8; ++j) a[8 + j] = t[j];
          unpack8(*(const u32x4*)bp, t);
#pragma unroll
          for (int j = 0; j < 8; ++j) bq[j] = t[j];
          unpack8(*(const u32x4*)(bp + 8), t);
#pragma unroll
          for (int j = 0; j < 8; ++j) bq[8 + j] = t[j];
          unpack8(*(const u32x4*)rp, t);
#pragma unroll
          for (int j = 0; j < 8; ++j) r[j] = t[j];
          unpack8(*(const u32x4*)(rp + 8), t);
#pragma unroll
          for (int j = 0; j < 8; ++j) r[8 + j] = t[j]; }
        float ss = 0.f;
#pragma unroll
        for (int j = 0; j < 16; ++j) { a[j] += bq[j]; ss += a[j] * a[j]; }
        ss += __shfl_xor(ss, 1); ss += __shfl_xor(ss, 2); ss += __shfl_xor(ss, 4); ss += __shfl_xor(ss, 8);
        const float rs = rsqrtf(ss * (1.0f / 256.0f) + 1e-5f);
        float o0[8], o1[8];
#pragma unroll
        for (int j = 0; j < 8; ++j) { o0[j] = a[j] * rs * gn[j] * r[j]; o1[j] = a[8 + j] * rs * gn[8 + j] * r[8 + j]; }
        *(u32x4*)op = pack8(o0); *(u32x4*)(op + 8) = pack8(o1);
    }
}

__device__ __forceinline__ void conv_phase(const bf16_t* AG, bf16_t* FF, const float* wdw, const float* bdw) {
    for (int wi = lwg(); wi < 220; wi += lnwg()) {
        const int rg = wi / 11, cg = wi - rg * 11;
        const int run = rg * 16 + (ltid() >> 5), cb = cg * 32 + (ltid() & 31), ch = cb * 8;
        const bool lat = run >= 64;
        const int tok0 = lat ? NCTX + (run - 64) * 64 : run * 64;
        const int gy = (run - 64) & 31;
        const bool up = lat && gy > 0, dn = lat && gy < 31;
        const int xlo = lat ? 0 : -(tok0 & 255), xhi = lat ? 63 : 255 - (tok0 & 255);
        f32x2 w[9][4], bias[4];
#pragma unroll
        for (int t = 0; t < 9; ++t) { const f32x4 a = *(const f32x4*)(wdw + t * DFF + ch), b = *(const f32x4*)(wdw + t * DFF + ch + 4);
            w[t][0] = (f32x2){a[0], a[1]}; w[t][1] = (f32x2){a[2], a[3]}; w[t][2] = (f32x2){b[0], b[1]}; w[t][3] = (f32x2){b[2], b[3]}; }
        { const f32x4 a = *(const f32x4*)(bdw + ch), b = *(const f32x4*)(bdw + ch + 4);
          bias[0] = (f32x2){a[0], a[1]}; bias[1] = (f32x2){a[2], a[3]}; bias[2] = (f32x2){b[0], b[1]}; bias[3] = (f32x2){b[2], b[3]}; }
        const bf16_t* base = AG + (size_t)tok0 * 5632 + ch;
        const u32x4 zero4 = {0u, 0u, 0u, 0u};
        f32x2 cA[3][4], cB[3][4], cC[3][4]; u32x4 nx[3], ny[3], gnx;
#define CONV_LOADCOL(dst, x) do { const bool okx = (x) >= xlo && (x) <= xhi; const bf16_t* q_ = base + (ptrdiff_t)(x) * 5632; \
            dst[0] = (okx && up) ? *(const u32x4*)(q_ - 64 * 5632) : zero4; dst[1] = okx ? *(const u32x4*)q_ : zero4; dst[2] = (okx && dn) ? *(const u32x4*)(q_ + 64 * 5632) : zero4; } while (0)
#define CONV_UNPACK(dst, src) do { _Pragma("unroll") for (int dy_ = 0; dy_ < 3; ++dy_) { const u32x4 s_ = src[dy_]; \
            dst[dy_][0] = (f32x2){bf2f(s_.x & 0xffffu), bf2f(s_.x >> 16)}; dst[dy_][1] = (f32x2){bf2f(s_.y & 0xffffu), bf2f(s_.y >> 16)}; \
            dst[dy_][2] = (f32x2){bf2f(s_.z & 0xffffu), bf2f(s_.z >> 16)}; dst[dy_][3] = (f32x2){bf2f(s_.w & 0xffffu), bf2f(s_.w >> 16)}; } } while (0)
#define CONV_STEP(c0, c1, c2, x) do { \
            const u32x4 gw_ = gnx; gnx = *(const u32x4*)(base + (size_t)((x) + 1 < 64 ? (x) + 1 : 63) * 5632 + DFF); \
            f32x2 acc_[4]; _Pragma("unroll") for (int j_ = 0; j_ < 4; ++j_) acc_[j_] = bias[j_]; \
            _Pragma("unroll") for (int dy_ = 0; dy_ < 3; ++dy_) _Pragma("unroll") for (int j_ = 0; j_ < 4; ++j_) { \
                acc_[j_] += c0[dy_][j_] * w[dy_ * 3 + 0][j_]; acc_[j_] += c1[dy_][j_] * w[dy_ * 3 + 1][j_]; acc_[j_] += c2[dy_][j_] * w[dy_ * 3 + 2][j_]; } \
            float g_[8], o_[8]; unpack8(gw_, g_); \
            _Pragma("unroll") for (int j_ = 0; j_ < 4; ++j_) { o_[2 * j_] = geluf_(acc_[j_][0]) * g_[2 * j_]; o_[2 * j_ + 1] = geluf_(acc_[j_][1]) * g_[2 * j_ + 1]; } \
            *(u32x4*)(FF + (size_t)(tok0 + (x)) * DFF + ch) = pack8(o_); \
            CONV_UNPACK(c0, nx); nx[0] = ny[0]; nx[1] = ny[1]; nx[2] = ny[2]; CONV_LOADCOL(ny, (x) + 4); } while (0)
        CONV_LOADCOL(nx, -1); CONV_UNPACK(cA, nx); CONV_LOADCOL(nx, 0); CONV_UNPACK(cB, nx); CONV_LOADCOL(nx, 1); CONV_UNPACK(cC, nx); CONV_LOADCOL(nx, 2); CONV_LOADCOL(ny, 3);
        gnx = *(const u32x4*)(base + DFF);
#pragma unroll 1
        for (int x = 0; x < 63; x += 3) { CONV_STEP(cA, cB, cC, x); CONV_STEP(cB, cC, cA, x + 1); CONV_STEP(cC, cA, cB, x + 2); }
        CONV_STEP(cA, cB, cC, 63);
#undef CONV_STEP
#undef CONV_UNPACK
#undef CONV_LOADCOL
    }
}

__device__ __forceinline__ void sgu_item(int item, int l, const P& p, const bf16_t* Z, bf16_t* AM, LAS unsigned char* lds) {
    const int tid = ltid(), wid = tid >> 6, lane = tid & 63, fr = lane & 15, fq = lane >> 4;
    LAS float* STAT = (LAS float*)lds;
    LAS bf16_t* VT = (LAS bf16_t*)(lds + 1024);
    const int row0 = item * 128;
    u32x4 vrow[16];
#pragma unroll
    for (int i = 0; i < 16; ++i) vrow[i] = *(const u32x4*)(Z + (size_t)(row0 + wid * 16 + i) * ZLD + ZV + lane * 8);
#pragma unroll
    for (int i = 0; i < 16; ++i) { const int q = wid * 16 + i; float f[8]; unpack8(vrow[i], f);
        float s = 0.f;
#pragma unroll
        for (int j = 0; j < 8; ++j) s += f[j];
        const float mean = wave_sum(s) * (1.0f / 512.0f); float qq = 0.f;
#pragma unroll
        for (int j = 0; j < 8; ++j) { const float d = f[j] - mean; qq += d * d; }
        const float rstd = rsqrtf(wave_sum(qq) * (1.0f / 512.0f) + 1e-5f);
        if (lane == 0) { STAT[q * 2] = mean; STAT[q * 2 + 1] = rstd; } }
    LDS_BARRIER();
    for (int g = 0; g < 4; ++g) {
        { const int q = tid >> 2, seg = tid & 3; const float mean = STAT[q * 2], rstd = STAT[q * 2 + 1];
#pragma unroll
          for (int j4 = 0; j4 < 4; ++j4) { const int c0 = seg * 32 + j4 * 8; float f[8]; unpack8(*(const u32x4*)(Z + (size_t)(row0 + q) * ZLD + ZV + g * 128 + c0), f);
              const float* sg = p.in[8] + l * 512 + g * 128 + c0;
#pragma unroll
              for (int j = 0; j < 8; ++j) VT[(c0 + j) * 136 + q] = f2bf((f[j] - mean) * rstd * sg[j]); } }
        LDS_BARRIER();
        bf16x8 Yf[4];
        { const float* wp = p.in[9] + ((size_t)(l * 4 + g) * 128 + wid * 16 + fr) * 128 + 8 * fq;
#pragma unroll
          for (int kk = 0; kk < 4; ++kk) { const f32x4 a = *(const f32x4*)(wp + kk * 32), b = *(const f32x4*)(wp + kk * 32 + 4);
              u32x4 w; w.x = cvt_pk_bf16(a[0], a[1]); w.y = cvt_pk_bf16(a[2], a[3]); w.z = cvt_pk_bf16(b[0], b[1]); w.w = cvt_pk_bf16(b[2], b[3]);
              Yf[kk] = __builtin_bit_cast(bf16x8, w); } }
        const int pp = wid * 16 + fr; const size_t tok = (size_t)(row0 + pp);
        const float bias = p.in[10][(l * 4 + g) * 128 + pp];
#pragma unroll
        for (int ct = 0; ct < 8; ++ct) { f32x4 acc = {0.f, 0.f, 0.f, 0.f};
#pragma unroll
            for (int kk = 0; kk < 4; ++kk) { const bf16x8 X = *(const LAS bf16x8*)(VT + (ct * 16 + fr) * 136 + kk * 32 + 8 * fq);
                acc = __builtin_amdgcn_mfma_f32_16x16x32_bf16(X, Yf[kk], acc, 0, 0, 0); }
            const int c = ct * 16 + 4 * fq;
            const u32x2 uw = *(const u32x2*)(Z + tok * ZLD + ZU + g * 128 + c);
            const float u0 = bf2f(uw.x & 0xffffu), u1 = bf2f(uw.x >> 16), u2 = bf2f(uw.y & 0xffffu), u3 = bf2f(uw.y >> 16);
            u32x2 ow; ow.x = cvt_pk_bf16(u0 * (acc[0] + bias), u1 * (acc[1] + bias)); ow.y = cvt_pk_bf16(u2 * (acc[2] + bias), u3 * (acc[3] + bias));
            *(u32x2*)(AM + tok * 2048 + 512 + g * 128 + c) = ow; }
        LDS_BARRIER();
    }
}

__device__ __forceinline__ void glapre_item(int item, int l, const P& p, const bf16_t* Z, const float* LR, bf16_t* AM, bf16_t* HB, float* ETOT, LAS unsigned char* lds) {
    const int tid = ltid();
    LAS float* LRS = (LAS float*)lds;
    LAS float* GT = (LAS float*)(lds + 8192);
    const int c = item >> 2, h = item & 3, row0 = c * 64;
    const int kc = tid & 127, lg = tid >> 7;
    { const int li = tid >> 3, part = tid & 7; *(LAS f32x4*)(LRS + li * 32 + part * 4) = *(const f32x4*)(LR + (size_t)(row0 + li) * 32 + part * 4); }
    float w0[16], w1[16];
#pragma unroll
    for (int r = 0; r < 16; ++r) { w0[r] = p.in[12][((size_t)(l * 2 + 0) * 16 + r) * 512 + h * 128 + kc]; w1[r] = p.in[12][((size_t)(l * 2 + 1) * 16 + r) * 512 + h * 128 + kc]; }
    const float b0 = p.in[13][(l * 2 + 0) * 512 + h * 128 + kc], b1 = p.in[13][(l * 2 + 1) * 512 + h * 128 + kc];
    float qv[16], kv[16];
#pragma unroll
    for (int i = 0; i < 16; ++i) { const bf16_t* zr = Z + (size_t)(row0 + lg * 16 + i) * ZLD + h * 128 + kc; qv[i] = bf2f(zr[ZQ]); kv[i] = bf2f(zr[ZK]); }
    __syncthreads();
    float G0[16], G1[16];
#pragma unroll
    for (int i = 0; i < 16; ++i) { const LAS float* lr = LRS + (lg * 16 + i) * 32; float z0 = b0, z1 = b1;
#pragma unroll
        for (int r4 = 0; r4 < 4; ++r4) { const f32x4 a = *(const LAS f32x4*)(lr + r4 * 4), b = *(const LAS f32x4*)(lr + 16 + r4 * 4);
#pragma unroll
            for (int r = 0; r < 4; ++r) { z0 += a[r] * w0[r4 * 4 + r]; z1 += b[r] * w1[r4 * 4 + r]; } }
        G0[i] = (fminf(z0, 0.f) - __logf(1.0f + __expf(-fabsf(z0)))) * (1.0f / 16.0f);
        G1[i] = (fminf(z1, 0.f) - __logf(1.0f + __expf(-fabsf(z1)))) * (1.0f / 16.0f); }
#pragma unroll
    for (int i = 1; i < 16; ++i) G0[i] += G0[i - 1];
#pragma unroll
    for (int i = 14; i >= 0; --i) G1[i] += G1[i + 1];
    GT[lg * 128 + kc] = G0[15]; GT[512 + lg * 128 + kc] = G1[0];
    LDS_BARRIER();
    float pre0 = 0.f, pre1 = 0.f, tot0 = 0.f, tot1 = 0.f;
#pragma unroll
    for (int g4 = 0; g4 < 4; ++g4) { const float t0 = GT[g4 * 128 + kc], t1 = GT[512 + g4 * 128 + kc]; tot0 += t0; tot1 += t1; if (g4 < lg) pre0 += t0; if (g4 > lg) pre1 += t1; }
    if (lg == 0) { ETOT[((size_t)item * 2 + 0) * 128 + kc] = __expf(tot0); ETOT[((size_t)item * 2 + 1) * 128 + kc] = __expf(tot1); }
#pragma unroll
    for (int i = 0; i < 16; ++i) { const size_t row = (size_t)(row0 + lg * 16 + i);
        const float e0 = __expf(pre0 + G0[i]), e1 = __expf(pre1 + G1[i]);
        bf16_t* a = AM + row * 2048 + 1024 + h * 256 + kc; bf16_t* b = HB + row * 1024 + h * 256 + kc;
        a[0] = f2bf(qv[i] * e0); a[128] = f2bf(kv[i] * __builtin_amdgcn_rcpf(e0));
        b[0] = f2bf(qv[i] * e1); b[128] = f2bf(kv[i] * __builtin_amdgcn_rcpf(e1)); }
    LDS_BARRIER();
}

typedef float f32x16 __attribute__((ext_vector_type(16)));
__device__ __forceinline__ int crow32(int reg, int h) { return (reg & 3) + 8 * (reg >> 2) + 4 * h; }
__device__ __forceinline__ void gla_item(int item, int l, const P& p, const bf16_t* Z, const float* ETOT, bf16_t* AM, bf16_t* HB, LAS unsigned char* lds) {
    const int tid = ltid(), wid = tid >> 6, lane = tid & 63, r32 = lane & 31, hh = lane >> 5;
    LAS bf16_t* QG  = (LAS bf16_t*)lds;
    LAS bf16_t* KG  = (LAS bf16_t*)(lds + 17408);
    LAS bf16_t* KGT = (LAS bf16_t*)(lds + 34816);
    LAS bf16_t* VT  = (LAS bf16_t*)(lds + 53248);
    LAS bf16_t* AB  = (LAS bf16_t*)(lds + 90112);
    LAS float*  ET  = (LAS float*)(lds + 99328);
    LAS bf16_t* OST = (LAS bf16_t*)(lds + 99840);
    int b, h, dir, T, seq0; const bool lat = item < 64;
    { const int idx = lat ? item : item - 64; dir = idx & 1; h = (idx >> 1) & 3; b = idx >> 3; }
    if (lat) { T = 2048; seq0 = NCTX + b * 2048; } else { T = 256; seq0 = b * 256; }
    f32x16 S[4];
    if (lat) { const float* sp = p.in[2] + ((size_t)((b * 4 + l) * 2 + dir) * 4 + h) * 128 * 256 + 32 * wid + r32;
#pragma unroll
        for (int kt = 0; kt < 4; ++kt)
#pragma unroll
            for (int reg = 0; reg < 16; ++reg) S[kt][reg] = sp[(size_t)(32 * kt + crow32(reg, hh)) * 256]; }
    else {
#pragma unroll
        for (int kt = 0; kt < 4; ++kt)
#pragma unroll
            for (int reg = 0; reg < 16; ++reg) S[kt][reg] = 0.f; }
    bf16_t* gbuf = dir ? HB : AM + 1024; const int ldg = dir ? 1024 : 2048;
    const int nch = T / 64;
    u32x4 pg[4], pv[4]; f32x4 pe = {0.f, 0.f, 0.f, 0.f};
#define GLA_TOK(pos) (seq0 + (dir ? T - 1 - (pos) : (pos)))
#define GLA_ISSUE(n_) do { const int pos0_ = (n_) * 64; const int li_ = tid >> 3, seg_ = tid & 7; const int tok_ = GLA_TOK(pos0_ + li_); \
        const bf16_t* gp_ = gbuf + (size_t)tok_ * ldg + h * 256 + seg_ * 32; const bf16_t* vp_ = Z + (size_t)tok_ * ZLD + ZVV + h * 256 + seg_ * 32; \
        _Pragma("unroll") for (int j_ = 0; j_ < 4; ++j_) { pg[j_] = *(const u32x4*)(gp_ + j_ * 8); pv[j_] = *(const u32x4*)(vp_ + j_ * 8); } \
        if (tid < 32) { const int ck_ = GLA_TOK(pos0_) >> 6; pe = *(const f32x4*)(ETOT + ((size_t)(ck_ * 4 + h) * 2 + dir) * 128 + tid * 4); } } while (0)
#define MFMA32(a_, b_, c_) __builtin_amdgcn_mfma_f32_32x32x16_bf16((a_), (b_), (c_), 0, 0, 0)
#define GLA_FLUSH(n_) do { const int li_ = tid >> 3, seg_ = tid & 7; bf16_t* op_ = gbuf + (size_t)GLA_TOK((n_) * 64 + li_) * ldg + h * 256 + seg_ * 32; \
        const LAS bf16_t* sp_ = OST + li_ * 264 + seg_ * 32; _Pragma("unroll") for (int j_ = 0; j_ < 4; ++j_) *(u32x4*)(op_ + j_ * 8) = *(const LAS u32x4*)(sp_ + j_ * 8); } while (0)
    GLA_ISSUE(0);
    for (int n = 0; n < nch; ++n) {
        const int pos0 = n * 64;
        if (n > 0) GLA_FLUSH(n - 1);
        { const int li = tid >> 3, seg = tid & 7;
          LAS bf16_t* gq = (seg < 4 ? QG : KG) + li * 136 + (seg & 3) * 32;
#pragma unroll
          for (int j = 0; j < 4; ++j) *(LAS u32x4*)(gq + j * 8) = pg[j];
          if (seg >= 4) { LAS bf16_t* q = KGT + ((seg - 4) * 32) * 72 + ((li + 8 * (seg - 4)) & 63);
#pragma unroll
              for (int j = 0; j < 4; ++j) { const u32x4 w = pg[j]; LAS bf16_t* qq = q + j * 8 * 72;
                  qq[0] = (bf16_t)(w.x & 0xffffu); qq[72] = (bf16_t)(w.x >> 16); qq[144] = (bf16_t)(w.y & 0xffffu); qq[216] = (bf16_t)(w.y >> 16);
                  qq[288] = (bf16_t)(w.z & 0xffffu); qq[360] = (bf16_t)(w.z >> 16); qq[432] = (bf16_t)(w.w & 0xffffu); qq[504] = (bf16_t)(w.w >> 16); } }
          LAS bf16_t* q = VT + (seg * 32) * 72 + ((li + 8 * seg) & 63);
#pragma unroll
          for (int j = 0; j < 4; ++j) { const u32x4 w = pv[j]; LAS bf16_t* qq = q + j * 8 * 72;
              qq[0] = (bf16_t)(w.x & 0xffffu); qq[72] = (bf16_t)(w.x >> 16); qq[144] = (bf16_t)(w.y & 0xffffu); qq[216] = (bf16_t)(w.y >> 16);
              qq[288] = (bf16_t)(w.z & 0xffffu); qq[360] = (bf16_t)(w.z >> 16); qq[432] = (bf16_t)(w.w & 0xffffu); qq[504] = (bf16_t)(w.w >> 16); } }
        if (tid < 32) *(LAS f32x4*)(ET + tid * 4) = pe;
        LDS_BARRIER();
        if (n + 1 < nch) GLA_ISSUE(n + 1);
        if (wid < 4) { const int lt = (wid == 1 || wid == 2) ? 1 : 0, mt = (wid == 2 || wid == 3) ? 1 : 0;
            f32x16 acc;
#pragma unroll
            for (int reg = 0; reg < 16; ++reg) acc[reg] = 0.f;
            if (wid < 3) {
#pragma unroll
                for (int s = 0; s < 8; ++s) { const bf16x8 A = *(const LAS bf16x8*)(KG + (32 * mt + r32) * 136 + 16 * s + 8 * hh), B = *(const LAS bf16x8*)(QG + (32 * lt + r32) * 136 + 16 * s + 8 * hh);
                    acc = MFMA32(A, B, acc); } }
            const int li = 32 * lt + r32;
#pragma unroll
            for (int g = 0; g < 4; ++g) { const int m0 = 32 * mt + 8 * g + 4 * hh;
                u32x2 w; w.x = cvt_pk_bf16(m0 <= li ? acc[4 * g] : 0.f, m0 + 1 <= li ? acc[4 * g + 1] : 0.f); w.y = cvt_pk_bf16(m0 + 2 <= li ? acc[4 * g + 2] : 0.f, m0 + 3 <= li ? acc[4 * g + 3] : 0.f);
                *(LAS u32x2*)(AB + li * 72 + m0) = w; } }
        LDS_BARRIER();
        bf16x8 VTf[4];
#pragma unroll
        for (int s = 0; s < 4; ++s) VTf[s] = *(const LAS bf16x8*)(VT + (32 * wid + r32) * 72 + ((16 * s + 8 * hh + 8 * wid) & 63));
#pragma unroll
        for (int lt = 0; lt < 2; ++lt) { f32x16 acc;
#pragma unroll
            for (int reg = 0; reg < 16; ++reg) acc[reg] = 0.f;
#pragma unroll
            for (int s = 0; s < 4; ++s) { const bf16x8 B = *(const LAS bf16x8*)(AB + (32 * lt + r32) * 72 + 16 * s + 8 * hh); acc = MFMA32(VTf[s], B, acc); }
#pragma unroll
            for (int kt = 0; kt < 4; ++kt)
#pragma unroll
                for (int s = 0; s < 2; ++s) {
                    u32x4 pa; pa.x = cvt_pk_bf16(S[kt][8 * s], S[kt][8 * s + 1]); pa.y = cvt_pk_bf16(S[kt][8 * s + 2], S[kt][8 * s + 3]);
                    pa.z = cvt_pk_bf16(S[kt][8 * s + 4], S[kt][8 * s + 5]); pa.w = cvt_pk_bf16(S[kt][8 * s + 6], S[kt][8 * s + 7]);
                    const LAS bf16_t* qp = QG + (32 * lt + r32) * 136 + 32 * kt + 16 * s + 4 * hh;
                    const u32x2 lo = *(const LAS u32x2*)qp, hi = *(const LAS u32x2*)(qp + 8);
                    u32x4 pb; pb.x = lo.x; pb.y = lo.y; pb.z = hi.x; pb.w = hi.y;
                    acc = MFMA32(__builtin_bit_cast(bf16x8, pa), __builtin_bit_cast(bf16x8, pb), acc); }
            LAS bf16_t* orow = OST + (32 * lt + r32) * 264 + 32 * wid + 4 * hh;
#pragma unroll
            for (int g = 0; g < 4; ++g) { u32x2 w; w.x = cvt_pk_bf16(acc[4 * g], acc[4 * g + 1]); w.y = cvt_pk_bf16(acc[4 * g + 2], acc[4 * g + 3]);
                *(LAS u32x2*)(orow + 8 * g) = w; } }
#pragma unroll
        for (int kt = 0; kt < 4; ++kt) { f32x16 acc = S[kt];
#pragma unroll
            for (int s = 0; s < 4; ++s) { const bf16x8 A = *(const LAS bf16x8*)(KGT + (32 * kt + r32) * 72 + ((16 * s + 8 * hh + 8 * kt) & 63)); acc = MFMA32(A, VTf[s], acc); }
#pragma unroll
            for (int g = 0; g < 4; ++g) { const f32x4 e4 = *(const LAS f32x4*)(ET + 32 * kt + 8 * g + 4 * hh);
#pragma unroll
                for (int q = 0; q < 4; ++q) acc[4 * g + q] *= e4[q]; }
            S[kt] = acc; }
        LDS_BARRIER();
    }
    GLA_FLUSH(nch - 1);
    LDS_BARRIER();
#undef GLA_FLUSH
#undef MFMA32
#undef GLA_ISSUE
#undef GLA_TOK
    if (!lat) { float* sp = p.out + (size_t)NTOK * 1024 + ((size_t)((b * 4 + l) * 2 + dir) * 4 + h) * 128 * 256 + 32 * wid + r32;
#pragma unroll
        for (int kt = 0; kt < 4; ++kt)
#pragma unroll
            for (int reg = 0; reg < 16; ++reg) sp[(size_t)(32 * kt + crow32(reg, hh)) * 256] = S[kt][reg]; }
}


__device__ __forceinline__ void fold_item(int item, const bf16_t* XTl, bf16_t* XF, LAS unsigned char* lds) {
    const int tid = ltid(); LAS bf16_t* R = (LAS bf16_t*)lds;
    const size_t r0 = (size_t)item * 4;
#pragma unroll
    for (int rr = 0; rr < 4; ++rr) *(LAS u32x4*)(R + rr * 4096 + tid * 8) = *(const u32x4*)(XTl + (r0 + rr) * 4096 + tid * 8);
    LDS_BARRIER();
#pragma unroll
    for (int rr = 0; rr < 4; ++rr) { const LAS bf16_t* row = R + rr * 4096; float f[4];
#pragma unroll
        for (int i = 0; i < 4; ++i) { const int kk = tid * 4 + i;
            if (kk <= 1024) { f[i] = bf2f(row[kk]); if (kk >= 1 && kk <= 1023) f[i] += bf2f(row[2048 - kk]); }
            else { const int t = kk - 1024; f[i] = bf2f(row[2048 + t]) - bf2f(row[4096 - t]); } }
        u32x2 w; w.x = cvt_pk_bf16(f[0], f[1]); w.y = cvt_pk_bf16(f[2], f[3]);
        *(u32x2*)(XF + (r0 + rr) * 2048 + tid * 4) = w; }
    LDS_BARRIER();
}

#define XB_TMO      128
#define XB_XCNT(j)  (256  + 64 * (j))
#define XB_XSUB(j)  (1280 + 64 * (j))
#define XB_XGEN(j)  (2304 + 64 * (j))
#define XB_TOP      3328
#define XB_TOPGEN   3392
#define XCD_BAR_WORDS 3456
#define XB_SPIN_CAP (1u << 18)
__device__ __forceinline__ unsigned xb_ld(unsigned* p)              { return __hip_atomic_load(p, __ATOMIC_RELAXED, __HIP_MEMORY_SCOPE_AGENT); }
__device__ __forceinline__ unsigned xb_add(unsigned* p, unsigned v) { return __hip_atomic_fetch_add(p, v, __ATOMIC_RELAXED, __HIP_MEMORY_SCOPE_AGENT); }
__device__ __forceinline__ unsigned xb_xcc_id() { return (unsigned)__builtin_amdgcn_s_getreg((3 << 11) | 20) & 0xFu; }
#define XB_SPIN(cond, bar) do { unsigned _sp = 0; while (cond) { __builtin_amdgcn_s_sleep(1); \
    if ((++_sp & 255u) == 0u) { if (xb_ld(&(bar)[XB_TMO])) break; if (_sp > XB_SPIN_CAP) { atomicAdd(&(bar)[XB_TMO], 1u); break; } } } } while (0)
struct XcdBarrier { unsigned* bar; unsigned x; volatile LAS unsigned* st; };
__device__ __forceinline__ XcdBarrier xcd_barrier_post(unsigned* bar, volatile LAS unsigned* st) {
    XcdBarrier b; b.bar = bar; b.x = xb_xcc_id(); b.st = st;
    if (threadIdx.x == 0) (void)xb_add(&bar[XB_XCNT(b.x)], 1u);
    return b;
}
__device__ __forceinline__ void xcd_barrier_complete(unsigned* bar, unsigned x, unsigned& nloc, unsigned& nx) {
    const unsigned G = gridDim.x * gridDim.y * gridDim.z;
    unsigned sum, cnt, mine, sp = 0u;
    for (;;) {
        sum = 0u; cnt = 0u; mine = 0u;
#pragma unroll
        for (unsigned j = 0; j < 16; ++j) { const unsigned c = xb_ld(&bar[XB_XCNT(j)]); sum += c; cnt += (c > 0u) ? 1u : 0u; mine = (j == x) ? c : mine; }
        if (sum == G) break;
        __builtin_amdgcn_s_sleep(1);
        if ((++sp & 255u) == 0u) { if (xb_ld(&bar[XB_TMO])) break; if (sp > XB_SPIN_CAP) { atomicAdd(&bar[XB_TMO], 1u); break; } }
    }
    nloc = mine > 0u ? mine : 1u; nx = cnt > 0u ? cnt : 1u;
}
__device__ __forceinline__ void xcd_barrier(const XcdBarrier& b) {
    asm volatile("s_waitcnt vmcnt(0)" ::: "memory");
    __syncthreads();
    if (threadIdx.x == 0) {
        unsigned* bar = b.bar;
        __builtin_amdgcn_s_waitcnt(0);
        unsigned nloc = b.st[0], nx = b.st[1];
        if (nloc == 0u) { xcd_barrier_complete(bar, b.x, nloc, nx); b.st[0] = nloc; b.st[1] = nx; }
        const unsigned old = xb_add(&bar[XB_XSUB(b.x)], 1u);
        const unsigned gen = old / nloc;
        if (old + 1u == (gen + 1u) * nloc) {
            __builtin_amdgcn_fence(__ATOMIC_RELEASE, "agent");
            asm volatile("s_waitcnt vmcnt(0)" ::: "memory");
            const unsigned og = xb_add(&bar[XB_TOP], 1u);
            const unsigned tg = og / nx;
            if (og + 1u == (tg + 1u) * nx) xb_add(&bar[XB_TOPGEN], 1u);
            else XB_SPIN(xb_ld(&bar[XB_TOPGEN]) == tg, bar);
            __builtin_amdgcn_fence(__ATOMIC_ACQUIRE, "agent");
            xb_add(&bar[XB_XGEN(b.x)], 1u);
            asm volatile("s_waitcnt vmcnt(0)" ::: "memory");
        } else {
            XB_SPIN(xb_ld(&bar[XB_XGEN(b.x)]) == gen, bar);
            __builtin_amdgcn_fence(__ATOMIC_ACQUIRE, "agent");
            asm volatile("s_waitcnt vmcnt(0)" ::: "memory");
        }
    }
    __syncthreads();
}

template <int PH>
__device__ __forceinline__ void run_phase(const P& p, int l, unsigned char* shm) {
    LAS unsigned char* lds = (LAS unsigned char*)shm;
    const int wg = lwg(), nwg = lnwg();
    size_t wso = 0; asm volatile("" : "+s"(wso)); unsigned char* wsb = p.ws + wso;
    float* MOD = (float*)(wsb + WS_MOD);
    bf16_t* DLAT = (bf16_t*)(wsb + WS_DLAT); bf16_t* DCTX = (bf16_t*)(wsb + WS_DCTX);
    bf16_t* W1T = (bf16_t*)(wsb + WS_W1T); bf16_t* WMT = (bf16_t*)(wsb + WS_WMT); bf16_t* WOT = (bf16_t*)(wsb + WS_WOT);
    bf16_t* WUPT = (bf16_t*)(wsb + WS_WUPT); bf16_t* WDNT = (bf16_t*)(wsb + WS_WDNT);
    bf16_t* H = (bf16_t*)(wsb + WS_H); bf16_t* XTc = (bf16_t*)(wsb + WS_XT); bf16_t* XTl = (bf16_t*)(wsb + WS_XTL); bf16_t* Mb = (bf16_t*)(wsb + WS_XT);
    bf16_t* Z = (bf16_t*)(wsb + WS_Z); float* LR = (float*)(wsb + WS_LR); bf16_t* AM = (bf16_t*)(wsb + WS_AM); float* ETOT = (float*)(wsb + WS_ETOT); bf16_t* XF = (bf16_t*)(wsb + WS_XF);
    bf16_t* AG = (bf16_t*)(wsb + WS_AG); bf16_t* FF = (bf16_t*)(wsb + WS_FF);
    float* X = p.out;
    const float* modl = MOD + (size_t)l * 9 * 6144;
    if constexpr (PH == 0) {
        mods_phase(p, MOD, (float*)shm);
        dft_phase(DLAT, DCTX);
        wconv_phase(p, 0, 0, (float*)shm, wg, nwg);
        wconv_phase(p, 1, 0, (float*)shm, wg, nwg);
    } else if constexpr (PH == 1) {
        ln_phase(p.in[0], p.in[1], nullptr, nullptr, nullptr, false, true, MOD, 1, 0, H);
    } else if constexpr (PH == 2) {
        const int full = (80 * 33 / nwg) * nwg;
        { SchedLim S{H, W1T, 1024, 1024, 1024, 80, 33, nwg, wg, full}; EpiIn E{Z, XTc, XTl, LR, p.in[6] + l * 3072}; gemm_phase(lds, S, E); }
        { SchedRestM S{H, W1T, 1024, 1024, 1024, 80, 33, nwg, wg, full}; EpiInT<true> E{Z, XTc, XTl, LR, p.in[6] + l * 3072}; gemm_phase(lds, S, E); }
    } else if constexpr (PH == 3) {
        for (int it = wg; it < 1280; it += nwg) glapre_item(it, l, p, Z, LR, AM, H, ETOT, lds);
        for (int it = wg; it < 1024; it += nwg) fold_item(it, XTl, XF, lds);
    } else if constexpr (PH == 4) {
        if (wg < NFFT_WG) { SchedFftL S{DLAT, XF, 2048, 2048, 2048, NFFT_WG, wg}; EpiBf16 E{AM, 2048}; gemm_phase(lds, S, E); }
        else if (wg < NFFT_WG + 64) gla_item(wg - NFFT_WG, l, p, Z, ETOT, AM, H, lds);
        unsigned* qhead = (unsigned*)(wsb + WS_BAR) + 3584 + 64 * l;
        volatile LAS unsigned* qw = (volatile LAS unsigned*)(lds + 151040 + 16);
        for (;;) {
            __syncthreads();
            if (ltid() == 0) qw[0] = __hip_atomic_fetch_add(qhead, 1u, __ATOMIC_RELAXED, __HIP_MEMORY_SCOPE_AGENT);
            __syncthreads();
            const int qi = __builtin_amdgcn_readfirstlane((int)qw[0]);
            if (qi >= 320) break;
            if (qi < 32) { SchedFftC S{DCTX, XTc, 512, 512, 512, 1 << 20, qi}; EpiBf16 E{AM, 2048}; gemm_phase(lds, S, E); }
            else if (qi < 160) gla_item(64 + (qi - 32), l, p, Z, ETOT, AM, H, lds);
            else sgu_item(qi - 160, l, p, Z, AM, lds);
        }
    } else if constexpr (PH == 5) {
        glapost_phase(AM, H, Z, p.in[14] + l * 256);
    } else if constexpr (PH == 6) {
        { SchedStd S{AM, WMT, 2048, 2048, 2048, 64, 4, nwg, wg}; EpiMerge E{Mb, Z}; gemm_phase(lds, S, E); }
        { SchedTailM S{AM, WMT, 2048, 2048, 2048, nwg, wg}; EpiMergeT<true> E{Mb, Z}; gemm_phase(lds, S, E); }
        if (wg >= 128) wconv_phase(p, 2, l, (float*)shm, wg - 128, nwg - 128);
    } else if constexpr (PH == 7) {
        const float* xc = l == 0 ? p.in[0] : X; const float* xl = l == 0 ? p.in[1] : X + (size_t)NCTX * 1024;
        { SchedStd S{Mb, WOT, 1024, 1024, 1024, 64, 4, nwg, wg}; EpiResid E{xc, xl, (bf16_t*)(wsb + WS_Z), modl + 2 * 1024}; gemm_phase(lds, S, E); }
        { SchedTailM S{Mb, WOT, 1024, 1024, 1024, nwg, wg}; EpiResidT<true> E{xc, xl, (bf16_t*)(wsb + WS_Z), modl + 2 * 1024}; gemm_phase(lds, S, E); }
        if (wg >= 128 && l + 1 < DEPTH) wconv_phase(p, 1, l + 1, (float*)shm, wg - 128, nwg - 128, 0, 128);
    } else if constexpr (PH == 8) {
        ln_phase(X, X + (size_t)NCTX * 1024, X, p.in[17] + l * 1024, p.in[18] + l * 1024, true, true, modl, 4, 3, H, (const bf16_t*)(wsb + WS_Z));
    } else if constexpr (PH == 9) {
        SchedStd S{H, WUPT, 1024, 1024, 1024, 80, 22, nwg, wg}; EpiBf16 E{AG, 5632}; gemm_phase(lds, S, E);
    } else if constexpr (PH == 10) {
        conv_phase(AG, FF, p.in[22] + (size_t)l * 9 * DFF, p.in[23] + l * DFF);
    } else if constexpr (PH == 11) {
        { SchedStd S{FF, WDNT, DFF, DFF, DFF, 64, 4, nwg, wg}; EpiResid E{X, X + (size_t)NCTX * 1024, (bf16_t*)(wsb + WS_Z), modl + 5 * 1024}; gemm_phase(lds, S, E); }
        { SchedTailM S{FF, WDNT, DFF, DFF, DFF, nwg, wg}; EpiResidT<true> E{X, X + (size_t)NCTX * 1024, (bf16_t*)(wsb + WS_Z), modl + 5 * 1024}; gemm_phase(lds, S, E); }
        if (wg >= 128 && l + 1 < DEPTH) { wconv_phase(p, 1, l + 1, (float*)shm, wg - 128, nwg - 128, 128, 192); wconv_phase(p, 0, l + 1, (float*)shm, wg - 128, nwg - 128); }
    } else if constexpr (PH == 12) {
        ln_phase(X, X + (size_t)NCTX * 1024, X, p.in[25] + l * 1024, p.in[26] + l * 1024, true, l + 1 < DEPTH, modl + 9 * 6144, 1, 0, H, (const bf16_t*)(wsb + WS_Z));
    }
}

#ifndef MULTI
#define MULTI 0
#endif

#if MULTI
template <int PH> __global__ void __launch_bounds__(512) k_phase(P p, int l) {
    extern __shared__ __attribute__((aligned(16))) unsigned char shm[];
    run_phase<PH>(p, l, shm);
}
template <int PH> static void launch_phase(const P& p, int l, int grid, hipStream_t stream) {
    static bool attr = false;
    if (!attr) { (void)hipFuncSetAttribute((const void*)k_phase<PH>, hipFuncAttributeMaxDynamicSharedMemorySize, LDS_BYTES); attr = true; }
    hipLaunchKernelGGL((k_phase<PH>), dim3(grid), dim3(512), LDS_BYTES, stream, p, l);
}
#else
#ifndef REPEAT_PH
#define REPEAT_PH 0
#endif
#ifndef STOP_PH
#define STOP_PH 99
#endif
__device__ __forceinline__ void dump_phase(const P& p, int which) {
    size_t wso = 0; asm volatile("" : "+s"(wso)); unsigned char* wsb = p.ws + wso;
    const size_t gt = (size_t)lwg() * 512 + ltid(), gn = (size_t)lnwg() * 512;
    const bf16_t* AM = (const bf16_t*)(wsb + WS_AM); const bf16_t* Z = (const bf16_t*)(wsb + WS_Z); const bf16_t* Mb = (const bf16_t*)(wsb + WS_XT);
    const bf16_t* H = (const bf16_t*)(wsb + WS_H); const float* LR = (const float*)(wsb + WS_LR);
    for (size_t i = gt; i < (size_t)NTOK * 1024; i += gn) { const size_t row = i >> 10, c = i & 1023; float v = 0.f;
        if (which == 0) v = bf2f(AM[row * 2048 + c]) + bf2f(AM[row * 2048 + 1024 + c]);
        else if (which == 1) { for (int j = 0; j < 7; ++j) v += bf2f(Z[row * ZLD + j * 1024 + c]); v += LR[row * 32 + (c & 31)] + bf2f(Mb[i]); }
        else if (which == 2) v = bf2f(Mb[i]);
        else if (which == 3) v = bf2f(H[i]);
        else if (which == 4) { const bf16_t* AG = (const bf16_t*)(wsb + WS_AG); for (int j = 0; j < 5; ++j) v += bf2f(AG[row * 5632 + j * 1024 + c]); }
        else if (which == 5) { const bf16_t* FF = (const bf16_t*)(wsb + WS_FF); v = bf2f(FF[row * DFF + c]) + bf2f(FF[row * DFF + 1024 + c]); }
        p.out[i] = v; }
}
__global__ void __launch_bounds__(512) fwd_megakernel(P p) {
    extern __shared__ __attribute__((aligned(16))) unsigned char shm[];
    cg::grid_group grid = cg::this_grid();
    volatile LAS unsigned* stw = (volatile LAS unsigned*)((LAS unsigned char*)shm + 151040);
    if (threadIdx.x == 0) { stw[0] = 0u; stw[1] = 0u; }
    __syncthreads();
    const XcdBarrier xb = xcd_barrier_post((unsigned*)(p.ws + WS_BAR), stw);
    run_phase<0>(p, 0, shm); grid.sync();
    run_phase<1>(p, 0, shm); xcd_barrier(xb);
#pragma unroll 1
    for (int l = 0; l < DEPTH; ++l) {
        run_phase<2>(p, l, shm); xcd_barrier(xb);
        if (STOP_PH == 2) { dump_phase(p, 1); return; }
#if REPEAT_PH == 2
        run_phase<2>(p, l, shm); xcd_barrier(xb);
#endif
        run_phase<3>(p, l, shm); xcd_barrier(xb);
        run_phase<4>(p, l, shm); xcd_barrier(xb);
#if REPEAT_PH == 34
        run_phase<3>(p, l, shm); xcd_barrier(xb);
        run_phase<4>(p, l, shm); xcd_barrier(xb);
#elif REPEAT_PH == 3
        run_phase<3>(p, l, shm); xcd_barrier(xb);
#elif REPEAT_PH == 4
        run_phase<4>(p, l, shm); xcd_barrier(xb);
#endif
        run_phase<5>(p, l, shm); xcd_barrier(xb);
        if (STOP_PH == 5) { dump_phase(p, 0); return; }
        run_phase<6>(p, l, shm); xcd_barrier(xb);
#if REPEAT_PH == 6
        run_phase<6>(p, l, shm); xcd_barrier(xb);
#endif
        if (STOP_PH == 6) { dump_phase(p, 2); return; }
        run_phase<7>(p, l, shm); xcd_barrier(xb);
        if (STOP_PH == 7) return;
        run_phase<8>(p, l, shm); xcd_barrier(xb);
        if (STOP_PH == 8) { xcd_barrier(xb); dump_phase(p, 3); return; }
        run_phase<9>(p, l, shm); xcd_barrier(xb);
        if (STOP_PH == 9) { dump_phase(p, 4); return; }
        run_phase<10>(p, l, shm); xcd_barrier(xb);
#if REPEAT_PH == 910
        run_phase<9>(p, l, shm); xcd_barrier(xb);
        run_phase<10>(p, l, shm); xcd_barrier(xb);
#elif REPEAT_PH == 10
        run_phase<10>(p, l, shm); xcd_barrier(xb);
#endif
        if (STOP_PH == 10) { dump_phase(p, 5); return; }
        run_phase<11>(p, l, shm); xcd_barrier(xb);
        if (STOP_PH == 11) return;
        run_phase<12>(p, l, shm); xcd_barrier(xb);
        if (STOP_PH == 12) return;
    }
}
#endif

extern "C" void kernel_launch(void* const* d_in, const int* in_sizes, int n_in, void* d_out, int out_size, void* d_ws, size_t ws_size, hipStream_t stream) {
    P p{};
    for (int i = 0; i < 27; ++i) p.in[i] = (const float*)d_in[i];
    p.out = (float*)d_out; p.ws = (unsigned char*)d_ws;
    if (ws_size < WS_END) { fprintf(stderr, "kernel_launch: workspace too small: %zu < %zu\n", ws_size, (size_t)WS_END); }
#if MULTI
    const int grid = 256;
    launch_phase<0>(p, 0, grid, stream);
    launch_phase<1>(p, 0, grid, stream);
    for (int l = 0; l < DEPTH; ++l) {
        launch_phase<2>(p, l, grid, stream);
        launch_phase<3>(p, l, grid, stream);
        launch_phase<4>(p, l, grid, stream);
        launch_phase<5>(p, l, grid, stream);
        launch_phase<6>(p, l, grid, stream);
        launch_phase<7>(p, l, grid, stream);
        launch_phase<8>(p, l, grid, stream);
        launch_phase<9>(p, l, grid, stream);
        launch_phase<10>(p, l, grid, stream);
        launch_phase<11>(p, l, grid, stream);
        launch_phase<12>(p, l, grid, stream);
    }
#else
    static int grid_blocks = 0;
    if (!grid_blocks) {
        int dev = 0, cus = 0, per_cu = 0;
        (void)hipGetDevice(&dev);
        (void)hipDeviceGetAttribute(&cus, hipDeviceAttributeMultiprocessorCount, dev);
        (void)hipFuncSetAttribute((const void*)fwd_megakernel, hipFuncAttributeMaxDynamicSharedMemorySize, LDS_BYTES);
        (void)hipOccupancyMaxActiveBlocksPerMultiprocessor(&per_cu, (const void*)fwd_megakernel, 512, LDS_BYTES);
        if (per_cu < 1) per_cu = 1;
        grid_blocks = cus * per_cu;
    }
    (void)hipMemsetAsync((char*)d_ws + WS_BAR, 0, 16384, stream);
    void* args[] = {&p};
    hipError_t e = hipLaunchCooperativeKernel((const void*)fwd_megakernel, dim3(grid_blocks), dim3(512), args, LDS_BYTES, stream);
    if (e != hipSuccess) fprintf(stderr, "cooperative launch failed: %s (grid %d)\n", hipGetErrorString(e), grid_blocks);
#endif
}
```

```cpp
#include <hip/hip_runtime.h>
#include <hip/hip_cooperative_groups.h>
#include <cstdio>
namespace cg = cooperative_groups;

#define LAS __attribute__((address_space(3)))
typedef unsigned short bf16_t;
typedef short bf16x8 __attribute__((ext_vector_type(8)));
typedef float f32x4 __attribute__((ext_vector_type(4)));
typedef float f32x2 __attribute__((ext_vector_type(2)));
typedef unsigned u32x4 __attribute__((ext_vector_type(4)));
typedef unsigned u32x2 __attribute__((ext_vector_type(2)));

constexpr int D = 1024, NTOK = 20480, NCTX = 4096, DEPTH = 4;
constexpr int ZLD = 7168;
constexpr int ZU = 0, ZV = 512, ZQ = 1024, ZK = 1536, ZVV = 2048, ZR = 3072, ZG = 4096;
constexpr int N1 = 8448;
constexpr int DFF = 2816;
constexpr int NFFT_WG = 128;

constexpr size_t WS_MOD  = 0;
constexpr size_t WS_DLAT = WS_MOD + 4ull * 9 * 6144 * 4;
constexpr size_t WS_DCTX = WS_DLAT + 2048ull * 2048 * 2;
constexpr size_t WS_W1T  = WS_DCTX + 256ull * 512 * 2;
constexpr size_t WS_WMT  = WS_W1T + (size_t)N1 * 1024 * 2;
constexpr size_t WS_WOT  = WS_WMT + 1024ull * 2048 * 2;
constexpr size_t WS_H    = WS_WOT + 1024ull * 1024 * 2;
constexpr size_t WS_XT   = WS_H + (size_t)NTOK * 1024 * 2;
constexpr size_t WS_XTL  = WS_XT + 16ull * 512 * 512 * 2;
constexpr size_t WS_Z    = WS_XT + (size_t)NTOK * 1024 * 2;
constexpr size_t WS_LR   = WS_Z + (size_t)NTOK * ZLD * 2;
constexpr size_t WS_AM   = WS_LR + (size_t)NTOK * 32 * 4;
constexpr size_t WS_BAR  = WS_AM + (size_t)NTOK * 2048 * 2;
constexpr size_t WS_ETOT = WS_BAR + 16384;
constexpr size_t WS_WUPT = WS_ETOT + 1280ull * 2 * 128 * 4;
constexpr size_t WS_WDNT = WS_WUPT + 5632ull * 1024 * 2;
constexpr size_t WS_XF   = WS_WDNT + 1024ull * 2816 * 2;
constexpr size_t WS_END  = WS_XF + 8ull * 512 * 2048 * 2;
constexpr size_t WS_AG   = WS_Z;
constexpr size_t WS_FF   = WS_Z + (size_t)NTOK * 5632 * 2;
static_assert(WS_FF + (size_t)NTOK * DFF * 2 <= WS_END, "ffn alias");

constexpr int LDS_BYTES = 151552;
#ifndef STAGGER_US
#define STAGGER_US 0
#endif

struct P {
    const float* in[27];
    float* out;
    unsigned char* ws;
};

#define LDS_BARRIER() do { asm volatile("s_waitcnt lgkmcnt(0)" ::: "memory"); __builtin_amdgcn_s_barrier(); asm volatile("" ::: "memory"); } while (0)
__device__ __forceinline__ int ltid() { int t = threadIdx.x; asm volatile("" : "+v"(t)); return t; }
__device__ __forceinline__ int lwg() { int b = blockIdx.x; asm volatile("" : "+s"(b)); return b; }
__device__ __forceinline__ int lnwg() { int b = gridDim.x; asm volatile("" : "+s"(b)); return b; }

__device__ __forceinline__ float bf2f(unsigned v) { return __uint_as_float(v << 16); }
typedef __bf16 bf2_t __attribute__((ext_vector_type(2)));
__device__ __forceinline__ unsigned cvt_pk_bf16(float lo, float hi) { const f32x2 v = {lo, hi}; const bf2_t b = __builtin_convertvector(v, bf2_t); return __builtin_bit_cast(unsigned, b); }
__device__ __forceinline__ bf16_t f2bf(float f) { return (bf16_t)(cvt_pk_bf16(f, 0.f) & 0xffffu); }
__device__ __forceinline__ float sigmoidf_(float x) { return __builtin_amdgcn_rcpf(1.0f + __expf(-x)); }
__device__ __forceinline__ float siluf_(float x) { return x * __builtin_amdgcn_rcpf(1.0f + __expf(-x)); }
__device__ __forceinline__ float geluf_(float x) { const float y = 1.5957691216057308f * (x + 0.044715f * x * x * x); return x * __builtin_amdgcn_rcpf(1.0f + __expf(-y)); }
__device__ __forceinline__ float wave_sum(float v) {
#pragma unroll
    for (int o = 32; o >= 1; o >>= 1) v += __shfl_xor(v, o);
    return v;
}
__device__ __forceinline__ void unpack8(const u32x4 w, float (&f)[8]) {
    f[0] = bf2f(w.x & 0xffffu); f[1] = bf2f(w.x >> 16); f[2] = bf2f(w.y & 0xffffu); f[3] = bf2f(w.y >> 16);
    f[4] = bf2f(w.z & 0xffffu); f[5] = bf2f(w.z >> 16); f[6] = bf2f(w.w & 0xffffu); f[7] = bf2f(w.w >> 16);
}
__device__ __forceinline__ u32x4 pack8(const float (&f)[8]) {
    u32x4 w; w.x = cvt_pk_bf16(f[0], f[1]); w.y = cvt_pk_bf16(f[2], f[3]); w.z = cvt_pk_bf16(f[4], f[5]); w.w = cvt_pk_bf16(f[6], f[7]); return w;
}

constexpr int BM = 256, BK = 64, HALF = 128, HTB = HALF * BK * 2;
__device__ __forceinline__ int lds_byte(int r, int c) { const int st = (r >> 4) * 2 + (c >> 5), rr = r & 15, cc = c & 31, ob = rr * 64 + cc * 2; return st * 1024 + (ob ^ (((ob >> 9) & 1) << 5)); }
__device__ __forceinline__ void stage_rc(int b, int& R, int& C) { const int st = b / 1024, sb = b % 1024, swz = sb ^ (((sb >> 9) & 1) << 5); R = (st >> 1) * 16 + swz / 64; C = (st & 1) * 32 + (swz % 64) / 2; }
__device__ __forceinline__ int perm32(int rho) { const int n = rho >> 4, i = rho & 15; return 8 * (i >> 2) + 4 * n + (i & 3); }

struct Unit { int pm, pn, aux; };

__device__ __forceinline__ void tile_map(int L, int nM, int nN, int& pm, int& pn) {
    const int nwg = nM * nN; int wgid = L;
    { const int q = nwg / 8, r = nwg % 8, xcd = wgid % 8, off = wgid / 8; wgid = (xcd < r ? xcd * (q + 1) : r * (q + 1) + (xcd - r) * q) + off; }
    const int nig = 8 * nN, gid = wgid / nig, fm = gid * 8, gsz = (nM - fm) < 8 ? (nM - fm) : 8;
    pm = fm + ((wgid % nig) % gsz); pn = (wgid % nig) / gsz;
}

struct SchedStd {
    const bf16_t* A; const bf16_t* Bt; int lda, ldb, K, nM, nN, G, c;
    __device__ __forceinline__ bool next(int i, Unit& u) const { const int L = i * G + c; if (L >= nM * nN) return false; tile_map(L, nM, nN, u.pm, u.pn); u.aux = 0; return true; }
    __device__ __forceinline__ const char* a_ptr(const Unit& u) const { return (const char*)A + (size_t)u.pm * 256 * lda * 2; }
    __device__ __forceinline__ const char* b_ptr(const Unit& u) const { return (const char*)Bt + (size_t)u.pn * 256 * ldb * 2; }
};
struct SchedMerge {
    const bf16_t* A; const bf16_t* Bt; int lda, ldb, K, G, c;
    __device__ __forceinline__ bool next(int i, Unit& u) const { const int L = (i >> 2) * G + c; if (L >= 320) return false; tile_map(L, 80, 4, u.pm, u.pn); u.aux = i & 3; return true; }
    __device__ __forceinline__ const char* a_ptr(const Unit& u) const { return (const char*)A + ((size_t)u.pm * 256 * lda + u.aux * 512) * 2; }
    __device__ __forceinline__ const char* b_ptr(const Unit& u) const { return (const char*)Bt + ((size_t)u.pn * 256 * ldb + u.aux * 512) * 2; }
};
struct SchedLim {
    const bf16_t* A; const bf16_t* Bt; int lda, ldb, K, nM, nN, G, c, limit;
    __device__ __forceinline__ bool next(int i, Unit& u) const { const int L = i * G + c; if (L >= limit) return false; tile_map(L, nM, nN, u.pm, u.pn); u.aux = 0; return true; }
    __device__ __forceinline__ const char* a_ptr(const Unit& u) const { return (const char*)A + (size_t)u.pm * 256 * lda * 2; }
    __device__ __forceinline__ const char* b_ptr(const Unit& u) const { return (const char*)Bt + (size_t)u.pn * 256 * ldb * 2; }
};
struct SchedRestM {
    const bf16_t* A; const bf16_t* Bt; int lda, ldb, K, nM, nN, G, c, first;
    __device__ __forceinline__ bool next(int i, Unit& u) const { const int q = i * G + c; const int L = first + (q >> 1); if (L >= nM * nN) return false; tile_map(L, nM, nN, u.pm, u.pn); u.aux = q & 1; return true; }
    __device__ __forceinline__ const char* a_ptr(const Unit& u) const { return (const char*)A + ((size_t)u.pm * 256 + (size_t)u.aux * 128) * lda * 2; }
    __device__ __forceinline__ const char* b_ptr(const Unit& u) const { return (const char*)Bt + (size_t)u.pn * 256 * ldb * 2; }
};
struct SchedTailM {
    const bf16_t* A; const bf16_t* Bt; int lda, ldb, K, G, c;
    __device__ __forceinline__ bool next(int i, Unit& u) const { const int L = i * G + c; if (L >= 128) return false; const int tt = L >> 1; u.pm = 64 + (tt >> 2); u.pn = tt & 3; u.aux = L & 1; return true; }
    __device__ __forceinline__ const char* a_ptr(const Unit& u) const { return (const char*)A + ((size_t)u.pm * 256 + (size_t)u.aux * 128) * lda * 2; }
    __device__ __forceinline__ const char* b_ptr(const Unit& u) const { return (const char*)Bt + (size_t)u.pn * 256 * ldb * 2; }
};
struct SchedFftL {
    const bf16_t* A; const bf16_t* Bt; int lda, ldb, K, G, c;
    __device__ __forceinline__ bool next(int i, Unit& u) const { const int L = i * G + c; if (L >= 128) return false; const int b = L >> 4, rem = L & 15; u.pm = 16 + b * 8 + (rem >> 1); u.pn = rem & 1; u.aux = b; return true; }
    __device__ __forceinline__ const char* a_ptr(const Unit& u) const { return (const char*)A + (size_t)((u.pm - 16) & 7) * 256 * 2048 * 2; }
    __device__ __forceinline__ const char* b_ptr(const Unit& u) const { return (const char*)Bt + ((size_t)u.aux * 512 + u.pn * 256) * 2048 * 2; }
};
struct SchedFftC {
    const bf16_t* A; const bf16_t* Bt; int lda, ldb, K, G, c;
    __device__ __forceinline__ bool next(int i, Unit& u) const { const int L = i * G + c; if (L >= 32) return false; u.pm = L >> 1; u.pn = L & 1; u.aux = 0; return true; }
    __device__ __forceinline__ const char* a_ptr(const Unit&) const { return (const char*)A; }
    __device__ __forceinline__ const char* b_ptr(const Unit& u) const { return (const char*)Bt + ((size_t)u.pm * 512 + u.pn * 256) * 512 * 2; }
};

template <bool HM> struct EpiInT {
    static constexpr bool PERM = true, HAS_MID = false, HALFM = HM;
    bf16_t* Z; bf16_t* XTc; bf16_t* XTl; float* LR; const float* bmerge;
    __device__ __forceinline__ void operator()(const f32x4 (&acc)[2][2][4][2], const Unit& u, int wr, int wc, int fr, int fq) const {
        const int pn = u.pn, cl = wc * 64 + 8 * fq;
        if (pn < 4) {
            bf16_t* base; int ldk, t0; const int cs = pn >> 1;
            if (u.pm < 16) { base = XTc + (size_t)u.pm * 512 * 512; ldk = 512; t0 = cs * 256; }
            else { const int b = (u.pm - 16) >> 3; base = XTl + (size_t)b * 512 * 4096; ldk = 4096; t0 = cs * 2048 + ((u.pm - 16) & 7) * 256; }
            t0 += (HM ? u.aux * 128 : 0) + wr * 64 + fr;
#pragma unroll
            for (int ai = 0; ai < (HM ? 1 : 2); ++ai)
#pragma unroll
                for (int m = 0; m < 4; ++m) { const int t = t0 + ai * 128 + m * 16;
#pragma unroll
                    for (int bj = 0; bj < 2; ++bj)
#pragma unroll
                        for (int n = 0; n < 2; ++n) { const int c = (pn & 1) * 256 + bj * 32 + cl + n * 4; const f32x4 v = acc[ai][bj][m][n];
                            const unsigned p0 = cvt_pk_bf16(v[0], v[1]), p1 = cvt_pk_bf16(v[2], v[3]);
                            bf16_t* q = base + (size_t)c * ldk + t;
                            q[0] = (bf16_t)(p0 & 0xffffu); q[ldk] = (bf16_t)(p0 >> 16); q[2 * ldk] = (bf16_t)(p1 & 0xffffu); q[3 * ldk] = (bf16_t)(p1 >> 16); } }
        } else if (pn < 32) {
            const int zc0 = (pn - 4) * 256 + cl;
            const int mode = pn < 8 ? 1 : (pn < 16 ? 0 : (pn < 20 ? 2 : 3));
            f32x4 bv[2][2];
#pragma unroll
            for (int bj = 0; bj < 2; ++bj)
#pragma unroll
                for (int n = 0; n < 2; ++n) bv[bj][n] = (mode == 3) ? *(const f32x4*)(bmerge + (zc0 - ZG) + bj * 32 + n * 4) : (f32x4){0.f, 0.f, 0.f, 0.f};
            const int row0 = u.pm * 256 + (HM ? u.aux * 128 : 0) + wr * 64 + fr;
#pragma unroll
            for (int ai = 0; ai < (HM ? 1 : 2); ++ai)
#pragma unroll
                for (int m = 0; m < 4; ++m) { bf16_t* rowp = Z + (size_t)(row0 + ai * 128 + m * 16) * ZLD + zc0;
#pragma unroll
                    for (int bj = 0; bj < 2; ++bj) { float f[8];
#pragma unroll
                        for (int j = 0; j < 4; ++j) { f[j] = acc[ai][bj][m][0][j] + bv[bj][0][j]; f[4 + j] = acc[ai][bj][m][1][j] + bv[bj][1][j]; }
                        if (mode == 1) {
#pragma unroll
                            for (int j = 0; j < 8; ++j) f[j] = geluf_(f[j]); }
                        else if (mode == 2) {
#pragma unroll
                            for (int j = 0; j < 8; ++j) f[j] = siluf_(f[j]); }
                        else if (mode == 3) {
#pragma unroll
                            for (int j = 0; j < 8; ++j) f[j] = sigmoidf_(f[j]); }
                        *(u32x4*)(rowp + bj * 32) = pack8(f); } }
        } else {
            if (wc == 0) { const int row0 = u.pm * 256 + (HM ? u.aux * 128 : 0) + wr * 64 + fr;
#pragma unroll
                for (int ai = 0; ai < (HM ? 1 : 2); ++ai)
#pragma unroll
                    for (int m = 0; m < 4; ++m) { float* q = LR + (size_t)(row0 + ai * 128 + m * 16) * 32 + 8 * fq;
                        *(f32x4*)q = acc[ai][0][m][0]; *(f32x4*)(q + 4) = acc[ai][0][m][1]; } }
        }
    }
};
typedef EpiInT<false> EpiIn;
struct EpiBf16 {
    static constexpr bool PERM = true, HAS_MID = false, HALFM = false;
    bf16_t* O; int ldc;
    __device__ __forceinline__ void operator()(const f32x4 (&acc)[2][2][4][2], const Unit& u, int wr, int wc, int fr, int fq) const {
        const int row0 = u.pm * 256 + wr * 64 + fr, col0 = u.pn * 256 + wc * 64 + 8 * fq;
#pragma unroll
        for (int ai = 0; ai < 2; ++ai)
#pragma unroll
            for (int m = 0; m < 4; ++m) { bf16_t* rowp = O + (size_t)(row0 + ai * 128 + m * 16) * ldc + col0;
#pragma unroll
                for (int bj = 0; bj < 2; ++bj) { const f32x4 v0 = acc[ai][bj][m][0], v1 = acc[ai][bj][m][1];
                    u32x4 w; w.x = cvt_pk_bf16(v0[0], v0[1]); w.y = cvt_pk_bf16(v0[2], v0[3]); w.z = cvt_pk_bf16(v1[0], v1[1]); w.w = cvt_pk_bf16(v1[2], v1[3]);
                    *(u32x4*)(rowp + bj * 32) = w; } }
    }
};
template <bool HM> struct EpiMergeT {
    static constexpr bool PERM = true, HAS_MID = true, HALFM = HM;
    bf16_t* Mo; const bf16_t* Z;
    __device__ __forceinline__ void mid(f32x4 (&acc)[2][2][4][2], const Unit& u, int seg, int wr, int wc, int fr, int fq) const {
        asm volatile("" : "+v"(fr), "+v"(fq));
        const int row0 = u.pm * 256 + (HM ? u.aux * 128 : 0) + wr * 64 + fr, col0 = u.pn * 256 + wc * 64 + 8 * fq;
        const bf16_t* zp = Z + ZG + (seg - 1) * 1024 + col0;
#pragma unroll
        for (int ai = 0; ai < (HM ? 1 : 2); ++ai)
#pragma unroll
            for (int m = 0; m < 4; ++m) { const bf16_t* rp = zp + (size_t)(row0 + ai * 128 + m * 16) * ZLD;
#pragma unroll
                for (int bj = 0; bj < 2; ++bj) { float gp[8], gn[8]; unpack8(*(const u32x4*)(rp + bj * 32), gp); unpack8(*(const u32x4*)(rp + 1024 + bj * 32), gn);
#pragma unroll
                    for (int j = 0; j < 4; ++j) { acc[ai][bj][m][0][j] *= fmaxf(gp[j], 1e-8f) * __builtin_amdgcn_rcpf(fmaxf(gn[j], 1e-8f));
                        acc[ai][bj][m][1][j] *= fmaxf(gp[4 + j], 1e-8f) * __builtin_amdgcn_rcpf(fmaxf(gn[4 + j], 1e-8f)); } }
                if (m & 1) asm volatile("" ::: "memory"); }
    }
    __device__ __forceinline__ void operator()(const f32x4 (&acc)[2][2][4][2], const Unit& u, int wr, int wc, int fr, int fq) const {
        const int row0 = u.pm * 256 + (HM ? u.aux * 128 : 0) + wr * 64 + fr, col0 = u.pn * 256 + wc * 64 + 8 * fq;
#pragma unroll
        for (int ai = 0; ai < (HM ? 1 : 2); ++ai)
#pragma unroll
            for (int m = 0; m < 4; ++m) { const size_t row = (size_t)(row0 + ai * 128 + m * 16);
#pragma unroll
                for (int bj = 0; bj < 2; ++bj) {
                    float g[8], f[8]; unpack8(*(const u32x4*)(Z + row * ZLD + ZG + 2048 + col0 + bj * 32), g);
#pragma unroll
                    for (int j = 0; j < 4; ++j) { f[j] = acc[ai][bj][m][0][j] * fmaxf(g[j], 1e-8f); f[4 + j] = acc[ai][bj][m][1][j] * fmaxf(g[4 + j], 1e-8f); }
                    *(u32x4*)(Mo + row * 1024 + col0 + bj * 32) = pack8(f); } }
    }
};
typedef EpiMergeT<false> EpiMerge;
template <bool HM> struct EpiResidT {
    static constexpr bool PERM = true, HAS_MID = false, HALFM = HM;
    const float* xin_ctx; const float* xin_lat; bf16_t* tout; const float* gate;
    __device__ __forceinline__ void operator()(const f32x4 (&acc)[2][2][4][2], const Unit& u, int wr, int wc, int fr, int fq) const {
        const float alpha = 1.681792830507429f;
        const int cond = u.pm < 16 ? 0 : 1 + ((u.pm - 16) >> 3);
        const int col0 = u.pn * 256 + wc * 64 + 8 * fq, row0 = u.pm * 256 + (HM ? u.aux * 128 : 0) + wr * 64 + fr;
        const float* gp = gate + (size_t)cond * 6144 + col0;
        f32x4 gv[2][2];
#pragma unroll
        for (int bj = 0; bj < 2; ++bj)
#pragma unroll
            for (int n = 0; n < 2; ++n) gv[bj][n] = *(const f32x4*)(gp + bj * 32 + n * 4);
        const float* xin = u.pm < 16 ? xin_ctx : xin_lat - (size_t)NCTX * 1024;
#pragma unroll
        for (int ai = 0; ai < (HM ? 1 : 2); ++ai)
#pragma unroll
            for (int m = 0; m < 4; ++m) { const size_t off = (size_t)(row0 + ai * 128 + m * 16) * 1024 + col0;
#pragma unroll
                for (int bj = 0; bj < 2; ++bj) { const f32x4 x0 = *(const f32x4*)(xin + off + bj * 32), x1 = *(const f32x4*)(xin + off + bj * 32 + 4);
                    const f32x4 t0 = alpha * x0 + gv[bj][0] * acc[ai][bj][m][0], t1 = alpha * x1 + gv[bj][1] * acc[ai][bj][m][1];
                    u32x4 w; w.x = cvt_pk_bf16(t0[0], t0[1]); w.y = cvt_pk_bf16(t0[2], t0[3]); w.z = cvt_pk_bf16(t1[0], t1[1]); w.w = cvt_pk_bf16(t1[2], t1[3]);
                    *(u32x4*)(tout + off + bj * 32) = w; } }
    }
};
typedef EpiResidT<false> EpiResid;

template <class Epi, class Sched>
__device__ __forceinline__ void gemm_phase(LAS unsigned char* lds, const Sched& S, const Epi& E) {
    const int tid = ltid(), wid = __builtin_amdgcn_readfirstlane(tid >> 6), lane = tid & 63, wr = wid >> 2, wc = wid & 3, fr = lane & 15, fq = lane >> 4;
    const int K = S.K, nt = K / BK, lda = S.lda, ldb = S.ldb;
    unsigned voffA[2], voffB[2];
#pragma unroll
    for (int i = 0; i < 2; ++i) { int R, C; stage_rc(tid * 16 + i * 8192, R, C); const int Rb = Epi::PERM ? ((R >> 5) * 64 + perm32(R & 31)) : R;
        voffA[i] = (unsigned)(R * lda + C) * 2u; voffB[i] = (unsigned)(Rb * ldb + C) * 2u; }
    const size_t kstep = (size_t)(BK * 2);
    const size_t hstepA = (size_t)HALF * lda * 2, hstepB = (size_t)(Epi::PERM ? 32 : HALF) * ldb * 2;
    const unsigned ldsw = (unsigned)wid * 1024u;
    const int aoff = lds_byte(wr * 64 + fr, fq * 8), boff = lds_byte(wc * 32 + fr, fq * 8);
#define PG8_SA(b, h) (((b) * 2 + (h)) * HTB)
#define PG8_SB(b, h) ((4 + (b) * 2 + (h)) * HTB)
#define PG8_STAGE(bufoff, gbase, voff) do { _Pragma("unroll") for (int _i = 0; _i < 2; ++_i) \
        __builtin_amdgcn_global_load_lds((const unsigned*)((const char*)(gbase) + (voff)[_i]), (LAS unsigned*)(lds + (bufoff) + ldsw + _i * 8192), 16, 0, 0); } while (0)
#define PG8_LDA(dst, b, h) do { _Pragma("unroll") for (int m = 0; m < 4; ++m) _Pragma("unroll") for (int k = 0; k < 2; ++k) dst[m][k] = *(const LAS bf16x8*)(lds + PG8_SA(b, h) + aoff + m * 2048 + k * 1024); } while (0)
#define PG8_LDB(dst, b, h) do { _Pragma("unroll") for (int n = 0; n < 2; ++n) _Pragma("unroll") for (int k = 0; k < 2; ++k) dst[n][k] = *(const LAS bf16x8*)(lds + PG8_SB(b, h) + boff + n * 2048 + k * 1024); } while (0)
#define PG8_MMA(ai, bj, At, Bt) do { __builtin_amdgcn_s_setprio(1); _Pragma("unroll") for (int m = 0; m < 4; ++m) _Pragma("unroll") for (int n = 0; n < 2; ++n) _Pragma("unroll") for (int k = 0; k < 2; ++k) \
        acc[ai][bj][m][n] = __builtin_amdgcn_mfma_f32_16x16x32_bf16(Bt[n][k], At[m][k], acc[ai][bj][m][n], 0, 0, 0); __builtin_amdgcn_s_setprio(0); } while (0)
#define PG8_WAIT_V(n) asm volatile("s_waitcnt vmcnt(" #n ")" ::: "memory")
#define PG8_WAIT_L(n) asm volatile("s_waitcnt lgkmcnt(" #n ")" ::: "memory")
#define PG8_BAR __builtin_amdgcn_s_barrier()
#define PG8_SCHED __builtin_amdgcn_sched_barrier(0)
    Unit cur, nxt; int ui = 0;
    if (!S.next(0, cur)) return;
    if (STAGGER_US > 0) {
        const unsigned grp = ((unsigned)lwg() >> 3) & 1u;
        if (grp) { const unsigned long long t0 = __builtin_amdgcn_s_memrealtime(); while (__builtin_amdgcn_s_memrealtime() - t0 < (unsigned long long)(STAGGER_US * 100)) __builtin_amdgcn_s_sleep(4); }
    }
    f32x4 acc[2][2][4][2];
#pragma unroll
    for (int a = 0; a < 2; ++a)
#pragma unroll
        for (int b = 0; b < 2; ++b)
#pragma unroll
            for (int m = 0; m < 4; ++m)
#pragma unroll
                for (int n = 0; n < 2; ++n) acc[a][b][m][n] = (f32x4){0.f, 0.f, 0.f, 0.f};
    bf16x8 At[4][2], B0[2][2], B1[2][2];
    const char* cA = S.a_ptr(cur); const char* cB = S.b_ptr(cur);
    PG8_STAGE(PG8_SB(0, 0), cB, voffB); PG8_STAGE(PG8_SA(0, 0), cA, voffA); PG8_STAGE(PG8_SB(0, 1), cB + hstepB, voffB); PG8_STAGE(PG8_SA(0, 1), cA + hstepA, voffA);
    if (wr == 1) PG8_BAR;
    PG8_WAIT_V(4); PG8_BAR;
    PG8_STAGE(PG8_SB(1, 0), cB + kstep, voffB); PG8_STAGE(PG8_SA(1, 0), cA + kstep, voffA); PG8_STAGE(PG8_SB(1, 1), cB + hstepB + kstep, voffB);
    PG8_WAIT_V(6); PG8_BAR;
    for (;;) {
        const bool has_next = S.next(ui + 1, nxt);
        const char* nA = has_next ? S.a_ptr(nxt) : cA; const char* nB = has_next ? S.b_ptr(nxt) : cB;
        for (int t = 0; t < nt; t += 2) {
            if constexpr (Epi::HAS_MID) { if (t == 8 || t == 16) E.mid(acc, cur, t >> 3, wr, wc, fr, fq); }
            const bool last = (t == nt - 2);
            const char* a1 = cA + (size_t)(t + 1) * kstep;
            const char* a2 = last ? nA : cA + (size_t)(t + 2) * kstep; const char* b2 = last ? nB : cB + (size_t)(t + 2) * kstep;
            const char* a3 = a2 + kstep; const char* b3 = b2 + kstep;
            PG8_LDB(B0, 0, 0); PG8_SCHED; PG8_LDA(At, 0, 0); PG8_STAGE(PG8_SA(1, 1), a1 + hstepA, voffA);
            PG8_WAIT_L(8); PG8_BAR; PG8_WAIT_L(0); PG8_MMA(0, 0, At, B0); PG8_BAR; PG8_SCHED;
            PG8_LDB(B1, 0, 1); PG8_STAGE(PG8_SB(0, 0), b2, voffB);
            PG8_BAR; PG8_WAIT_L(0); PG8_MMA(0, 1, At, B1); PG8_BAR;
            if constexpr (!Epi::HALFM) { PG8_LDA(At, 0, 1); } PG8_STAGE(PG8_SA(0, 0), a2, voffA);
            PG8_BAR; PG8_WAIT_L(0); if constexpr (!Epi::HALFM) { PG8_MMA(1, 0, At, B0); } PG8_BAR; PG8_SCHED;
            PG8_STAGE(PG8_SB(0, 1), b2 + hstepB, voffB);
            PG8_WAIT_V(6); PG8_BAR; if constexpr (!Epi::HALFM) { PG8_MMA(1, 1, At, B1); } PG8_BAR;
            PG8_LDB(B0, 1, 0); PG8_SCHED; PG8_LDA(At, 1, 0); PG8_STAGE(PG8_SA(0, 1), a2 + hstepA, voffA);
            PG8_WAIT_L(8); PG8_BAR; PG8_WAIT_L(0); PG8_MMA(0, 0, At, B0); PG8_BAR; PG8_SCHED;
            PG8_LDB(B1, 1, 1); PG8_STAGE(PG8_SB(1, 0), b3, voffB);
            PG8_BAR; PG8_WAIT_L(0); PG8_MMA(0, 1, At, B1); PG8_BAR;
            if constexpr (!Epi::HALFM) { PG8_LDA(At, 1, 1); } PG8_STAGE(PG8_SA(1, 0), a3, voffA);
            PG8_BAR; PG8_WAIT_L(0); if constexpr (!Epi::HALFM) { PG8_MMA(1, 0, At, B0); } PG8_BAR; PG8_SCHED;
            PG8_STAGE(PG8_SB(1, 1), b3 + hstepB, voffB);
            PG8_WAIT_V(6); PG8_BAR; if constexpr (!Epi::HALFM) { PG8_MMA(1, 1, At, B1); } PG8_BAR;
        }
        E(acc, cur, wr, wc, fr, fq);
        if (!has_next) break;
#pragma unroll
        for (int a = 0; a < 2; ++a)
#pragma unroll
            for (int b = 0; b < 2; ++b)
#pragma unroll
                for (int m = 0; m < 4; ++m)
#pragma unroll
                    for (int n = 0; n < 2; ++n) acc[a][b][m][n] = (f32x4){0.f, 0.f, 0.f, 0.f};
        cur = nxt; cA = nA; cB = nB; ++ui;
    }
    PG8_WAIT_V(0);
    if (wr == 0) PG8_BAR;
    PG8_BAR;
#undef PG8_SA
#undef PG8_SB
#undef PG8_STAGE
#undef PG8_LDA
#undef PG8_LDB
#undef PG8_MMA
#undef PG8_WAIT_V
#undef PG8_WAIT_L
#undef PG8_BAR
#undef PG8_SCHED
}

__device__ __forceinline__ void mods_phase(const P& p, float* MOD, float* ldsf) {
    const int tid = ltid(), wid = tid >> 6, lane = tid & 63;
    float* sc = ldsf;
    float* red = ldsf + 9 * 1024;
    for (int i = tid; i < 9 * 1024; i += 512) { const int j = i >> 10, k = i & 1023; const float v = j == 0 ? p.in[4][k] : p.in[3][(j - 1) * 1024 + k]; sc[i] = siluf_(v); }
    __syncthreads();
    for (int item = lwg(); item < 384; item += lnwg()) {
        const int l = item / 96, col0 = (item % 96) * 64;
        const float* w = p.in[19] + (size_t)l * 1024 * 6144 + col0 + lane;
        float a[9];
#pragma unroll
        for (int j = 0; j < 9; ++j) a[j] = 0.f;
        const int kb = wid * 128;
#pragma unroll 8
        for (int k = 0; k < 128; ++k) { const float wv = w[(size_t)(kb + k) * 6144];
#pragma unroll
            for (int j = 0; j < 9; ++j) a[j] += sc[j * 1024 + kb + k] * wv; }
#pragma unroll
        for (int j = 0; j < 9; ++j) red[(wid * 9 + j) * 64 + lane] = a[j];
        __syncthreads();
        for (int i = tid; i < 576; i += 512) { const int j = i >> 6, ln = i & 63; float s = p.in[20][l * 6144 + col0 + ln];
#pragma unroll
            for (int w8 = 0; w8 < 8; ++w8) s += red[(w8 * 9 + j) * 64 + ln];
            MOD[(size_t)(l * 9 + j) * 6144 + col0 + ln] = s; }
        __syncthreads();
    }
}

__device__ __forceinline__ void dft_phase(bf16_t* DL, bf16_t* DC) {
    const size_t gt = (size_t)lwg() * 512 + ltid(), gn = (size_t)lnwg() * 512;
    for (size_t i = gt; i < 2048ull * 2048 / 8; i += gn) { const int k = (int)(i / 256), kk0 = (int)(i % 256) * 8; float f[8];
#pragma unroll
        for (int j = 0; j < 8; ++j) { const int kk = kk0 + j; const bool cs = kk <= 1024; const int t = cs ? kk : kk - 1024; const int m = (k * t) & 2047; const float x = (float)m * (1.0f / 1024.0f);
            f[j] = (cs ? cospif(x) : -sinpif(x)) * (1.0f / 512.0f); }
        *(u32x4*)(DL + i * 8) = pack8(f); }
    for (size_t i = gt; i < 256ull * 512 / 8; i += gn) { const int k = (int)(i / 64), t0 = (int)(i % 64) * 8; float f[8];
#pragma unroll
        for (int j = 0; j < 8; ++j) { const int tt = t0 + j, t = tt & 255; const int m = (k * t) & 255; const float x = (float)m * (1.0f / 128.0f);
            f[j] = (tt < 256 ? cospif(x) : -sinpif(x)) * 0.005524271728019903f; }
        *(u32x4*)(DC + i * 8) = pack8(f); }
}

__device__ __forceinline__ void tconv_tile(const float* src, int ld_src, bf16_t* dst, int ld_dst, int k0, int n0, float scale, float* tl) {
    const int tid = ltid();
    f32x4 v[8];
#pragma unroll
    for (int ps = 0; ps < 8; ++ps) v[ps] = *(const f32x4*)(src + (size_t)(k0 + ps * 16 + (tid >> 5)) * ld_src + n0 + (tid & 31) * 4);
#pragma unroll
    for (int ps = 0; ps < 8; ++ps) { float* q = tl + (ps * 16 + (tid >> 5)) * 129 + (tid & 31) * 4; q[0] = v[ps][0]; q[1] = v[ps][1]; q[2] = v[ps][2]; q[3] = v[ps][3]; }
    LDS_BARRIER();
    { const int n = tid >> 2, kq = tid & 3; bf16_t* q = dst + (size_t)(n0 + n) * ld_dst + k0 + kq * 32;
#pragma unroll
      for (int c = 0; c < 4; ++c) { float f[8];
#pragma unroll
          for (int j = 0; j < 8; ++j) f[j] = tl[(kq * 32 + c * 8 + j) * 129 + n] * scale;
          *(u32x4*)(q + c * 8) = pack8(f); } }
    LDS_BARRIER();
}

__device__ __forceinline__ void wfft_item(int item, const float* win, bf16_t* W1T, float* tl) {
    const int tid = ltid(), kb = item >> 2, g = item & 3;
    float* xin = tl;
    float* ct = tl + 2048;
    { const int r = tid >> 5, c4 = (tid & 31) * 4; const f32x4 v = *(const f32x4*)(win + (size_t)(kb * 16 + r) * 7712 + g * 128 + c4); *(f32x4*)(xin + r * 128 + c4) = v; }
    if (tid < 128) { ct[tid] = cospif((float)tid * (1.0f / 64.0f)); ct[128 + tid] = sinpif((float)tid * (1.0f / 64.0f)); }
    LDS_BARRIER();
    { const int jj = tid & 255, cs = jj >> 7, j = jj & 127, half = tid >> 8; float a[8];
#pragma unroll
      for (int r = 0; r < 8; ++r) a[r] = 0.f;
      const float* tb = ct + cs * 128; const float* xr = xin + half * 8 * 128;
      for (int c = 0; c < 128; ++c) { const float w = tb[(j * c) & 127];
#pragma unroll
          for (int r = 0; r < 8; ++r) a[r] += xr[r * 128 + c] * w; }
      *(u32x4*)(W1T + (size_t)(cs * 512 + g * 128 + j) * 1024 + kb * 16 + half * 8) = pack8(a); }
    LDS_BARRIER();
}

__device__ __forceinline__ void wconv_phase(const P& p, int set, int l, float* tl, int wi, int nw, int lo = 0, int hi = 1 << 30) {
    bf16_t* W1T = (bf16_t*)(p.ws + WS_W1T); bf16_t* WMT = (bf16_t*)(p.ws + WS_WMT); bf16_t* WOT = (bf16_t*)(p.ws + WS_WOT);
    bf16_t* WUPT = (bf16_t*)(p.ws + WS_WUPT); bf16_t* WDNT = (bf16_t*)(p.ws + WS_WDNT);
    const float* win = p.in[5] + (size_t)l * 1024 * 7712;
    if (set == 0) {
        for (int it = lo + wi; it < (hi < 705 ? hi : 705); it += nw) {
            if (it < 256) wfft_item(it, win, W1T, tl);
            else if (it < 512) { const int j = it - 256, tk = j & 7, tn = j >> 3; const int n0 = tn * 128;
                tconv_tile(win + 512, 7712, W1T + (size_t)1024 * 1024, 1024, tk * 128, n0, (n0 >= 1024 && n0 < 1536) ? 0.08838834764831845f : 1.0f, tl); }
            else if (it < 704) { const int j = it - 512, tk = j & 7, tn = j >> 3;
                tconv_tile(win + 4640, 7712, W1T + (size_t)5120 * 1024, 1024, tk * 128, tn * 128, 1.0f, tl); }
            else { for (int i = ltid(); i < 256 * 1024; i += 512) { const int n = i >> 10, k = i & 1023;
                    W1T[(size_t)(8192 + n) * 1024 + k] = n < 32 ? f2bf(win[(size_t)k * 7712 + 4608 + n]) : (bf16_t)0; } }
        }
    } else if (set == 1) {
        for (int it = lo + wi; it < (hi < 192 ? hi : 192); it += nw) {
            if (it < 32) { const int tk = it & 3, tn = it >> 2; tconv_tile(p.in[7] + (size_t)l * 512 * 1024, 1024, WMT, 2048, tk * 128, tn * 128, 1.0f, tl); }
            else if (it < 64) { const int j = it - 32, tk = j & 3, tn = j >> 2; tconv_tile(p.in[11] + (size_t)l * 512 * 1024, 1024, WMT + 512, 2048, tk * 128, tn * 128, 1.0f, tl); }
            else if (it < 128) { const int j = it - 64, tk = j & 7, tn = j >> 3; tconv_tile(p.in[15] + (size_t)l * 1024 * 1024, 1024, WMT + 1024, 2048, tk * 128, tn * 128, 1.0f, tl); }
            else { const int j = it - 128, tk = j & 7, tn = j >> 3; tconv_tile(p.in[16] + (size_t)l * 1024 * 1024, 1024, WOT, 1024, tk * 128, tn * 128, 1.0f, tl); }
        }
    } else {
        for (int it = lo + wi; it < (hi < 528 ? hi : 528); it += nw) {
            if (it < 352) { const int tk = it & 7, tn = it >> 3; tconv_tile(p.in[21] + (size_t)l * 1024 * 5632, 5632, WUPT, 1024, tk * 128, tn * 128, 1.0f, tl); }
            else { const int j = it - 352, tn = j & 7, tk = j >> 3; tconv_tile(p.in[24] + (size_t)l * DFF * 1024, 1024, WDNT, DFF, tk * 128, tn * 128, 1.0f, tl); }
        }
    }
}

__device__ __forceinline__ void ln_phase(const float* src_ctx, const float* src_lat, float* xout, const float* g, const float* b, bool doLN,
                                         bool doH, const float* modl, int sci, int shi, bf16_t* H, const bf16_t* tsrc = nullptr) {
    const int lane = ltid() & 63, gw = lwg() * 8 + (ltid() >> 6), nw = lnwg() * 8;
    const int per = (NTOK + nw - 1) / nw, rbeg = gw * per, rend = (rbeg + per < NTOK) ? rbeg + per : NTOK;
    f32x4 gg[4], bb[4], scv[4], shv[4]; int cur = -1;
#pragma unroll
    for (int i = 0; i < 4; ++i) { gg[i] = doLN ? *(const f32x4*)(g + i * 256 + lane * 4) : (f32x4){1.f, 1.f, 1.f, 1.f}; bb[i] = doLN ? *(const f32x4*)(b + i * 256 + lane * 4) : (f32x4){0.f, 0.f, 0.f, 0.f};
        scv[i] = (f32x4){0.f, 0.f, 0.f, 0.f}; shv[i] = (f32x4){0.f, 0.f, 0.f, 0.f}; }
    auto body = [&](int row, f32x4 (&v)[4]) {
        if (doLN) {
            float s = 0.f;
#pragma unroll
            for (int i = 0; i < 4; ++i) s += (v[i][0] + v[i][1]) + (v[i][2] + v[i][3]);
            const float mean = wave_sum(s) * (1.0f / 1024.0f); float q = 0.f;
#pragma unroll
            for (int i = 0; i < 4; ++i) { const f32x4 d = v[i] - mean; q += (d[0] * d[0] + d[1] * d[1]) + (d[2] * d[2] + d[3] * d[3]); }
            const float rstd = rsqrtf(wave_sum(q) * (1.0f / 1024.0f) + 1e-5f);
#pragma unroll
            for (int i = 0; i < 4; ++i) { v[i] = (v[i] - mean) * rstd * gg[i] + bb[i]; *(f32x4*)(xout + (size_t)row * 1024 + i * 256 + lane * 4) = v[i]; }
        }
        if (doH) {
            const int cond = row < NCTX ? 0 : 1 + ((row - NCTX) >> 11);
            if (cond != cur) { cur = cond; const float* mp = modl + (size_t)cond * 6144;
#pragma unroll
                for (int i = 0; i < 4; ++i) { scv[i] = *(const f32x4*)(mp + sci * 1024 + i * 256 + lane * 4); shv[i] = *(const f32x4*)(mp + shi * 1024 + i * 256 + lane * 4); } }
            float s = 0.f;
#pragma unroll
            for (int i = 0; i < 4; ++i) s += (v[i][0] + v[i][1]) + (v[i][2] + v[i][3]);
            const float mean = wave_sum(s) * (1.0f / 1024.0f); float q = 0.f;
#pragma unroll
            for (int i = 0; i < 4; ++i) { const f32x4 d = v[i] - mean; q += (d[0] * d[0] + d[1] * d[1]) + (d[2] * d[2] + d[3] * d[3]); }
            const float rstd = rsqrtf(wave_sum(q) * (1.0f / 1024.0f) + 1e-5f);
#pragma unroll
            for (int i = 0; i < 4; ++i) { const f32x4 h = (v[i] - mean) * rstd * (1.0f + scv[i]) + shv[i];
                u32x2 w; w.x = cvt_pk_bf16(h[0], h[1]); w.y = cvt_pk_bf16(h[2], h[3]);
                *(u32x2*)(H + (size_t)row * 1024 + i * 256 + lane * 4) = w; }
        }
    };
    for (int row = rbeg; row < rend; row += 2) {
        const int row2 = row + 1; const bool has2 = row2 < rend;
        const int r2 = has2 ? row2 : row;
        f32x4 v[4], u[4];
        if (tsrc != nullptr) {
            u32x2 a[4], c[4];
#pragma unroll
            for (int i = 0; i < 4; ++i) { a[i] = *(const u32x2*)(tsrc + (size_t)row * 1024 + i * 256 + lane * 4); c[i] = *(const u32x2*)(tsrc + (size_t)r2 * 1024 + i * 256 + lane * 4); }
#pragma unroll
            for (int i = 0; i < 4; ++i) { v[i] = (f32x4){bf2f(a[i].x & 0xffffu), bf2f(a[i].x >> 16), bf2f(a[i].y & 0xffffu), bf2f(a[i].y >> 16)};
                u[i] = (f32x4){bf2f(c[i].x & 0xffffu), bf2f(c[i].x >> 16), bf2f(c[i].y & 0xffffu), bf2f(c[i].y >> 16)}; }
        } else {
            const float* src = row < NCTX ? src_ctx + (size_t)row * 1024 : src_lat + (size_t)(row - NCTX) * 1024;
            const float* src2 = r2 < NCTX ? src_ctx + (size_t)r2 * 1024 : src_lat + (size_t)(r2 - NCTX) * 1024;
#pragma unroll
            for (int i = 0; i < 4; ++i) { v[i] = *(const f32x4*)(src + i * 256 + lane * 4); u[i] = *(const f32x4*)(src2 + i * 256 + lane * 4); } }
        body(row, v);
        if (has2) body(row2, u);
    }
}

__device__ __forceinline__ void glapost_phase(bf16_t* AM, const bf16_t* OB, const bf16_t* Z, const float* ng) {
    const int lane = ltid() & 63, gw = lwg() * 8 + (ltid() >> 6), nw = lnwg() * 8;
    float gn[16];
#pragma unroll
    for (int j = 0; j < 16; ++j) gn[j] = ng[(lane & 15) * 16 + j];
    for (int row = gw; row < NTOK; row += nw) {
        bf16_t* op = AM + (size_t)row * 2048 + 1024 + lane * 16;
        const bf16_t* bp = OB + (size_t)row * 1024 + lane * 16;
        const bf16_t* rp = Z + (size_t)row * ZLD + ZR + lane * 16;
        float a[16], bq[16], r[16];
        { float t[8]; unpack8(*(const u32x4*)op, t);
#pragma unroll
          for (int j = 0; j < 8; ++j) a[j] = t[j];
          unpack8(*(const u32x4*)(op + 8), t);
#pragma unroll
          for (int j = 0; j < 8; ++j) a[8 + j] = t[j];
          unpack8(*(const u32x4*)bp, t);
#pragma unroll
          for (int j = 0; j < 8; ++j) bq[j] = t[j];
          unpack8(*(const u32x4*)(bp + 8), t);
#pragma unroll
          for (int j = 0; j < 8; ++j) bq[8 + j] = t[j];
          unpack8(*(const u32x4*)rp, t);
#pragma unroll
          for (int j = 0; j < 8; ++j) r[j] = t[j];
          unpack8(*(const u32x4*)(rp + 8), t);
#pragma unroll
          for (int j = 0; j < 8; ++j) r[8 + j] = t[j]; }
        float ss = 0.f;
#pragma unroll
        for (int j = 0; j < 16; ++j) { a[j] += bq[j]; ss += a[j] * a[j]; }
        ss += __shfl_xor(ss, 1); ss += __shfl_xor(ss, 2); ss += __shfl_xor(ss, 4); ss += __shfl_xor(ss, 8);
        const float rs = rsqrtf(ss * (1.0f / 256.0f) + 1e-5f);
        float o0[8], o1[8];
#pragma unroll
        for (int j = 0; j < 8; ++j) { o0[j] = a[j] * rs * gn[j] * r[j]; o1[j] = a[8 + j] * rs * gn[8 + j] * r[8 + j]; }
        *(u32x4*)op = pack8(o0); *(u32x4*)(op + 8) = pack8(o1);
    }
}

__device__ __forceinline__ void conv_phase(const bf16_t* AG, bf16_t* FF, const float* wdw, const float* bdw) {
    for (int wi = lwg(); wi < 220; wi += lnwg()) {
        const int rg = wi / 11, cg = wi - rg * 11;
        const int run = rg * 16 + (ltid() >> 5), cb = cg * 32 + (ltid() & 31), ch = cb * 8;
        const bool lat = run >= 64;
        const int tok0 = lat ? NCTX + (run - 64) * 64 : run * 64;
        const int gy = (run - 64) & 31;
        const bool up = lat && gy > 0, dn = lat && gy < 31;
        const int xlo = lat ? 0 : -(tok0 & 255), xhi = lat ? 63 : 255 - (tok0 & 255);
        f32x2 w[9][4], bias[4];
#pragma unroll
        for (int t = 0; t < 9; ++t) { const f32x4 a = *(const f32x4*)(wdw + t * DFF + ch), b = *(const f32x4*)(wdw + t * DFF + ch + 4);
            w[t][0] = (f32x2){a[0], a[1]}; w[t][1] = (f32x2){a[2], a[3]}; w[t][2] = (f32x2){b[0], b[1]}; w[t][3] = (f32x2){b[2], b[3]}; }
        { const f32x4 a = *(const f32x4*)(bdw + ch), b = *(const f32x4*)(bdw + ch + 4);
          bias[0] = (f32x2){a[0], a[1]}; bias[1] = (f32x2){a[2], a[3]}; bias[2] = (f32x2){b[0], b[1]}; bias[3] = (f32x2){b[2], b[3]}; }
        const bf16_t* base = AG + (size_t)tok0 * 5632 + ch;
        const u32x4 zero4 = {0u, 0u, 0u, 0u};
        f32x2 cA[3][4], cB[3][4], cC[3][4]; u32x4 nx[3], ny[3], gnx;
#define CONV_LOADCOL(dst, x) do { const bool okx = (x) >= xlo && (x) <= xhi; const bf16_t* q_ = base + (ptrdiff_t)(x) * 5632; \
            dst[0] = (okx && up) ? *(const u32x4*)(q_ - 64 * 5632) : zero4; dst[1] = okx ? *(const u32x4*)q_ : zero4; dst[2] = (okx && dn) ? *(const u32x4*)(q_ + 64 * 5632) : zero4; } while (0)
#define CONV_UNPACK(dst, src) do { _Pragma("unroll") for (int dy_ = 0; dy_ < 3; ++dy_) { const u32x4 s_ = src[dy_]; \
            dst[dy_][0] = (f32x2){bf2f(s_.x & 0xffffu), bf2f(s_.x >> 16)}; dst[dy_][1] = (f32x2){bf2f(s_.y & 0xffffu), bf2f(s_.y >> 16)}; \
            dst[dy_][2] = (f32x2){bf2f(s_.z & 0xffffu), bf2f(s_.z >> 16)}; dst[dy_][3] = (f32x2){bf2f(s_.w & 0xffffu), bf2f(s_.w >> 16)}; } } while (0)
#define CONV_STEP(c0, c1, c2, x) do { \
            const u32x4 gw_ = gnx; gnx = *(const u32x4*)(base + (size_t)((x) + 1 < 64 ? (x) + 1 : 63) * 5632 + DFF); \
            f32x2 acc_[4]; _Pragma("unroll") for (int j_ = 0; j_ < 4; ++j_) acc_[j_] = bias[j_]; \
            _Pragma("unroll") for (int dy_ = 0; dy_ < 3; ++dy_) _Pragma("unroll") for (int j_ = 0; j_ < 4; ++j_) { \
                acc_[j_] += c0[dy_][j_] * w[dy_ * 3 + 0][j_]; acc_[j_] += c1[dy_][j_] * w[dy_ * 3 + 1][j_]; acc_[j_] += c2[dy_][j_] * w[dy_ * 3 + 2][j_]; } \
            float g_[8], o_[8]; unpack8(gw_, g_); \
            _Pragma("unroll") for (int j_ = 0; j_ < 4; ++j_) { o_[2 * j_] = geluf_(acc_[j_][0]) * g_[2 * j_]; o_[2 * j_ + 1] = geluf_(acc_[j_][1]) * g_[2 * j_ + 1]; } \
            *(u32x4*)(FF + (size_t)(tok0 + (x)) * DFF + ch) = pack8(o_); \
            CONV_UNPACK(c0, nx); nx[0] = ny[0]; nx[1] = ny[1]; nx[2] = ny[2]; CONV_LOADCOL(ny, (x) + 4); } while (0)
        CONV_LOADCOL(nx, -1); CONV_UNPACK(cA, nx); CONV_LOADCOL(nx, 0); CONV_UNPACK(cB, nx); CONV_LOADCOL(nx, 1); CONV_UNPACK(cC, nx); CONV_LOADCOL(nx, 2); CONV_LOADCOL(ny, 3);
        gnx = *(const u32x4*)(base + DFF);
#pragma unroll 1
        for (int x = 0; x < 63; x += 3) { CONV_STEP(cA, cB, cC, x); CONV_STEP(cB, cC, cA, x + 1); CONV_STEP(cC, cA, cB, x + 2); }
        CONV_STEP(cA, cB, cC, 63);
#undef CONV_STEP
#undef CONV_UNPACK
#undef CONV_LOADCOL
    }
}

__device__ __forceinline__ void sgu_item(int item, int l, const P& p, const bf16_t* Z, bf16_t* AM, LAS unsigned char* lds) {
    const int tid = ltid(), wid = tid >> 6, lane = tid & 63, fr = lane & 15, fq = lane >> 4;
    LAS float* STAT = (LAS float*)lds;
    LAS bf16_t* VT = (LAS bf16_t*)(lds + 1024);
    const int row0 = item * 128;
    u32x4 vrow[16];
#pragma unroll
    for (int i = 0; i < 16; ++i) vrow[i] = *(const u32x4*)(Z + (size_t)(row0 + wid * 16 + i) * ZLD + ZV + lane * 8);
#pragma unroll
    for (int i = 0; i < 16; ++i) { const int q = wid * 16 + i; float f[8]; unpack8(vrow[i], f);
        float s = 0.f;
#pragma unroll
        for (int j = 0; j < 8; ++j) s += f[j];
        const float mean = wave_sum(s) * (1.0f / 512.0f); float qq = 0.f;
#pragma unroll
        for (int j = 0; j < 8; ++j) { const float d = f[j] - mean; qq += d * d; }
        const float rstd = rsqrtf(wave_sum(qq) * (1.0f / 512.0f) + 1e-5f);
        if (lane == 0) { STAT[q * 2] = mean; STAT[q * 2 + 1] = rstd; } }
    LDS_BARRIER();
    for (int g = 0; g < 4; ++g) {
        { const int q = tid >> 2, seg = tid & 3; const float mean = STAT[q * 2], rstd = STAT[q * 2 + 1];
#pragma unroll
          for (int j4 = 0; j4 < 4; ++j4) { const int c0 = seg * 32 + j4 * 8; float f[8]; unpack8(*(const u32x4*)(Z + (size_t)(row0 + q) * ZLD + ZV + g * 128 + c0), f);
              const float* sg = p.in[8] + l * 512 + g * 128 + c0;
#pragma unroll
              for (int j = 0; j < 8; ++j) VT[(c0 + j) * 136 + q] = f2bf((f[j] - mean) * rstd * sg[j]); } }
        LDS_BARRIER();
        bf16x8 Yf[4];
        { const float* wp = p.in[9] + ((size_t)(l * 4 + g) * 128 + wid * 16 + fr) * 128 + 8 * fq;
#pragma unroll
          for (int kk = 0; kk < 4; ++kk) { const f32x4 a = *(const f32x4*)(wp + kk * 32), b = *(const f32x4*)(wp + kk * 32 + 4);
              u32x4 w; w.x = cvt_pk_bf16(a[0], a[1]); w.y = cvt_pk_bf16(a[2], a[3]); w.z = cvt_pk_bf16(b[0], b[1]); w.w = cvt_pk_bf16(b[2], b[3]);
              Yf[kk] = __builtin_bit_cast(bf16x8, w); } }
        const int pp = wid * 16 + fr; const size_t tok = (size_t)(row0 + pp);
        const float bias = p.in[10][(l * 4 + g) * 128 + pp];
#pragma unroll
        for (int ct = 0; ct < 8; ++ct) { f32x4 acc = {0.f, 0.f, 0.f, 0.f};
#pragma unroll
            for (int kk = 0; kk < 4; ++kk) { const bf16x8 X = *(const LAS bf16x8*)(VT + (ct * 16 + fr) * 136 + kk * 32 + 8 * fq);
                acc = __builtin_amdgcn_mfma_f32_16x16x32_bf16(X, Yf[kk], acc, 0, 0, 0); }
            const int c = ct * 16 + 4 * fq;
            const u32x2 uw = *(const u32x2*)(Z + tok * ZLD + ZU + g * 128 + c);
            const float u0 = bf2f(uw.x & 0xffffu), u1 = bf2f(uw.x >> 16), u2 = bf2f(uw.y & 0xffffu), u3 = bf2f(uw.y >> 16);
            u32x2 ow; ow.x = cvt_pk_bf16(u0 * (acc[0] + bias), u1 * (acc[1] + bias)); ow.y = cvt_pk_bf16(u2 * (acc[2] + bias), u3 * (acc[3] + bias));
            *(u32x2*)(AM + tok * 2048 + 512 + g * 128 + c) = ow; }
        LDS_BARRIER();
    }
}

__device__ __forceinline__ void glapre_phase(int wg, int nwg, int l, const P& p, const bf16_t* Z, const float* LR, bf16_t* AM, bf16_t* HB, float* ETOT, LAS unsigned char* lds) {
    const int tid = ltid();
    LAS float* LRS = (LAS float*)lds;
    LAS float* GT = (LAS float*)(lds + 8192);
    const int kc = tid & 127, lg = tid >> 7;
    float w0[16], w1[16], b0 = 0.f, b1 = 0.f; int cur_h = -1;
#pragma unroll
    for (int r = 0; r < 16; ++r) { w0[r] = 0.f; w1[r] = 0.f; }
    bf16_t pq[16], pk[16];
#define GLAPRE_LOADQK(it_) do { const int c_ = (it_) >> 2, h_ = (it_) & 3; _Pragma("unroll") for (int i_ = 0; i_ < 16; ++i_) { \
        const bf16_t* zr_ = Z + (size_t)(c_ * 64 + lg * 16 + i_) * ZLD + h_ * 128 + kc; pq[i_] = zr_[ZQ]; pk[i_] = zr_[ZK]; } } while (0)
    int item = wg;
    if (item < 1280) GLAPRE_LOADQK(item);
    for (; item < 1280; item += nwg) {
        const int c = item >> 2, h = item & 3, row0 = c * 64;
        { const int li = tid >> 3, part = tid & 7; *(LAS f32x4*)(LRS + li * 32 + part * 4) = *(const f32x4*)(LR + (size_t)(row0 + li) * 32 + part * 4); }
        if (h != cur_h) { cur_h = h;
#pragma unroll
            for (int r = 0; r < 16; ++r) { w0[r] = p.in[12][((size_t)(l * 2 + 0) * 16 + r) * 512 + h * 128 + kc]; w1[r] = p.in[12][((size_t)(l * 2 + 1) * 16 + r) * 512 + h * 128 + kc]; }
            b0 = p.in[13][(l * 2 + 0) * 512 + h * 128 + kc]; b1 = p.in[13][(l * 2 + 1) * 512 + h * 128 + kc]; }
        float qv[16], kv[16];
#pragma unroll
        for (int i = 0; i < 16; ++i) { qv[i] = bf2f(pq[i]); kv[i] = bf2f(pk[i]); }
        LDS_BARRIER();
        if (item + nwg < 1280) GLAPRE_LOADQK(item + nwg);
        float G0[16], G1[16];
#pragma unroll
        for (int i = 0; i < 16; ++i) { const LAS float* lr = LRS + (lg * 16 + i) * 32; float z0 = b0, z1 = b1;
#pragma unroll
            for (int r4 = 0; r4 < 4; ++r4) { const f32x4 a = *(const LAS f32x4*)(lr + r4 * 4), b = *(const LAS f32x4*)(lr + 16 + r4 * 4);
#pragma unroll
                for (int r = 0; r < 4; ++r) { z0 += a[r] * w0[r4 * 4 + r]; z1 += b[r] * w1[r4 * 4 + r]; } }
            G0[i] = (fminf(z0, 0.f) - __logf(1.0f + __expf(-fabsf(z0)))) * (1.0f / 16.0f);
            G1[i] = (fminf(z1, 0.f) - __logf(1.0f + __expf(-fabsf(z1)))) * (1.0f / 16.0f); }
#pragma unroll
        for (int i = 1; i < 16; ++i) G0[i] += G0[i - 1];
#pragma unroll
        for (int i = 14; i >= 0; --i) G1[i] += G1[i + 1];
        GT[lg * 128 + kc] = G0[15]; GT[512 + lg * 128 + kc] = G1[0];
        LDS_BARRIER();
        float pre0 = 0.f, pre1 = 0.f, tot0 = 0.f, tot1 = 0.f;
#pragma unroll
        for (int g4 = 0; g4 < 4; ++g4) { const float t0 = GT[g4 * 128 + kc], t1 = GT[512 + g4 * 128 + kc]; tot0 += t0; tot1 += t1; if (g4 < lg) pre0 += t0; if (g4 > lg) pre1 += t1; }
        if (lg == 0) { ETOT[((size_t)item * 2 + 0) * 128 + kc] = __expf(tot0); ETOT[((size_t)item * 2 + 1) * 128 + kc] = __expf(tot1); }
#pragma unroll
        for (int i = 0; i < 16; ++i) { const size_t row = (size_t)(row0 + lg * 16 + i);
            const float e0 = __expf(pre0 + G0[i]), e1 = __expf(pre1 + G1[i]);
            bf16_t* a = AM + row * 2048 + 1024 + h * 256 + kc; bf16_t* b = HB + row * 1024 + h * 256 + kc;
            a[0] = f2bf(qv[i] * e0); a[128] = f2bf(kv[i] * __builtin_amdgcn_rcpf(e0));
            b[0] = f2bf(qv[i] * e1); b[128] = f2bf(kv[i] * __builtin_amdgcn_rcpf(e1)); }
        LDS_BARRIER();
    }
#undef GLAPRE_LOADQK
}

typedef float f32x16 __attribute__((ext_vector_type(16)));
__device__ __forceinline__ int crow32(int reg, int h) { return (reg & 3) + 8 * (reg >> 2) + 4 * h; }
__device__ __forceinline__ void gla_item(int item, int l, const P& p, const bf16_t* Z, const float* ETOT, bf16_t* AM, bf16_t* HB, LAS unsigned char* lds) {
    const int tid = ltid(), wid = tid >> 6, lane = tid & 63, r32 = lane & 31, hh = lane >> 5;
    LAS bf16_t* QG  = (LAS bf16_t*)lds;
    LAS bf16_t* KG  = (LAS bf16_t*)(lds + 17408);
    LAS bf16_t* KGT = (LAS bf16_t*)(lds + 34816);
    LAS bf16_t* VT  = (LAS bf16_t*)(lds + 53248);
    LAS bf16_t* AB  = (LAS bf16_t*)(lds + 90112);
    LAS float*  ET  = (LAS float*)(lds + 99328);
    LAS bf16_t* OST = (LAS bf16_t*)(lds + 99840);
    int b, h, dir, T, seq0; const bool lat = item < 64;
    { const int idx = lat ? item : item - 64; dir = idx & 1; h = (idx >> 1) & 3; b = idx >> 3; }
    if (lat) { T = 2048; seq0 = NCTX + b * 2048; } else { T = 256; seq0 = b * 256; }
    f32x16 S[4];
    if (lat) { const float* sp = p.in[2] + ((size_t)((b * 4 + l) * 2 + dir) * 4 + h) * 128 * 256 + 32 * wid + r32;
#pragma unroll
        for (int kt = 0; kt < 4; ++kt)
#pragma unroll
            for (int reg = 0; reg < 16; ++reg) S[kt][reg] = sp[(size_t)(32 * kt + crow32(reg, hh)) * 256]; }
    else {
#pragma unroll
        for (int kt = 0; kt < 4; ++kt)
#pragma unroll
            for (int reg = 0; reg < 16; ++reg) S[kt][reg] = 0.f; }
    bf16_t* gbuf = dir ? HB : AM + 1024; const int ldg = dir ? 1024 : 2048;
    const int nch = T / 64;
    u32x4 pg[4], pv[4]; f32x4 pe = {0.f, 0.f, 0.f, 0.f};
#define GLA_TOK(pos) (seq0 + (dir ? T - 1 - (pos) : (pos)))
#define GLA_ISSUE(n_) do { const int pos0_ = (n_) * 64; const int li_ = tid >> 3, seg_ = tid & 7; const int tok_ = GLA_TOK(pos0_ + li_); \
        const bf16_t* gp_ = gbuf + (size_t)tok_ * ldg + h * 256 + seg_ * 32; const bf16_t* vp_ = Z + (size_t)tok_ * ZLD + ZVV + h * 256 + seg_ * 32; \
        _Pragma("unroll") for (int j_ = 0; j_ < 4; ++j_) { pg[j_] = *(const u32x4*)(gp_ + j_ * 8); pv[j_] = *(const u32x4*)(vp_ + j_ * 8); } \
        if (tid < 32) { const int ck_ = GLA_TOK(pos0_) >> 6; pe = *(const f32x4*)(ETOT + ((size_t)(ck_ * 4 + h) * 2 + dir) * 128 + tid * 4); } } while (0)
#define MFMA32(a_, b_, c_) __builtin_amdgcn_mfma_f32_32x32x16_bf16((a_), (b_), (c_), 0, 0, 0)
#define GLA_FLUSH(n_) do { const int li_ = tid >> 3, seg_ = tid & 7; bf16_t* op_ = gbuf + (size_t)GLA_TOK((n_) * 64 + li_) * ldg + h * 256 + seg_ * 32; \
        const LAS bf16_t* sp_ = OST + li_ * 264 + seg_ * 32; _Pragma("unroll") for (int j_ = 0; j_ < 4; ++j_) *(u32x4*)(op_ + j_ * 8) = *(const LAS u32x4*)(sp_ + j_ * 8); } while (0)
    GLA_ISSUE(0);
    for (int n = 0; n < nch; ++n) {
        const int pos0 = n * 64;
        if (n > 0) GLA_FLUSH(n - 1);
        { const int li = tid >> 3, seg = tid & 7;
          LAS bf16_t* gq = (seg < 4 ? QG : KG) + li * 136 + (seg & 3) * 32;
#pragma unroll
          for (int j = 0; j < 4; ++j) *(LAS u32x4*)(gq + j * 8) = pg[j];
          if (seg >= 4) { LAS bf16_t* q = KGT + ((seg - 4) * 32) * 72 + ((li + 8 * (seg - 4)) & 63);
#pragma unroll
              for (int j = 0; j < 4; ++j) { const u32x4 w = pg[j]; LAS bf16_t* qq = q + j * 8 * 72;
                  qq[0] = (bf16_t)(w.x & 0xffffu); qq[72] = (bf16_t)(w.x >> 16); qq[144] = (bf16_t)(w.y & 0xffffu); qq[216] = (bf16_t)(w.y >> 16);
                  qq[288] = (bf16_t)(w.z & 0xffffu); qq[360] = (bf16_t)(w.z >> 16); qq[432] = (bf16_t)(w.w & 0xffffu); qq[504] = (bf16_t)(w.w >> 16); } }
          LAS bf16_t* q = VT + (seg * 32) * 72 + ((li + 8 * seg) & 63);
#pragma unroll
          for (int j = 0; j < 4; ++j) { const u32x4 w = pv[j]; LAS bf16_t* qq = q + j * 8 * 72;
              qq[0] = (bf16_t)(w.x & 0xffffu); qq[72] = (bf16_t)(w.x >> 16); qq[144] = (bf16_t)(w.y & 0xffffu); qq[216] = (bf16_t)(w.y >> 16);
              qq[288] = (bf16_t)(w.z & 0xffffu); qq[360] = (bf16_t)(w.z >> 16); qq[432] = (bf16_t)(w.w & 0xffffu); qq[504] = (bf16_t)(w.w >> 16); } }
        if (tid < 32) *(LAS f32x4*)(ET + tid * 4) = pe;
        LDS_BARRIER();
        if (n + 1 < nch) GLA_ISSUE(n + 1);
        if (wid < 4) { const int lt = (wid == 1 || wid == 2) ? 1 : 0, mt = (wid == 2 || wid == 3) ? 1 : 0;
            f32x16 acc;
#pragma unroll
            for (int reg = 0; reg < 16; ++reg) acc[reg] = 0.f;
            if (wid < 3) {
#pragma unroll
                for (int s = 0; s < 8; ++s) { const bf16x8 A = *(const LAS bf16x8*)(KG + (32 * mt + r32) * 136 + 16 * s + 8 * hh), B = *(const LAS bf16x8*)(QG + (32 * lt + r32) * 136 + 16 * s + 8 * hh);
                    acc = MFMA32(A, B, acc); } }
            const int li = 32 * lt + r32;
#pragma unroll
            for (int g = 0; g < 4; ++g) { const int m0 = 32 * mt + 8 * g + 4 * hh;
                u32x2 w; w.x = cvt_pk_bf16(m0 <= li ? acc[4 * g] : 0.f, m0 + 1 <= li ? acc[4 * g + 1] : 0.f); w.y = cvt_pk_bf16(m0 + 2 <= li ? acc[4 * g + 2] : 0.f, m0 + 3 <= li ? acc[4 * g + 3] : 0.f);
                *(LAS u32x2*)(AB + li * 72 + m0) = w; } }
        LDS_BARRIER();
        bf16x8 VTf[4];
#pragma unroll
        for (int s = 0; s < 4; ++s) VTf[s] = *(const LAS bf16x8*)(VT + (32 * wid + r32) * 72 + ((16 * s + 8 * hh + 8 * wid) & 63));
#pragma unroll
        for (int lt = 0; lt < 2; ++lt) { f32x16 acc;
#pragma unroll
            for (int reg = 0; reg < 16; ++reg) acc[reg] = 0.f;
#pragma unroll
            for (int s = 0; s < 4; ++s) { const bf16x8 B = *(const LAS bf16x8*)(AB + (32 * lt + r32) * 72 + 16 * s + 8 * hh); acc = MFMA32(VTf[s], B, acc); }
#pragma unroll
            for (int kt = 0; kt < 4; ++kt)
#pragma unroll
                for (int s = 0; s < 2; ++s) {
                    u32x4 pa; pa.x = cvt_pk_bf16(S[kt][8 * s], S[kt][8 * s + 1]); pa.y = cvt_pk_bf16(S[kt][8 * s + 2], S[kt][8 * s + 3]);
                    pa.z = cvt_pk_bf16(S[kt][8 * s + 4], S[kt][8 * s + 5]); pa.w = cvt_pk_bf16(S[kt][8 * s + 6], S[kt][8 * s + 7]);
                    const LAS bf16_t* qp = QG + (32 * lt + r32) * 136 + 32 * kt + 16 * s + 4 * hh;
                    const u32x2 lo = *(const LAS u32x2*)qp, hi = *(const LAS u32x2*)(qp + 8);
                    u32x4 pb; pb.x = lo.x; pb.y = lo.y; pb.z = hi.x; pb.w = hi.y;
                    acc = MFMA32(__builtin_bit_cast(bf16x8, pa), __builtin_bit_cast(bf16x8, pb), acc); }
            LAS bf16_t* orow = OST + (32 * lt + r32) * 264 + 32 * wid + 4 * hh;
#pragma unroll
            for (int g = 0; g < 4; ++g) { u32x2 w; w.x = cvt_pk_bf16(acc[4 * g], acc[4 * g + 1]); w.y = cvt_pk_bf16(acc[4 * g + 2], acc[4 * g + 3]);
                *(LAS u32x2*)(orow + 8 * g) = w; } }
#pragma unroll
        for (int kt = 0; kt < 4; ++kt) { f32x16 acc = S[kt];
#pragma unroll
            for (int s = 0; s < 4; ++s) { const bf16x8 A = *(const LAS bf16x8*)(KGT + (32 * kt + r32) * 72 + ((16 * s + 8 * hh + 8 * kt) & 63)); acc = MFMA32(A, VTf[s], acc); }
#pragma unroll
            for (int g = 0; g < 4; ++g) { const f32x4 e4 = *(const LAS f32x4*)(ET + 32 * kt + 8 * g + 4 * hh);
#pragma unroll
                for (int q = 0; q < 4; ++q) acc[4 * g + q] *= e4[q]; }
            S[kt] = acc; }
        LDS_BARRIER();
    }
    GLA_FLUSH(nch - 1);
    LDS_BARRIER();
#undef GLA_FLUSH
#undef MFMA32
#undef GLA_ISSUE
#undef GLA_TOK
    if (!lat) { float* sp = p.out + (size_t)NTOK * 1024 + ((size_t)((b * 4 + l) * 2 + dir) * 4 + h) * 128 * 256 + 32 * wid + r32;
#pragma unroll
        for (int kt = 0; kt < 4; ++kt)
#pragma unroll
            for (int reg = 0; reg < 16; ++reg) sp[(size_t)(32 * kt + crow32(reg, hh)) * 256] = S[kt][reg]; }
}


__device__ __forceinline__ void fold_item(int item, const bf16_t* XTl, bf16_t* XF, LAS unsigned char* lds) {
    const int tid = ltid(); LAS bf16_t* R = (LAS bf16_t*)lds;
    const size_t r0 = (size_t)item * 4;
#pragma unroll
    for (int rr = 0; rr < 4; ++rr) *(LAS u32x4*)(R + rr * 4096 + tid * 8) = *(const u32x4*)(XTl + (r0 + rr) * 4096 + tid * 8);
    LDS_BARRIER();
#pragma unroll
    for (int rr = 0; rr < 4; ++rr) { const LAS bf16_t* row = R + rr * 4096; float f[4];
#pragma unroll
        for (int i = 0; i < 4; ++i) { const int kk = tid * 4 + i;
            if (kk <= 1024) { f[i] = bf2f(row[kk]); if (kk >= 1 && kk <= 1023) f[i] += bf2f(row[2048 - kk]); }
            else { const int t = kk - 1024; f[i] = bf2f(row[2048 + t]) - bf2f(row[4096 - t]); } }
        u32x2 w; w.x = cvt_pk_bf16(f[0], f[1]); w.y = cvt_pk_bf16(f[2], f[3]);
        *(u32x2*)(XF + (r0 + rr) * 2048 + tid * 4) = w; }
    LDS_BARRIER();
}

#define XB_TMO      128
#define XB_XCNT(j)  (256  + 64 * (j))
#define XB_XSUB(j)  (1280 + 64 * (j))
#define XB_XGEN(j)  (2304 + 64 * (j))
#define XB_TOP      3328
#define XB_TOPGEN   3392
#define XCD_BAR_WORDS 3456
#define XB_SPIN_CAP (1u << 18)
__device__ __forceinline__ unsigned xb_ld(unsigned* p)              { return __hip_atomic_load(p, __ATOMIC_RELAXED, __HIP_MEMORY_SCOPE_AGENT); }
__device__ __forceinline__ unsigned xb_add(unsigned* p, unsigned v) { return __hip_atomic_fetch_add(p, v, __ATOMIC_RELAXED, __HIP_MEMORY_SCOPE_AGENT); }
__device__ __forceinline__ unsigned xb_xcc_id() { return (unsigned)__builtin_amdgcn_s_getreg((3 << 11) | 20) & 0xFu; }
#define XB_SPIN(cond, bar) do { unsigned _sp = 0; while (cond) { __builtin_amdgcn_s_sleep(1); \
    if ((++_sp & 255u) == 0u) { if (xb_ld(&(bar)[XB_TMO])) break; if (_sp > XB_SPIN_CAP) { atomicAdd(&(bar)[XB_TMO], 1u); break; } } } } while (0)
struct XcdBarrier { unsigned* bar; unsigned x; volatile LAS unsigned* st; };
__device__ __forceinline__ XcdBarrier xcd_barrier_post(unsigned* bar, volatile LAS unsigned* st) {
    XcdBarrier b; b.bar = bar; b.x = xb_xcc_id(); b.st = st;
    if (threadIdx.x == 0) (void)xb_add(&bar[XB_XCNT(b.x)], 1u);
    return b;
}
__device__ __forceinline__ void xcd_barrier_complete(unsigned* bar, unsigned x, unsigned& nloc, unsigned& nx) {
    const unsigned G = gridDim.x * gridDim.y * gridDim.z;
    unsigned sum, cnt, mine, sp = 0u;
    for (;;) {
        sum = 0u; cnt = 0u; mine = 0u;
#pragma unroll
        for (unsigned j = 0; j < 16; ++j) { const unsigned c = xb_ld(&bar[XB_XCNT(j)]); sum += c; cnt += (c > 0u) ? 1u : 0u; mine = (j == x) ? c : mine; }
        if (sum == G) break;
        __builtin_amdgcn_s_sleep(1);
        if ((++sp & 255u) == 0u) { if (xb_ld(&bar[XB_TMO])) break; if (sp > XB_SPIN_CAP) { atomicAdd(&bar[XB_TMO], 1u); break; } }
    }
    nloc = mine > 0u ? mine : 1u; nx = cnt > 0u ? cnt : 1u;
}
__device__ __forceinline__ void xcd_barrier(const XcdBarrier& b) {
    asm volatile("s_waitcnt vmcnt(0)" ::: "memory");
    __syncthreads();
    if (threadIdx.x == 0) {
        unsigned* bar = b.bar;
        __builtin_amdgcn_s_waitcnt(0);
        unsigned nloc = b.st[0], nx = b.st[1];
        if (nloc == 0u) { xcd_barrier_complete(bar, b.x, nloc, nx); b.st[0] = nloc; b.st[1] = nx; }
        const unsigned old = xb_add(&bar[XB_XSUB(b.x)], 1u);
        const unsigned gen = old / nloc;
        if (old + 1u == (gen + 1u) * nloc) {
            __builtin_amdgcn_fence(__ATOMIC_RELEASE, "agent");
            asm volatile("s_waitcnt vmcnt(0)" ::: "memory");
            const unsigned og = xb_add(&bar[XB_TOP], 1u);
            const unsigned tg = og / nx;
            if (og + 1u == (tg + 1u) * nx) xb_add(&bar[XB_TOPGEN], 1u);
            else XB_SPIN(xb_ld(&bar[XB_TOPGEN]) == tg, bar);
            __builtin_amdgcn_fence(__ATOMIC_ACQUIRE, "agent");
            xb_add(&bar[XB_XGEN(b.x)], 1u);
            asm volatile("s_waitcnt vmcnt(0)" ::: "memory");
        } else {
            XB_SPIN(xb_ld(&bar[XB_XGEN(b.x)]) == gen, bar);
            __builtin_amdgcn_fence(__ATOMIC_ACQUIRE, "agent");
            asm volatile("s_waitcnt vmcnt(0)" ::: "memory");
        }
    }
    __syncthreads();
}

template <int PH>
__device__ __forceinline__ void run_phase(const P& p, int l, unsigned char* shm) {
    LAS unsigned char* lds = (LAS unsigned char*)shm;
    const int wg = lwg(), nwg = lnwg();
    size_t wso = 0; asm volatile("" : "+s"(wso)); unsigned char* wsb = p.ws + wso;
    float* MOD = (float*)(wsb + WS_MOD);
    bf16_t* DLAT = (bf16_t*)(wsb + WS_DLAT); bf16_t* DCTX = (bf16_t*)(wsb + WS_DCTX);
    bf16_t* W1T = (bf16_t*)(wsb + WS_W1T); bf16_t* WMT = (bf16_t*)(wsb + WS_WMT); bf16_t* WOT = (bf16_t*)(wsb + WS_WOT);
    bf16_t* WUPT = (bf16_t*)(wsb + WS_WUPT); bf16_t* WDNT = (bf16_t*)(wsb + WS_WDNT);
    bf16_t* H = (bf16_t*)(wsb + WS_H); bf16_t* XTc = (bf16_t*)(wsb + WS_XT); bf16_t* XTl = (bf16_t*)(wsb + WS_XTL); bf16_t* Mb = (bf16_t*)(wsb + WS_XT);
    bf16_t* Z = (bf16_t*)(wsb + WS_Z); float* LR = (float*)(wsb + WS_LR); bf16_t* AM = (bf16_t*)(wsb + WS_AM); float* ETOT = (float*)(wsb + WS_ETOT); bf16_t* XF = (bf16_t*)(wsb + WS_XF);
    bf16_t* AG = (bf16_t*)(wsb + WS_AG); bf16_t* FF = (bf16_t*)(wsb + WS_FF);
    float* X = p.out;
    const float* modl = MOD + (size_t)l * 9 * 6144;
    if constexpr (PH == 0) {
        mods_phase(p, MOD, (float*)shm);
        dft_phase(DLAT, DCTX);
        wconv_phase(p, 0, 0, (float*)shm, wg, nwg);
        wconv_phase(p, 1, 0, (float*)shm, wg, nwg);
    } else if constexpr (PH == 1) {
        ln_phase(p.in[0], p.in[1], nullptr, nullptr, nullptr, false, true, MOD, 1, 0, H);
    } else if constexpr (PH == 2) {
        const int full = (80 * 33 / nwg) * nwg;
        { SchedLim S{H, W1T, 1024, 1024, 1024, 80, 33, nwg, wg, full}; EpiIn E{Z, XTc, XTl, LR, p.in[6] + l * 3072}; gemm_phase(lds, S, E); }
        { SchedRestM S{H, W1T, 1024, 1024, 1024, 80, 33, nwg, wg, full}; EpiInT<true> E{Z, XTc, XTl, LR, p.in[6] + l * 3072}; gemm_phase(lds, S, E); }
    } else if constexpr (PH == 3) {
        glapre_phase(wg, nwg, l, p, Z, LR, AM, H, ETOT, lds);
        for (int it = wg; it < 1024; it += nwg) fold_item(it, XTl, XF, lds);
    } else if constexpr (PH == 4) {
        if (wg < NFFT_WG) { SchedFftL S{DLAT, XF, 2048, 2048, 2048, NFFT_WG, wg}; EpiBf16 E{AM, 2048}; gemm_phase(lds, S, E); }
        else if (wg < NFFT_WG + 64) gla_item(wg - NFFT_WG, l, p, Z, ETOT, AM, H, lds);
        unsigned* qhead = (unsigned*)(wsb + WS_BAR) + 3584 + 64 * l;
        volatile LAS unsigned* qw = (volatile LAS unsigned*)(lds + 151040 + 16);
        for (;;) {
            __syncthreads();
            if (ltid() == 0) qw[0] = __hip_atomic_fetch_add(qhead, 1u, __ATOMIC_RELAXED, __HIP_MEMORY_SCOPE_AGENT);
            __syncthreads();
            const int qi = __builtin_amdgcn_readfirstlane((int)qw[0]);
            if (qi >= 320) break;
            if (qi < 32) { SchedFftC S{DCTX, XTc, 512, 512, 512, 1 << 20, qi}; EpiBf16 E{AM, 2048}; gemm_phase(lds, S, E); }
            else if (qi < 160) gla_item(64 + (qi - 32), l, p, Z, ETOT, AM, H, lds);
            else sgu_item(qi - 160, l, p, Z, AM, lds);
        }
    } else if constexpr (PH == 5) {
        glapost_phase(AM, H, Z, p.in[14] + l * 256);
    } else if constexpr (PH == 6) {
        { SchedStd S{AM, WMT, 2048, 2048, 2048, 64, 4, nwg, wg}; EpiMerge E{Mb, Z}; gemm_phase(lds, S, E); }
        { SchedTailM S{AM, WMT, 2048, 2048, 2048, nwg, wg}; EpiMergeT<true> E{Mb, Z}; gemm_phase(lds, S, E); }
        if (wg >= 128) wconv_phase(p, 2, l, (float*)shm, wg - 128, nwg - 128);
    } else if constexpr (PH == 7) {
        const float* xc = l == 0 ? p.in[0] : X; const float* xl = l == 0 ? p.in[1] : X + (size_t)NCTX * 1024;
        { SchedStd S{Mb, WOT, 1024, 1024, 1024, 64, 4, nwg, wg}; EpiResid E{xc, xl, (bf16_t*)(wsb + WS_Z), modl + 2 * 1024}; gemm_phase(lds, S, E); }
        { SchedTailM S{Mb, WOT, 1024, 1024, 1024, nwg, wg}; EpiResidT<true> E{xc, xl, (bf16_t*)(wsb + WS_Z), modl + 2 * 1024}; gemm_phase(lds, S, E); }
        if (wg >= 128 && l + 1 < DEPTH) wconv_phase(p, 1, l + 1, (float*)shm, wg - 128, nwg - 128, 0, 128);
    } else if constexpr (PH == 8) {
        ln_phase(X, X + (size_t)NCTX * 1024, X, p.in[17] + l * 1024, p.in[18] + l * 1024, true, true, modl, 4, 3, H, (const bf16_t*)(wsb + WS_Z));
    } else if constexpr (PH == 9) {
        SchedStd S{H, WUPT, 1024, 1024, 1024, 80, 22, nwg, wg}; EpiBf16 E{AG, 5632}; gemm_phase(lds, S, E);
    } else if constexpr (PH == 10) {
        conv_phase(AG, FF, p.in[22] + (size_t)l * 9 * DFF, p.in[23] + l * DFF);
    } else if constexpr (PH == 11) {
        { SchedStd S{FF, WDNT, DFF, DFF, DFF, 64, 4, nwg, wg}; EpiResid E{X, X + (size_t)NCTX * 1024, (bf16_t*)(wsb + WS_Z), modl + 5 * 1024}; gemm_phase(lds, S, E); }
        { SchedTailM S{FF, WDNT, DFF, DFF, DFF, nwg, wg}; EpiResidT<true> E{X, X + (size_t)NCTX * 1024, (bf16_t*)(wsb + WS_Z), modl + 5 * 1024}; gemm_phase(lds, S, E); }
        if (wg >= 128 && l + 1 < DEPTH) { wconv_phase(p, 1, l + 1, (float*)shm, wg - 128, nwg - 128, 128, 192); wconv_phase(p, 0, l + 1, (float*)shm, wg - 128, nwg - 128); }
    } else if constexpr (PH == 12) {
        ln_phase(X, X + (size_t)NCTX * 1024, X, p.in[25] + l * 1024, p.in[26] + l * 1024, true, l + 1 < DEPTH, modl + 9 * 6144, 1, 0, H, (const bf16_t*)(wsb + WS_Z));
    }
}

#ifndef MULTI
#define MULTI 0
#endif

#if MULTI
template <int PH> __global__ void __launch_bounds__(512) k_phase(P p, int l) {
    extern __shared__ __attribute__((aligned(16))) unsigned char shm[];
    run_phase<PH>(p, l, shm);
}
template <int PH> static void launch_phase(const P& p, int l, int grid, hipStream_t stream) {
    static bool attr = false;
    if (!attr) { (void)hipFuncSetAttribute((const void*)k_phase<PH>, hipFuncAttributeMaxDynamicSharedMemorySize, LDS_BYTES); attr = true; }
    hipLaunchKernelGGL((k_phase<PH>), dim3(grid), dim3(512), LDS_BYTES, stream, p, l);
}
#else
#ifndef REPEAT_PH
#define REPEAT_PH 0
#endif
#ifndef STOP_PH
#define STOP_PH 99
#endif
__device__ __forceinline__ void dump_phase(const P& p, int which) {
    size_t wso = 0; asm volatile("" : "+s"(wso)); unsigned char* wsb = p.ws + wso;
    const size_t gt = (size_t)lwg() * 512 + ltid(), gn = (size_t)lnwg() * 512;
    const bf16_t* AM = (const bf16_t*)(wsb + WS_AM); const bf16_t* Z = (const bf16_t*)(wsb + WS_Z); const bf16_t* Mb = (const bf16_t*)(wsb + WS_XT);
    const bf16_t* H = (const bf16_t*)(wsb + WS_H); const float* LR = (const float*)(wsb + WS_LR);
    for (size_t i = gt; i < (size_t)NTOK * 1024; i += gn) { const size_t row = i >> 10, c = i & 1023; float v = 0.f;
        if (which == 0) v = bf2f(AM[row * 2048 + c]) + bf2f(AM[row * 2048 + 1024 + c]);
        else if (which == 1) { for (int j = 0; j < 7; ++j) v += bf2f(Z[row * ZLD + j * 1024 + c]); v += LR[row * 32 + (c & 31)] + bf2f(Mb[i]); }
        else if (which == 2) v = bf2f(Mb[i]);
        else if (which == 3) v = bf2f(H[i]);
        else if (which == 4) { const bf16_t* AG = (const bf16_t*)(wsb + WS_AG); for (int j = 0; j < 5; ++j) v += bf2f(AG[row * 5632 + j * 1024 + c]); }
        else if (which == 5) { const bf16_t* FF = (const bf16_t*)(wsb + WS_FF); v = bf2f(FF[row * DFF + c]) + bf2f(FF[row * DFF + 1024 + c]); }
        p.out[i] = v; }
}
__global__ void __launch_bounds__(512) fwd_megakernel(P p) {
    extern __shared__ __attribute__((aligned(16))) unsigned char shm[];
    cg::grid_group grid = cg::this_grid();
    volatile LAS unsigned* stw = (volatile LAS unsigned*)((LAS unsigned char*)shm + 151040);
    if (threadIdx.x == 0) { stw[0] = 0u; stw[1] = 0u; }
    __syncthreads();
    const XcdBarrier xb = xcd_barrier_post((unsigned*)(p.ws + WS_BAR), stw);
    run_phase<0>(p, 0, shm); grid.sync();
    run_phase<1>(p, 0, shm); xcd_barrier(xb);
#pragma unroll 1
    for (int l = 0; l < DEPTH; ++l) {
        run_phase<2>(p, l, shm); xcd_barrier(xb);
        if (STOP_PH == 2) { dump_phase(p, 1); return; }
#if REPEAT_PH == 2
        run_phase<2>(p, l, shm); xcd_barrier(xb);
#endif
        run_phase<3>(p, l, shm); xcd_barrier(xb);
        run_phase<4>(p, l, shm); xcd_barrier(xb);
#if REPEAT_PH == 34
        run_phase<3>(p, l, shm); xcd_barrier(xb);
        run_phase<4>(p, l, shm); xcd_barrier(xb);
#elif REPEAT_PH == 3
        run_phase<3>(p, l, shm); xcd_barrier(xb);
#elif REPEAT_PH == 4
        run_phase<4>(p, l, shm); xcd_barrier(xb);
#endif
        run_phase<5>(p, l, shm); xcd_barrier(xb);
        if (STOP_PH == 5) { dump_phase(p, 0); return; }
        run_phase<6>(p, l, shm); xcd_barrier(xb);
#if REPEAT_PH == 6
        run_phase<6>(p, l, shm); xcd_barrier(xb);
#endif
        if (STOP_PH == 6) { dump_phase(p, 2); return; }
        run_phase<7>(p, l, shm); xcd_barrier(xb);
        if (STOP_PH == 7) return;
        run_phase<8>(p, l, shm); xcd_barrier(xb);
        if (STOP_PH == 8) { xcd_barrier(xb); dump_phase(p, 3); return; }
        run_phase<9>(p, l, shm); xcd_barrier(xb);
        if (STOP_PH == 9) { dump_phase(p, 4); return; }
        run_phase<10>(p, l, shm); xcd_barrier(xb);
#if REPEAT_PH == 910
        run_phase<9>(p, l, shm); xcd_barrier(xb);
        run_phase<10>(p, l, shm); xcd_barrier(xb);
#elif REPEAT_PH == 10
        run_phase<10>(p, l, shm); xcd_barrier(xb);
#endif
        if (STOP_PH == 10) { dump_phase(p, 5); return; }
        run_phase<11>(p, l, shm); xcd_barrier(xb);
        if (STOP_PH == 11) return;
        run_phase<12>(p, l, shm); xcd_barrier(xb);
        if (STOP_PH == 12) return;
    }
}
#endif

extern "C" void kernel_launch(void* const* d_in, const int* in_sizes, int n_in, void* d_out, int out_size, void* d_ws, size_t ws_size, hipStream_t stream) {
    P p{};
    for (int i = 0; i < 27; ++i) p.in[i] = (const float*)d_in[i];
    p.out = (float*)d_out; p.ws = (unsigned char*)d_ws;
    if (ws_size < WS_END) { fprintf(stderr, "kernel_launch: workspace too small: %zu < %zu\n", ws_size, (size_t)WS_END); }
#if MULTI
    const int grid = 256;
    launch_phase<0>(p, 0, grid, stream);
    launch_phase<1>(p, 0, grid, stream);
    for (int l = 0; l < DEPTH; ++l) {
        launch_phase<2>(p, l, grid, stream);
        launch_phase<3>(p, l, grid, stream);
        launch_phase<4>(p, l, grid, stream);
        launch_phase<5>(p, l, grid, stream);
        launch_phase<6>(p, l, grid, stream);
        launch_phase<7>(p, l, grid, stream);
        launch_phase<8>(p, l, grid, stream);
        launch_phase<9>(p, l, grid, stream);
        launch_phase<10>(p, l, grid, stream);
        launch_phase<11>(p, l, grid, stream);
        launch_phase<12>(p, l, grid, stream);
    }
#else
    static int grid_blocks = 0;
    if (!grid_blocks) {
        int dev = 0, cus = 0, per_cu = 0;
        (void)hipGetDevice(&dev);
        (void)hipDeviceGetAttribute(&cus, hipDeviceAttributeMultiprocessorCount, dev);
        (void)hipFuncSetAttribute((const void*)fwd_megakernel, hipFuncAttributeMaxDynamicSharedMemorySize, LDS_BYTES);
        (void)hipOccupancyMaxActiveBlocksPerMultiprocessor(&per_cu, (const void*)fwd_megakernel, 512, LDS_BYTES);
        if (per_cu < 1) per_cu = 1;
        grid_blocks = cus * per_cu;
    }
    (void)hipMemsetAsync((char*)d_ws + WS_BAR, 0, 16384, stream);
    void* args[] = {&p};
    hipError_t e = hipLaunchCooperativeKernel((const void*)fwd_megakernel, dim3(grid_blocks), dim3(512), args, LDS_BYTES, stream);
    if (e != hipSuccess) fprintf(stderr, "cooperative launch failed: %s (grid %d)\n", hipGetErrorString(e), grid_blocks);
#endif
}
```
